# Optimizing an MI355X kernel written in HIP

```python
import math
import jax
import jax.numpy as jnp
from jax import lax
import numpy as np

D_MODEL = 1024
BATCH = 8
SEQ = 4096
DEPTH = 2

N_MEM = 256
H_A = 8
KVH_A = 2
G_A = H_A // KVH_A
DH_A = 64
WINDOW = 128
BLOCK = 128
KEY_SPAN = BLOCK + 2 * WINDOW
N_BUCKETS = 32
MAX_DISTANCE = 128
H_B = 4
DK_B = 64
DV_B = 128
GLA_RANK = 16
GLA_CHUNK = 64
GLA_NORMALIZER = 16.0
H_M = 4
DH_M = 128
BRANCH_W = 512
N_BRANCH = 3
D_FF = -(-8 * D_MODEL // (3 * 256)) * 256
EPS = 1e-6
NEG_INF = -1e30
IN_SIZES = (H_A * DH_A, KVH_A * DH_A, KVH_A * DH_A, H_B * DK_B, H_B * DK_B, H_B * DV_B, H_B * DV_B, 2 * GLA_RANK, H_M * DH_M, N_BRANCH * D_MODEL)
D_IN = sum(IN_SIZES)

kernel_name = "hybrid_gated_parallel_encoder"


def rmsnorm(x, g):
    xf = x.astype(jnp.float32)
    y = xf * lax.rsqrt(jnp.mean(xf * xf, axis=-1, keepdims=True) + EPS)
    return (y * g.astype(jnp.float32)).astype(x.dtype)


def t5_bucket(rel):
    nb = N_BUCKETS // 2
    max_exact = nb // 2
    ret = (rel > 0).astype(jnp.int32) * nb
    n = jnp.abs(rel)
    nf = jnp.maximum(n, 1).astype(jnp.float32)
    large = max_exact + (jnp.log(nf / max_exact) / math.log(MAX_DISTANCE / max_exact) * (nb - max_exact)).astype(jnp.int32)
    large = jnp.minimum(large, nb - 1)
    return ret + jnp.where(n < max_exact, n, large)


def window_attention(q, k, v, bias, sink):
    Bn, S = q.shape[0], q.shape[1]
    nblk = S // BLOCK
    pad = ((0, 0), (WINDOW, WINDOW), (0, 0), (0, 0))
    k_pad = jnp.pad(k, pad)
    v_pad = jnp.pad(v, pad)
    q_blocks = q.reshape(Bn, nblk, BLOCK, KVH_A, G_A, DH_A).swapaxes(0, 1)
    t = jnp.arange(BLOCK)[:, None]
    j = jnp.arange(KEY_SPAN)[None, :]
    in_band = jnp.abs(j - WINDOW - t) <= WINDOW
    scale = DH_A ** -0.5
    sink_f = sink.astype(jnp.float32)[:, :, None]

    def one_block(args):
        qb, i = args
        start = i * BLOCK
        kb = lax.dynamic_slice_in_dim(k_pad, start, KEY_SPAN, axis=1)
        vb = lax.dynamic_slice_in_dim(v_pad, start, KEY_SPAN, axis=1)
        kpos = start - WINDOW + jnp.arange(KEY_SPAN)
        valid = in_band & ((kpos >= 0) & (kpos < S))[None, :]
        s = jnp.einsum('bqhgd,bkhd->bhgqk', qb, kb).astype(jnp.float32) * scale + bias
        s = jnp.where(valid, s, NEG_INF)
        m = jnp.maximum(jnp.max(s, axis=-1), sink_f)
        p = jnp.exp(s - m[..., None])
        denom = jnp.sum(p, axis=-1) + jnp.exp(sink_f - m)
        o = jnp.einsum('bhgqk,bkhd->bqhgd', p.astype(v.dtype), vb)
        return o / denom.transpose(0, 3, 1, 2)[..., None].astype(o.dtype)

    out = lax.map(one_block, (q_blocks, jnp.arange(nblk)))
    return out.swapaxes(0, 1).reshape(Bn, S, H_A * DH_A)


def gla_chunked(q, k, v, log_a, strict):
    Bn, S, H, DK = q.shape
    DV = v.shape[-1]
    N = S // GLA_CHUNK

    def to_chunks(t):
        return t.astype(jnp.float32).reshape(Bn, N, GLA_CHUNK, H, t.shape[-1]).transpose(1, 0, 3, 2, 4)

    qc, kc, vc, gc = to_chunks(q), to_chunks(k), to_chunks(v), to_chunks(log_a)
    b = jnp.cumsum(gc, axis=3)
    b_last = b[:, :, :, -1:, :]
    qd = qc * jnp.exp(b)
    kd = kc * jnp.exp(-b)
    k_end = kc * jnp.exp(b_last - b)
    mask = jnp.tril(jnp.ones((GLA_CHUNK, GLA_CHUNK), dtype=bool), k=-1 if strict else 0)
    attn = jnp.where(mask, jnp.einsum('nbhcd,nbhsd->nbhcs', qd, kd), 0.0)
    o_intra = jnp.einsum('nbhcs,nbhse->nbhce', attn, vc)
    u = jnp.einsum('nbhsd,nbhse->nbhde', k_end, vc)
    decay = jnp.exp(b_last[:, :, :, 0, :])

    def step(state, inp):
        d, u_n = inp
        return state * d[..., None] + u_n, state

    _, s_prev = lax.scan(step, jnp.zeros((Bn, H, DK, DV), jnp.float32), (decay, u))
    o_inter = jnp.einsum('nbhcd,nbhde->nbhce', qd, s_prev)
    o = (o_intra + o_inter).transpose(1, 0, 3, 2, 4).reshape(Bn, S, H, DV)
    return o.astype(v.dtype)


def gla_branch(q, k, v, og, lr, w_up, b_dec, g_norm):
    Bn, S = q.shape[0], q.shape[1]
    q = q.reshape(Bn, S, H_B, DK_B) * (DK_B ** -0.5)
    k = k.reshape(Bn, S, H_B, DK_B)
    v = v.reshape(Bn, S, H_B, DV_B)
    logits = jnp.einsum('bsjr,jrk->bsjk', lr.reshape(Bn, S, 2, GLA_RANK).astype(jnp.float32), w_up.astype(jnp.float32)) + b_dec.astype(jnp.float32)
    la = (jax.nn.log_sigmoid(logits) / GLA_NORMALIZER).reshape(Bn, S, 2, H_B, DK_B)
    o_fwd = gla_chunked(q, k, v, la[:, :, 0], strict=False)
    flip = lambda t: jnp.flip(t, axis=1)
    o_bwd = flip(gla_chunked(flip(q), flip(k), flip(v), flip(la[:, :, 1]), strict=True))
    o = rmsnorm(o_fwd + o_bwd, g_norm).reshape(Bn, S, H_B * DV_B)
    return o * jax.nn.silu(og)


def memory_attention(q, k, v):
    Bn, S = q.shape[0], q.shape[1]
    s = jnp.einsum('bshd,bmhd->bhsm', q, k).astype(jnp.float32) * (DH_M ** -0.5)
    p = jax.nn.softmax(s, axis=-1).astype(v.dtype)
    return jnp.einsum('bhsm,bmhd->bshd', p, v).reshape(Bn, S, H_M * DH_M)


def setup_inputs(seed: int = 0) -> dict:
    key = jax.random.key(seed)
    ks = jax.random.split(key, 20)
    f32 = jnp.float32

    def nrm(k, shape, scale):
        return jax.random.normal(k, shape, f32) * scale

    def gain(k, shape):
        return 1.0 + 0.02 * jax.random.normal(k, shape, f32)

    return {
        'x': nrm(ks[0], (BATCH, SEQ, D_MODEL), 1.0),
        'mem': nrm(ks[1], (BATCH, N_MEM, D_MODEL), 1.0),
        'rel_bias': nrm(ks[2], (N_BUCKETS, H_A), 0.5),
        'norm_mix_g': gain(ks[3], (DEPTH, D_MODEL)),
        'norm_ffn_g': gain(ks[4], (DEPTH, D_MODEL)),
        'norm_mem_g': gain(ks[5], (DEPTH, D_MODEL)),
        'w_in': nrm(ks[6], (DEPTH, D_MODEL, D_IN), D_MODEL ** -0.5),
        'q_norm_a': gain(ks[7], (DEPTH, DH_A)),
        'k_norm_a': gain(ks[8], (DEPTH, DH_A)),
        'sink_a': nrm(ks[9], (DEPTH, H_A), 0.5),
        'w_decay_up': nrm(ks[10], (DEPTH, 2, GLA_RANK, H_B * DK_B), GLA_RANK ** -0.5),
        'b_decay': nrm(ks[11], (DEPTH, 2, H_B * DK_B), 0.1),
        'gla_norm_g': gain(ks[12], (DEPTH, DV_B)),
        'w_mem_kv': nrm(ks[13], (DEPTH, D_MODEL, 2 * H_M * DH_M), D_MODEL ** -0.5),
        'q_norm_m': gain(ks[14], (DEPTH, DH_M)),
        'k_norm_m': gain(ks[15], (DEPTH, DH_M)),
        'w_branch': nrm(ks[16], (DEPTH, N_BRANCH, BRANCH_W, D_MODEL), BRANCH_W ** -0.5),
        'w_out': nrm(ks[17], (DEPTH, D_MODEL, D_MODEL), 0.5 * D_MODEL ** -0.5),
        'w_ffn_in': nrm(ks[18], (DEPTH, D_MODEL, 2 * D_FF), D_MODEL ** -0.5),
        'w_ffn_out': nrm(ks[19], (DEPTH, D_FF, D_MODEL), 0.5 * D_FF ** -0.5),
    }


def reference(x, mem, rel_bias, norm_mix_g, norm_ffn_g, norm_mem_g, w_in, q_norm_a, k_norm_a, sink_a, w_decay_up, b_decay, gla_norm_g, w_mem_kv, q_norm_m, k_norm_m, w_branch, w_out, w_ffn_in, w_ffn_out):
    Bn, S, _ = x.shape
    n_mem = mem.shape[1]
    t = jnp.arange(BLOCK)[:, None]
    j = jnp.arange(KEY_SPAN)[None, :]
    rel = j - WINDOW - t
    band_bias = rel_bias[t5_bucket(rel)].astype(jnp.float32)
    band_bias = band_bias.transpose(2, 0, 1).reshape(KVH_A, G_A, BLOCK, KEY_SPAN)
    split_at = np.cumsum(IN_SIZES)[:-1].tolist()

    for l in range(DEPTH):
        h = rmsnorm(x, norm_mix_g[l])
        proj = h @ w_in[l]
        qa, ka, va, qb, kb, vb, gb, lr, qm, gl = jnp.split(proj, split_at, axis=-1)

        qa = rmsnorm(qa.reshape(Bn, S, KVH_A, G_A, DH_A), q_norm_a[l])
        ka = rmsnorm(ka.reshape(Bn, S, KVH_A, DH_A), k_norm_a[l])
        va = va.reshape(Bn, S, KVH_A, DH_A)
        o_a = window_attention(qa, ka, va, band_bias, sink_a[l].reshape(KVH_A, G_A))

        o_b = gla_branch(qb, kb, vb, gb, lr, w_decay_up[l], b_decay[l], gla_norm_g[l])

        mn = rmsnorm(mem, norm_mem_g[l])
        km, vm = jnp.split(mn @ w_mem_kv[l], 2, axis=-1)
        qm = rmsnorm(qm.reshape(Bn, S, H_M, DH_M), q_norm_m[l])
        km = rmsnorm(km.reshape(Bn, n_mem, H_M, DH_M), k_norm_m[l])
        o_m = memory_attention(qm, km, vm.reshape(Bn, n_mem, H_M, DH_M))

        branches = jnp.stack([o_a, o_b, o_m], axis=2)
        gates = jax.nn.sigmoid(gl.reshape(Bn, S, N_BRANCH, D_MODEL))
        merged = jnp.sum(gates * jnp.einsum('bsjc,jcd->bsjd', branches, w_branch[l]), axis=2)
        x = x + merged @ w_out[l]

        h2 = rmsnorm(x, norm_ffn_g[l])
        gate, up = jnp.split(h2 @ w_ffn_in[l], 2, axis=-1)
        x = x + (jax.nn.silu(gate) * up) @ w_ffn_out[l]
    return x
```

```cpp
#include <hip/hip_runtime.h>
#include <cstdio>
#include <cstdint>

#ifndef MK_N_LAUNCHES
#define MK_N_LAUNCHES 1
#endif

#define LAS __attribute__((address_space(3)))
#define GAS __attribute__((address_space(1)))
typedef unsigned short bf16_t;
typedef short bf16x8 __attribute__((ext_vector_type(8)));
typedef short s16x4 __attribute__((ext_vector_type(4)));
typedef short v4i16_t __attribute__((ext_vector_type(4)));
typedef float f32x2 __attribute__((ext_vector_type(2)));
typedef float f32x4 __attribute__((ext_vector_type(4)));
typedef float f32x16 __attribute__((ext_vector_type(16)));
typedef unsigned u32x2 __attribute__((ext_vector_type(2)));
typedef unsigned u32x4 __attribute__((ext_vector_type(4)));
typedef __bf16 bf16x2_t __attribute__((ext_vector_type(2)));

constexpr int DM = 1024, BATCH = 8, SEQ = 4096, T = BATCH * SEQ, NMEM = 256, TMEM = BATCH * NMEM;
constexpr int DFF = 2816, DIN = 5920;
constexpr float EPS = 1e-6f, LOG2E = 1.4426950408889634f;
constexpr int NPH = 17;

constexpr size_t MiB = 1u << 20;
constexpr size_t WS_CTL = 0;
constexpr size_t WS_SS = 512 * 1024;
constexpr size_t WS_MSS = 1 * MiB;
constexpr size_t WS_BIAS = 1 * MiB + 64 * 1024;
constexpr size_t WS_PAR = 1 * MiB + 128 * 1024;
constexpr int PAR_GKA = 0, PAR_SINK = 64, PAR_GKM = 128, PAR_GLAG = 256, PAR_BDEC = 384, PAR_WDU = 896, PAR_LAYER = 896 + 8192;
constexpr size_t WS_DEC = 2 * MiB;
constexpr size_t WS_KVM = 3 * MiB;
constexpr size_t WS_MB = 11 * MiB;
constexpr size_t WS_W = 16 * MiB;
constexpr size_t W_INA = 0, W_ING = 6 * MiB, W_MKV = 12 * MiB, W_BR = 14 * MiB, W_OUT = 17 * MiB, W_FI = 19 * MiB, W_FO = 30 * MiB, W_LAYER = 35 * MiB + 512 * 1024;
constexpr size_t WS_XB = 88 * MiB;
constexpr size_t WS_QA = 152 * MiB;
constexpr size_t WS_OB = 184 * MiB;
constexpr size_t WS_QM = 216 * MiB;
constexpr size_t WS_KA = 248 * MiB, WS_VA = 256 * MiB;
constexpr size_t WS_QB = 264 * MiB, WS_KB = 280 * MiB;
constexpr size_t WS_VB = 296 * MiB, WS_OG = 328 * MiB;
constexpr size_t WS_LR = 360 * MiB;
constexpr size_t WS_QD = 362 * MiB;
constexpr size_t WS_U = 394 * MiB;
constexpr size_t WS_OI = 458 * MiB;
constexpr size_t WS_OT = 264 * MiB;
constexpr size_t WS_G = 248 * MiB;
constexpr size_t WS_MG = 440 * MiB;
constexpr size_t WS_H = 248 * MiB;
constexpr size_t WS_END = 512 * MiB;
static_assert(WS_OI + 32 * MiB <= WS_END && WS_MG + 64 * MiB <= WS_END && WS_W + 2 * W_LAYER <= WS_XB && WS_G + 192 * MiB <= WS_MG && WS_H + 176 * MiB <= WS_END, "ws map");

constexpr int CW_BAR = 4096;

constexpr int RING_BYTES = 131072;
constexpr int MISC_OFF = RING_BYTES;
constexpr int WSF_OFF = RING_BYTES + 1024;
constexpr int LDS_BYTES = 147456;

__device__ __forceinline__ unsigned cvtpk(float lo, float hi) { f32x2 v = {lo, hi}; bf16x2_t b = __builtin_convertvector(v, bf16x2_t); return __builtin_bit_cast(unsigned, b); }
__device__ __forceinline__ float bflo(unsigned w) { return __uint_as_float(w << 16); }
__device__ __forceinline__ float bfhi(unsigned w) { return __uint_as_float(w & 0xffff0000u); }
__device__ __forceinline__ float ex2(float x) { return __builtin_amdgcn_exp2f(x); }
__device__ __forceinline__ float sigmoidf_(float x) { return __builtin_amdgcn_rcpf(1.0f + ex2(-x * LOG2E)); }
__device__ __forceinline__ float siluf_(float x) { return x * sigmoidf_(x); }
__device__ __forceinline__ int crow(int r, int hi) { return (r & 3) + 8 * (r >> 2) + 4 * hi; }
__device__ __forceinline__ float swapmax(float v) { auto rr = __builtin_amdgcn_permlane32_swap(__float_as_uint(v), __float_as_uint(v), false, false); return fmaxf(__uint_as_float(rr[0]), __uint_as_float(rr[1])); }
__device__ __forceinline__ float swapsum(float v) { auto rr = __builtin_amdgcn_permlane32_swap(__float_as_uint(v), __float_as_uint(v), false, false); return __uint_as_float(rr[0]) + __uint_as_float(rr[1]); }
__device__ __forceinline__ s16x4 vtr(const LAS char* p) { return __builtin_bit_cast(s16x4, __builtin_amdgcn_ds_read_tr16_b64_v4i16((LAS v4i16_t*)p)); }
#define MFMA32(a, b, c) __builtin_amdgcn_mfma_f32_32x32x16_bf16((a), (b), (c), 0, 0, 0)
__device__ __forceinline__ bf16x8 pack8(const f32x16& x, int s) {
    u32x4 p; p.x = cvtpk(x[8 * s], x[8 * s + 1]); p.y = cvtpk(x[8 * s + 2], x[8 * s + 3]); p.z = cvtpk(x[8 * s + 4], x[8 * s + 5]); p.w = cvtpk(x[8 * s + 6], x[8 * s + 7]);
    return __builtin_bit_cast(bf16x8, p);
}
__device__ __forceinline__ bf16x8 mk8(s16x4 lo, s16x4 hi) { return (bf16x8){lo[0], lo[1], lo[2], lo[3], hi[0], hi[1], hi[2], hi[3]}; }

__device__ __forceinline__ int opaque_v(int v) { asm volatile("" : "+v"(v)); return v; }
namespace pg8 {
constexpr int BM = 256, BK = 64, HALF = 128, HTB = HALF * BK * 2, NXCD = 8, WGM = 8;
__host__ __device__ __forceinline__ int lds_byte(int r, int c) { const int st = (r >> 4) * 2 + (c >> 5), rr = r & 15, cc = c & 31, ob = rr * 64 + cc * 2; return st * 1024 + (ob ^ (((ob >> 9) & 1) << 5)); }
__host__ __device__ __forceinline__ void stage_rc(int b, int& R, int& C) { const int st = b / 1024, sb = b % 1024, swz = sb ^ (((sb >> 9) & 1) << 5); R = (st >> 1) * 16 + swz / 64; C = (st & 1) * 32 + (swz % 64) / 2; }
__host__ __device__ __forceinline__ int perm32(int rho) { const int n = rho >> 4, i = rho & 15; return 8 * (i >> 2) + 4 * n + (i & 3); }

struct Unit { int pm, pn, sub; unsigned aoff, boff; };
struct Gemm { const bf16_t* A; const bf16_t* Bt; int lda, ldb, K; };

struct Sched {
    int nM, nN, nSub, nwg, G, c; unsigned a_pm, a_sub, b_pn, b_sub;
    __device__ void init(int M, int N, int nSub_, int G_, int c_, unsigned a_pm_, unsigned a_sub_, unsigned b_pn_, unsigned b_sub_) {
        nM = M / BM; nN = N / BM; nSub = nSub_; nwg = nM * nN; G = G_; c = c_; a_pm = a_pm_; a_sub = a_sub_; b_pn = b_pn_; b_sub = b_sub_; }
    __device__ bool next(int i, Unit& u) const {
        const int round = i / nSub, sub = i - round * nSub;
        const long L = (long)round * G + c; if (L >= nwg) return false;
        int wgid = (int)L; { const int q = nwg / NXCD, r = nwg % NXCD, xcd = wgid % NXCD, off = wgid / NXCD; wgid = (xcd < r ? xcd * (q + 1) : r * (q + 1) + (xcd - r) * q) + off; }
        const int nig = WGM * nN, gid = wgid / nig, fm = gid * WGM, gsz = (nM - fm) < WGM ? (nM - fm) : WGM;
        u.pm = fm + ((wgid % nig) % gsz); u.pn = (wgid % nig) / gsz; u.sub = sub;
        u.aoff = (unsigned)u.pm * a_pm + (unsigned)sub * a_sub; u.boff = (unsigned)u.pn * b_pn + (unsigned)sub * b_sub; return true;
    }
};

template <class Epi, bool ALIGN_EPI, bool SP2>
__device__ __forceinline__ void gemm_phase(LAS unsigned char* lds, const Gemm g, const Sched& S, const Epi& E) {
    const int tid = opaque_v(threadIdx.x), wid = __builtin_amdgcn_readfirstlane(tid >> 6), lane = tid & 63, wr = wid >> 2, wc = wid & 3, fr = lane & 15, fq = lane >> 4;
    const int K = g.K, nt = K / BK;
    unsigned voffA[2], voffB[2];
#pragma unroll
    for (int i = 0; i < 2; ++i) { int R, C; stage_rc(tid * 16 + i * 8192, R, C); const int Rb = (R & ~31) + perm32(R & 31);
        voffA[i] = (unsigned)(R * g.lda + C) * 2u; voffB[i] = (unsigned)(Rb * g.ldb + C) * 2u; }
    const size_t kstep = (size_t)(BK * 2);
    const size_t hstepA = (size_t)HALF * g.lda * 2, hstepB = (size_t)HALF * g.ldb * 2;
    const unsigned ldsw = (unsigned)wid * 1024u;
    const int aoff = lds_byte(wr * 64 + fr, fq * 8), boff = lds_byte(wc * 32 + fr, fq * 8);
#define PG8_SA(b, h) (((b) * 2 + (h)) * HTB)
#define PG8_SB(b, h) ((4 + (b) * 2 + (h)) * HTB)
#define PG8_STAGE(bufoff, gbase, voff) do { _Pragma("unroll") for (int _i = 0; _i < 2; ++_i) \
        __builtin_amdgcn_global_load_lds((const unsigned*)((const char*)(gbase) + (voff)[_i]), (LAS unsigned*)(lds + (bufoff) + ldsw + _i * 8192), 16, 0, 0); } while (0)
#define PG8_LDA(dst, b, h) do { _Pragma("unroll") for (int m = 0; m < 4; ++m) _Pragma("unroll") for (int k = 0; k < 2; ++k) dst[m][k] = *(const LAS bf16x8*)(lds + PG8_SA(b, h) + aoff + m * 2048 + k * 1024); } while (0)
#define PG8_LDB(dst, b, h) do { _Pragma("unroll") for (int n = 0; n < 2; ++n) _Pragma("unroll") for (int k = 0; k < 2; ++k) dst[n][k] = *(const LAS bf16x8*)(lds + PG8_SB(b, h) + boff + n * 2048 + k * 1024); } while (0)
#define PG8_MMA(ai, bj, At, Bt) do { __builtin_amdgcn_s_setprio(1); _Pragma("unroll") for (int m = 0; m < 4; ++m) _Pragma("unroll") for (int n = 0; n < 2; ++n) _Pragma("unroll") for (int k = 0; k < 2; ++k) \
        acc[ai][bj][m][n] = __builtin_amdgcn_mfma_f32_16x16x32_bf16(Bt[n][k], At[m][k], acc[ai][bj][m][n], 0, 0, 0); __builtin_amdgcn_s_setprio(0); } while (0)
#define PG8_WAIT_V(n) asm volatile("s_waitcnt vmcnt(" #n ")" ::: "memory")
#define PG8_WAIT_L(n) asm volatile("s_waitcnt lgkmcnt(" #n ")" ::: "memory")
#define PG8_BAR __builtin_amdgcn_s_barrier()
#define PG8_SCHED __builtin_amdgcn_sched_barrier(0)
    Unit cur, nxt; int ui = 0;
    if (!S.next(0, cur)) return;
    f32x4 acc[2][2][4][2];
#pragma unroll
    for (int a = 0; a < 2; ++a)
#pragma unroll
        for (int b = 0; b < 2; ++b)
#pragma unroll
            for (int m = 0; m < 4; ++m)
#pragma unroll
                for (int n = 0; n < 2; ++n) acc[a][b][m][n] = (f32x4){0.f, 0.f, 0.f, 0.f};
    bf16x8 At[4][2], B0[2][2], B1[2][2];
    const char* cA = (const char*)g.A + cur.aoff; const char* cB = (const char*)g.Bt + cur.boff;
    if constexpr (SP2) {
        PG8_STAGE(PG8_SB(0, 0), cB, voffB); PG8_STAGE(PG8_SB(0, 1), cB + hstepB, voffB); PG8_STAGE(PG8_SA(0, 0), cA, voffA); PG8_STAGE(PG8_SA(0, 1), cA + hstepA, voffA);
        if (wr == 1) PG8_BAR;
        PG8_WAIT_V(2); PG8_BAR;
        PG8_STAGE(PG8_SB(1, 0), cB + kstep, voffB); PG8_STAGE(PG8_SA(1, 0), cA + kstep, voffA); PG8_STAGE(PG8_SB(1, 1), cB + hstepB + kstep, voffB);
        PG8_WAIT_V(6); PG8_BAR;
    } else {
        PG8_STAGE(PG8_SB(0, 0), cB, voffB); PG8_STAGE(PG8_SA(0, 0), cA, voffA); PG8_STAGE(PG8_SB(0, 1), cB + hstepB, voffB); PG8_STAGE(PG8_SA(0, 1), cA + hstepA, voffA);
        if (wr == 1) PG8_BAR;
        PG8_WAIT_V(4); PG8_BAR;
        PG8_STAGE(PG8_SB(1, 0), cB + kstep, voffB); PG8_STAGE(PG8_SA(1, 0), cA + kstep, voffA); PG8_STAGE(PG8_SB(1, 1), cB + hstepB + kstep, voffB);
        PG8_WAIT_V(6); PG8_BAR;
    }
    for (;;) {
        const bool has_next = S.next(ui + 1, nxt);
        const char* nA = has_next ? (const char*)g.A + nxt.aoff : cA; const char* nB = has_next ? (const char*)g.Bt + nxt.boff : cB;
        for (int t = 0; t < nt; t += 2) {
            const bool last = (t == nt - 2);
            const char* a1 = cA + (size_t)(t + 1) * kstep;
            const char* a2 = last ? nA : cA + (size_t)(t + 2) * kstep; const char* b2 = last ? nB : cB + (size_t)(t + 2) * kstep;
            const char* a3 = a2 + kstep; const char* b3 = b2 + kstep;
            if constexpr (SP2) {
            PG8_LDB(B0, 0, 0); PG8_LDB(B1, 0, 1); PG8_SCHED; PG8_LDA(At, 0, 0); PG8_STAGE(PG8_SA(1, 1), a1 + hstepA, voffA);
            PG8_WAIT_V(8); PG8_WAIT_L(0); PG8_BAR; PG8_MMA(0, 0, At, B0); PG8_MMA(0, 1, At, B1); PG8_BAR; PG8_SCHED;
            PG8_LDA(At, 0, 1); PG8_STAGE(PG8_SB(0, 0), b2, voffB); PG8_STAGE(PG8_SB(0, 1), b2 + hstepB, voffB); PG8_STAGE(PG8_SA(0, 0), a2, voffA);
            PG8_WAIT_V(8); PG8_WAIT_L(0); PG8_BAR; PG8_MMA(1, 0, At, B0); PG8_MMA(1, 1, At, B1); PG8_BAR; PG8_SCHED;
            PG8_LDB(B0, 1, 0); PG8_LDB(B1, 1, 1); PG8_SCHED; PG8_LDA(At, 1, 0); PG8_STAGE(PG8_SA(0, 1), a2 + hstepA, voffA);
            PG8_WAIT_V(8); PG8_WAIT_L(0); PG8_BAR; PG8_MMA(0, 0, At, B0); PG8_MMA(0, 1, At, B1); PG8_BAR; PG8_SCHED;
            PG8_LDA(At, 1, 1); PG8_STAGE(PG8_SB(1, 0), b3, voffB); PG8_STAGE(PG8_SB(1, 1), b3 + hstepB, voffB); PG8_STAGE(PG8_SA(1, 0), a3, voffA);
            PG8_WAIT_V(8); PG8_WAIT_L(0); PG8_BAR; PG8_MMA(1, 0, At, B0); PG8_MMA(1, 1, At, B1); PG8_BAR; PG8_SCHED;
            } else {
            PG8_LDB(B0, 0, 0); PG8_SCHED; PG8_LDA(At, 0, 0); PG8_STAGE(PG8_SA(1, 1), a1 + hstepA, voffA);
            PG8_WAIT_L(8); PG8_BAR; PG8_WAIT_L(0); PG8_MMA(0, 0, At, B0); PG8_BAR; PG8_SCHED;
            PG8_LDB(B1, 0, 1); PG8_STAGE(PG8_SB(0, 0), b2, voffB);
            PG8_BAR; PG8_WAIT_L(0); PG8_MMA(0, 1, At, B1); PG8_BAR;
            PG8_LDA(At, 0, 1); PG8_STAGE(PG8_SA(0, 0), a2, voffA);
            PG8_BAR; PG8_WAIT_L(0); PG8_MMA(1, 0, At, B0); PG8_BAR; PG8_SCHED;
            PG8_STAGE(PG8_SB(0, 1), b2 + hstepB, voffB);
            PG8_WAIT_V(6); PG8_BAR; PG8_MMA(1, 1, At, B1); PG8_BAR;
            PG8_LDB(B0, 1, 0); PG8_SCHED; PG8_LDA(At, 1, 0); PG8_STAGE(PG8_SA(0, 1), a2 + hstepA, voffA);
            PG8_WAIT_L(8); PG8_BAR; PG8_WAIT_L(0); PG8_MMA(0, 0, At, B0); PG8_BAR; PG8_SCHED;
            PG8_LDB(B1, 1, 1); PG8_STAGE(PG8_SB(1, 0), b3, voffB);
            PG8_BAR; PG8_WAIT_L(0); PG8_MMA(0, 1, At, B1); PG8_BAR;
            PG8_LDA(At, 1, 1); PG8_STAGE(PG8_SA(1, 0), a3, voffA);
            PG8_BAR; PG8_WAIT_L(0); PG8_MMA(1, 0, At, B0); PG8_BAR; PG8_SCHED;
            PG8_STAGE(PG8_SB(1, 1), b3 + hstepB, voffB);
            PG8_WAIT_V(6); PG8_BAR; PG8_MMA(1, 1, At, B1); PG8_BAR;
            }
        }
        if constexpr (ALIGN_EPI) { if (wr == 0) PG8_BAR; }
        const bool keep = E(acc, cur, wr, wc, fr, fq);
        if (!has_next) break;
        if (!keep) {
#pragma unroll
        for (int a = 0; a < 2; ++a)
#pragma unroll
            for (int b = 0; b < 2; ++b)
#pragma unroll
                for (int m = 0; m < 4; ++m)
#pragma unroll
                    for (int n = 0; n < 2; ++n) acc[a][b][m][n] = (f32x4){0.f, 0.f, 0.f, 0.f};
        }
        cur = nxt; cA = nA; cB = nB; ++ui;
        if constexpr (ALIGN_EPI) { if (wr == 1) PG8_BAR; }
    }
    PG8_WAIT_V(0);
    if constexpr (!ALIGN_EPI) { if (wr == 0) PG8_BAR; }
    PG8_BAR;
#undef PG8_SA
#undef PG8_SB
#undef PG8_STAGE
#undef PG8_LDA
#undef PG8_LDB
#undef PG8_MMA
#undef PG8_WAIT_V
#undef PG8_WAIT_L
#undef PG8_BAR
#undef PG8_SCHED
}
}
typedef f32x4 Acc[2][2][4][2];
using pg8::Unit;

__device__ __forceinline__ void st8(bf16_t* p, const f32x4 a, const f32x4 b) { u32x4 w; w.x = cvtpk(a[0], a[1]); w.y = cvtpk(a[2], a[3]); w.z = cvtpk(b[0], b[1]); w.w = cvtpk(b[2], b[3]); *(u32x4*)p = w; }

struct EpiQKV {
    unsigned char* ws; const float* ss; const float* gka;
    __device__ __forceinline__ bool operator()(Acc& acc, const Unit& u, int wr, int wc, int fr, int fq) const {
        const int G = 4 * u.pn + wc;
        if (G >= 45) return false;
        unsigned dmib; int ld, g0, op;
        if (G < 8) { dmib = WS_QA / MiB; ld = 512; g0 = 0; op = 1; }
        else if (G < 10) { dmib = WS_KA / MiB; ld = 128; g0 = 8; op = 2; }
        else if (G < 12) { dmib = WS_VA / MiB; ld = 128; g0 = 10; op = 0; }
        else if (G < 16) { dmib = WS_QB / MiB; ld = 256; g0 = 12; op = 3; }
        else if (G < 20) { dmib = WS_KB / MiB; ld = 256; g0 = 16; op = 0; }
        else if (G < 28) { dmib = WS_VB / MiB; ld = 512; g0 = 20; op = 0; }
        else if (G < 36) { dmib = WS_OG / MiB; ld = 512; g0 = 28; op = 4; }
        else if (G < 44) { dmib = WS_QM / MiB; ld = 512; g0 = 36; op = 0; }
        else { dmib = WS_LR / MiB; ld = 32; g0 = 44; op = 5; }
        bf16_t* base = (bf16_t*)(ws + (size_t)dmib * MiB); const int col = 64 * (G - g0);
        f32x4 gk[2][2];
#pragma unroll
        for (int bj = 0; bj < 2; ++bj)
#pragma unroll
            for (int n = 0; n < 2; ++n) {
                gk[bj][n] = (f32x4){1.f, 1.f, 1.f, 1.f};
                if (op == 2) { const int d = 32 * bj + 8 * fq + 4 * n; gk[bj][n] = *(const f32x4*)(gka + d); }
            }
        const int row0 = u.pm * 256 + wr * 64 + fr;
#pragma unroll
        for (int ai = 0; ai < 2; ++ai)
#pragma unroll
            for (int m = 0; m < 4; ++m) {
                const int row = row0 + ai * 128 + m * 16;
                const float rs = __builtin_amdgcn_rsqf(ss[row] * (1.0f / DM) + EPS);
                f32x4 v[2][2];
#pragma unroll
                for (int bj = 0; bj < 2; ++bj)
#pragma unroll
                    for (int n = 0; n < 2; ++n) v[bj][n] = acc[ai][bj][m][n] * rs;
                if (op == 1 || op == 2) {
                    float s = 0.f;
#pragma unroll
                    for (int bj = 0; bj < 2; ++bj)
#pragma unroll
                        for (int n = 0; n < 2; ++n) { const f32x4 x = v[bj][n]; s += (x[0] * x[0] + x[1] * x[1]) + (x[2] * x[2] + x[3] * x[3]); }
                    s += __shfl_xor(s, 16); s += __shfl_xor(s, 32);
                    const float r2 = __builtin_amdgcn_rsqf(s * (1.0f / 64.0f) + EPS);
#pragma unroll
                    for (int bj = 0; bj < 2; ++bj)
#pragma unroll
                        for (int n = 0; n < 2; ++n) v[bj][n] = v[bj][n] * r2 * gk[bj][n];
                } else if (op == 3) {
#pragma unroll
                    for (int bj = 0; bj < 2; ++bj)
#pragma unroll
                        for (int n = 0; n < 2; ++n) v[bj][n] = v[bj][n] * 0.125f;
                } else if (op == 4) {
#pragma unroll
                    for (int bj = 0; bj < 2; ++bj)
#pragma unroll
                        for (int n = 0; n < 2; ++n)
#pragma unroll
                            for (int e = 0; e < 4; ++e) v[bj][n][e] = siluf_(v[bj][n][e]);
                }
                bf16_t* rp = base + (size_t)row * ld + col + 8 * fq;
                st8(rp, v[0][0], v[0][1]);
                if (op != 5) st8(rp + 32, v[1][0], v[1][1]);
            }
        return false;
    }
};
template <int ACT> struct EpiRowScale {
    bf16_t* O; int ldc; size_t sub_stride; const float* ss;
    __device__ __forceinline__ bool operator()(Acc& acc, const Unit& u, int wr, int wc, int fr, int fq) const {
        const int row0 = u.pm * 256 + wr * 64 + fr, col0 = u.pn * 256 + wc * 32 + 8 * fq;
        bf16_t* base = O + (size_t)u.sub * sub_stride;
#pragma unroll
        for (int ai = 0; ai < 2; ++ai)
#pragma unroll
            for (int m = 0; m < 4; ++m) {
                const int row = row0 + ai * 128 + m * 16;
                const float rs = __builtin_amdgcn_rsqf(ss[row] * (1.0f / DM) + EPS);
#pragma unroll
                for (int bj = 0; bj < 2; ++bj) {
                    f32x4 a = acc[ai][bj][m][0] * rs, b = acc[ai][bj][m][1] * rs;
                    if (ACT == 1) {
#pragma unroll
                        for (int e = 0; e < 4; ++e) { a[e] = sigmoidf_(a[e]); b[e] = sigmoidf_(b[e]); }
                    }
                    st8(base + (size_t)row * ldc + col0 + bj * 128, a, b);
                }
            }
        return false;
    }
};
struct EpiMerge {
    const bf16_t* GT; bf16_t* O;
    __device__ __forceinline__ bool operator()(Acc& acc, const Unit& u, int wr, int wc, int fr, int fq) const {
        const int row0 = u.pm * 256 + wr * 64 + fr, col0 = u.pn * 256 + wc * 32 + 8 * fq;
        const int sub = u.sub;
#pragma unroll
        for (int ai = 0; ai < 2; ++ai)
#pragma unroll
            for (int m = 0; m < 4; ++m) {
                const int row = row0 + ai * 128 + m * 16;
#pragma unroll
                for (int bj = 0; bj < 2; ++bj) {
                    const bf16_t* gp = GT + (size_t)row * 3072 + sub * 1024 + col0 + bj * 128;
                    const u32x4 ga = *(const u32x4*)gp;
                    float f[8] = {bflo(ga.x), bfhi(ga.x), bflo(ga.y), bfhi(ga.y), bflo(ga.z), bfhi(ga.z), bflo(ga.w), bfhi(ga.w)};
                    if (sub < 2) {
                        const u32x4 gb = *(const u32x4*)(gp + 1024);
                        const float d[8] = {bflo(gb.x), bfhi(gb.x), bflo(gb.y), bfhi(gb.y), bflo(gb.z), bfhi(gb.z), bflo(gb.w), bfhi(gb.w)};
#pragma unroll
                        for (int e = 0; e < 8; ++e) f[e] = f[e] * __builtin_amdgcn_rcpf(fmaxf(d[e], 1e-30f));
                    }
                    f32x4 a = acc[ai][bj][m][0], b = acc[ai][bj][m][1];
#pragma unroll
                    for (int e = 0; e < 4; ++e) { a[e] *= f[e]; b[e] *= f[4 + e]; }
                    acc[ai][bj][m][0] = a; acc[ai][bj][m][1] = b;
                    if (sub == 2) st8(O + (size_t)row * DM + col0 + bj * 128, a, b);
                }
            }
        return sub < 2;
    }
};
struct EpiRes {
    const float* xin; float* xout; bf16_t* XB; float* ss;
    __device__ __forceinline__ bool operator()(Acc& acc, const Unit& u, int wr, int wc, int fr, int fq) const {
        const int row0 = u.pm * 256 + wr * 64 + fr, col0 = u.pn * 256 + wc * 32 + 8 * fq;
#pragma unroll
        for (int ai = 0; ai < 2; ++ai)
#pragma unroll
            for (int m = 0; m < 4; ++m) {
                const int row = row0 + ai * 128 + m * 16; float s = 0.f;
#pragma unroll
                for (int bj = 0; bj < 2; ++bj) {
                    const size_t off = (size_t)row * DM + col0 + bj * 128;
                    const f32x4 a = *(const f32x4*)(xin + off) + acc[ai][bj][m][0], b = *(const f32x4*)(xin + off + 4) + acc[ai][bj][m][1];
                    *(f32x4*)(xout + off) = a; *(f32x4*)(xout + off + 4) = b;
                    if (XB) { st8(XB + off, a, b); s += (a[0] * a[0] + a[1] * a[1]) + (a[2] * a[2] + a[3] * a[3]) + (b[0] * b[0] + b[1] * b[1]) + (b[2] * b[2] + b[3] * b[3]); }
                }
                if (XB) { s += __shfl_xor(s, 16); s += __shfl_xor(s, 32); if (fq == 0) atomicAdd(ss + row, s); }
            }
        return false;
    }
};
struct EpiFFN {
    bf16_t* H; const float* ss;
    __device__ __forceinline__ bool operator()(Acc& acc, const Unit& u, int wr, int wc, int fr, int fq) const {
        const int row0 = u.pm * 256 + wr * 64 + fr, col0 = u.pn * 128 + wc * 32 + 8 * fq;
#pragma unroll
        for (int ai = 0; ai < 2; ++ai)
#pragma unroll
            for (int m = 0; m < 4; ++m) {
                const int row = row0 + ai * 128 + m * 16;
                const float rs = __builtin_amdgcn_rsqf(ss[row] * (1.0f / DM) + EPS);
                f32x4 h[2];
#pragma unroll
                for (int n = 0; n < 2; ++n)
#pragma unroll
                    for (int e = 0; e < 4; ++e) { const float gt = acc[ai][0][m][n][e] * rs, up = acc[ai][1][m][n][e] * rs; h[n][e] = siluf_(gt) * up; }
                st8(H + (size_t)row * DFF + col0, h[0], h[1]);
            }
        return false;
    }
};

typedef GAS unsigned gu32;
#define XB_TMO      128
#define XB_XCNT(j)  (256  + 64 * (j))
#define XB_XSUB(j)  (1280 + 64 * (j))
#define XB_XGEN(j)  (2304 + 64 * (j))
#define XB_TOP      3328
#define XB_TOPGEN   3392
#define XCD_BAR_WORDS 3456
#define XB_SPIN_CAP (1u << 22)
__device__ __forceinline__ unsigned xb_ld(unsigned* p)              { return __hip_atomic_load(p, __ATOMIC_RELAXED, __HIP_MEMORY_SCOPE_AGENT); }
__device__ __forceinline__ unsigned xb_add(unsigned* p, unsigned v) { return __hip_atomic_fetch_add(p, v, __ATOMIC_RELAXED, __HIP_MEMORY_SCOPE_AGENT); }
__device__ __forceinline__ unsigned xb_xcc_id() { return (unsigned)__builtin_amdgcn_s_getreg((3 << 11) | 20) & 0xFu; }
#define XB_SPIN(cond, bar) do { unsigned _sp = 0; while (cond) { __builtin_amdgcn_s_sleep(1); \
    if ((++_sp & 255u) == 0u) { if (xb_ld(&(bar)[XB_TMO])) break; if (_sp > XB_SPIN_CAP) { atomicAdd(&(bar)[XB_TMO], 1u); break; } } } } while (0)
struct XcdBarrier { unsigned* bar; unsigned x; volatile LAS unsigned* st; };
__device__ __forceinline__ XcdBarrier xcd_barrier_post(unsigned* bar, volatile LAS unsigned* st) {
    XcdBarrier b; b.bar = bar; b.x = xb_xcc_id(); b.st = st;
    if (threadIdx.x == 0) (void)xb_add(&bar[XB_XCNT(b.x)], 1u);
    return b;
}
__device__ __forceinline__ void xcd_barrier_complete(unsigned* bar, unsigned x, unsigned& nloc, unsigned& nx) {
    const unsigned G = gridDim.x * gridDim.y * gridDim.z;
    unsigned sum, cnt, mine, sp = 0u;
    for (;;) {
        sum = 0u; cnt = 0u; mine = 0u;
#pragma unroll
        for (unsigned j = 0; j < 16; ++j) { const unsigned c = xb_ld(&bar[XB_XCNT(j)]); sum += c; cnt += (c > 0u) ? 1u : 0u; mine = (j == x) ? c : mine; }
        if (sum == G) break;
        __builtin_amdgcn_s_sleep(1);
        if ((++sp & 255u) == 0u) { if (xb_ld(&bar[XB_TMO])) break; if (sp > XB_SPIN_CAP) { atomicAdd(&bar[XB_TMO], 1u); break; } }
    }
    nloc = mine > 0u ? mine : 1u; nx = cnt > 0u ? cnt : 1u;
}
__device__ __forceinline__ void xcd_barrier(const XcdBarrier& b) {
    asm volatile("s_waitcnt vmcnt(0)" ::: "memory");
    __syncthreads();
    if (threadIdx.x == 0) {
        unsigned* bar = b.bar;
        __builtin_amdgcn_s_waitcnt(0);
        unsigned nloc = b.st[0], nx = b.st[1];
        if (nloc == 0u) { xcd_barrier_complete(bar, b.x, nloc, nx); b.st[0] = nloc; b.st[1] = nx; }
        const unsigned old = xb_add(&bar[XB_XSUB(b.x)], 1u);
        const unsigned gen = old / nloc;
        if (old + 1u == (gen + 1u) * nloc) {
            __builtin_amdgcn_fence(__ATOMIC_RELEASE, "agent");
            asm volatile("s_waitcnt vmcnt(0)" ::: "memory");
            const unsigned og = xb_add(&bar[XB_TOP], 1u);
            const unsigned tg = og / nx;
            if (og + 1u == (tg + 1u) * nx) xb_add(&bar[XB_TOPGEN], 1u);
            else XB_SPIN(xb_ld(&bar[XB_TOPGEN]) == tg, bar);
            __builtin_amdgcn_fence(__ATOMIC_ACQUIRE, "agent");
            xb_add(&bar[XB_XGEN(b.x)], 1u);
            asm volatile("s_waitcnt vmcnt(0)" ::: "memory");
        } else {
            XB_SPIN(xb_ld(&bar[XB_XGEN(b.x)]) == gen, bar);
            __builtin_amdgcn_fence(__ATOMIC_ACQUIRE, "agent");
            asm volatile("s_waitcnt vmcnt(0)" ::: "memory");
        }
    }
    __syncthreads();
}

struct Args { const float* in[20]; float* out; unsigned char* ws; int ph_lo, ph_hi; };
struct Frame {
    LAS unsigned char* lds; unsigned char* ws; int tid, lane, wave, G, bid;
    float* out;
};
__device__ __forceinline__ const float* par(const Frame& F, int l, int off) { return (const float*)(F.ws + WS_PAR) + l * PAR_LAYER + off; }
enum { I_X = 0, I_MEM, I_RELB, I_NMIX, I_NFFN, I_NMEM, I_WIN, I_QNA, I_KNA, I_SINK, I_WDU, I_BDEC, I_GLAG, I_WMKV, I_QNM, I_KNM, I_WBR, I_WOUT, I_WFI, I_WFO };

__device__ __forceinline__ float wave_sum(float v) {
#pragma unroll
    for (int o = 1; o < 64; o <<= 1) v += __shfl_xor(v, o);
    return v;
}

__device__ __forceinline__ void tr_item(const float* W, int ldw, int s0, int k0, bf16_t* Bt, int ldb, int n0, int kd0, const float* gain, LAS float* scr, int lane) {
#pragma unroll 8
    for (int i = 0; i < 32; ++i) { const int kk = 2 * i + (lane >> 5); float v = 0.f; if (s0 >= 0) { v = W[(size_t)(k0 + kk) * ldw + s0 + (lane & 31)]; if (gain) v *= gain[k0 + kk]; } scr[kk * 33 + (lane & 31)] = v; }
    asm volatile("s_waitcnt lgkmcnt(0)" ::: "memory");
    const int c = lane & 7;
#pragma unroll
    for (int j = 0; j < 4; ++j) { const int n = (lane >> 3) + 8 * j; const LAS float* s = scr + (8 * c) * 33 + n;
        u32x4 o; o.x = cvtpk(s[0 * 33], s[1 * 33]); o.y = cvtpk(s[2 * 33], s[3 * 33]); o.z = cvtpk(s[4 * 33], s[5 * 33]); o.w = cvtpk(s[6 * 33], s[7 * 33]);
        *(u32x4*)(Bt + (size_t)(n0 + n) * ldb + kd0 + k0 + 8 * c) = o; }
    asm volatile("s_waitcnt lgkmcnt(0)" ::: "memory");
}
__device__ __forceinline__ int ina_src(int n0) {
    const int pn = n0 >> 8, c = n0 & 255, bj = c >> 7, wc = (c >> 5) & 3;
    const int x = 64 * (4 * pn + wc) + 32 * bj;
    if (x < 2304) return x;
    if (x < 2816) return x + 32;
    if (x < 2848) return 2304 + (x - 2816);
    return -1;
}
__device__ __forceinline__ void p0_prologue(Frame& F, const Args& A) {
    LAS float* scr = (LAS float*)(F.lds + F.wave * 16384);
    const int gw = F.bid * 8 + F.wave, NGW = F.G * 8;
    constexpr int I_A = 96 * 16, I_G = 96 * 16, I_M = 32 * 16, I_B = 3 * 32 * 8, I_O = 32 * 16, I_FI = 176 * 16, I_FO = 32 * 44;
    constexpr int I_LAYER = I_A + I_G + I_M + I_B + I_O + I_FI + I_FO;
    for (int it = gw; it < 2 * I_LAYER; it += NGW) {
        const int l = it / I_LAYER; int r = it - l * I_LAYER;
        unsigned char* wl = F.ws + WS_W + (size_t)l * W_LAYER;
        if (r < I_A) { const int nb = r >> 4, kb = r & 15; tr_item(A.in[I_WIN] + (size_t)l * DM * DIN, DIN, ina_src(32 * nb), 64 * kb, (bf16_t*)(wl + W_INA), DM, 32 * nb, 0, A.in[I_NMIX] + l * DM, scr, F.lane); continue; } r -= I_A;
        if (r < I_G) { const int nb = r >> 4, kb = r & 15; tr_item(A.in[I_WIN] + (size_t)l * DM * DIN, DIN, 2848 + 32 * nb, 64 * kb, (bf16_t*)(wl + W_ING), DM, 32 * nb, 0, A.in[I_NMIX] + l * DM, scr, F.lane); continue; } r -= I_G;
        if (r < I_M) { const int nb = r >> 4, kb = r & 15; tr_item(A.in[I_WMKV] + (size_t)l * DM * 1024, 1024, 32 * nb, 64 * kb, (bf16_t*)(wl + W_MKV), DM, 32 * nb, 0, A.in[I_NMEM] + l * DM, scr, F.lane); continue; } r -= I_M;
        if (r < I_B) { const int j = r / 256, q = r % 256, nb = q >> 3, kb = q & 7; tr_item(A.in[I_WBR] + ((size_t)l * 3 + j) * 512 * DM, DM, 32 * nb, 64 * kb, (bf16_t*)(wl + W_BR), 1536, 32 * nb, 512 * j, nullptr, scr, F.lane); continue; } r -= I_B;
        if (r < I_O) { const int nb = r >> 4, kb = r & 15; tr_item(A.in[I_WOUT] + (size_t)l * DM * DM, DM, 32 * nb, 64 * kb, (bf16_t*)(wl + W_OUT), DM, 32 * nb, 0, nullptr, scr, F.lane); continue; } r -= I_O;
        if (r < I_FI) { const int nb = r >> 4, kb = r & 15, n0 = 32 * nb; const int src = 2816 * ((n0 >> 7) & 1) + 128 * (n0 >> 8) + (n0 & 127);
            tr_item(A.in[I_WFI] + (size_t)l * DM * 2 * DFF, 2 * DFF, src, 64 * kb, (bf16_t*)(wl + W_FI), DM, n0, 0, A.in[I_NFFN] + l * DM, scr, F.lane); continue; } r -= I_FI;
        { const int nb = r / 44, kb = r % 44; tr_item(A.in[I_WFO] + (size_t)l * DFF * DM, DM, 32 * nb, 64 * kb, (bf16_t*)(wl + W_FO), DFF, 32 * nb, 0, nullptr, scr, F.lane); }
    }
    for (int m = gw; m < T + TMEM; m += NGW) {
        const bool ism = m >= T; const int r = ism ? m - T : m;
        const f32x4* xr = (const f32x4*)((ism ? A.in[I_MEM] : A.in[I_X]) + (size_t)r * DM) + F.lane;
        bf16_t* orow = (bf16_t*)(F.ws + (ism ? WS_MB : WS_XB)) + (size_t)r * DM;
        f32x4* xo = (f32x4*)(F.out + (size_t)r * DM) + F.lane;
        float s = 0.f;
#pragma unroll
        for (int j = 0; j < 4; ++j) { const f32x4 v = xr[64 * j]; if (!ism) xo[64 * j] = v; s += (v.x * v.x + v.y * v.y) + (v.z * v.z + v.w * v.w);
            u32x2 w; w.x = cvtpk(v.x, v.y); w.y = cvtpk(v.z, v.w); *(u32x2*)(orow + 256 * j + 4 * F.lane) = w; }
        s = wave_sum(s);
        if (F.lane == 0) ((float*)(F.ws + (ism ? WS_MSS : WS_SS)))[r] = s;
    }
    if (F.bid == 1) {
        for (int i = F.tid; i < 2 * PAR_LAYER; i += 512) {
            const int l = i / PAR_LAYER, o = i % PAR_LAYER; float v = 0.f;
            if (o < 64) v = A.in[I_QNA][l * 64 + o] * A.in[I_KNA][l * 64 + o] * (0.125f * LOG2E);
            else if (o < 72) v = A.in[I_SINK][l * 8 + (o - 64)] * LOG2E;
            else if (o < 128) v = 0.f;
            else if (o < 256) v = A.in[I_QNM][l * 128 + (o - 128)] * A.in[I_KNM][l * 128 + (o - 128)] * (0.08838834764831845f * LOG2E);
            else if (o < 384) v = A.in[I_GLAG][l * 128 + (o - 256)];
            else if (o < 896) v = A.in[I_BDEC][l * 512 + (o - 384)];
            else v = A.in[I_WDU][l * 8192 + (o - 896)];
            ((float*)(F.ws + WS_PAR))[i] = v;
        }
    }
    if (F.bid == 0) {
        for (int i = F.tid; i < 8 * 257; i += 512) {
            const int h = i / 257, rel = i % 257 - 128, n = rel < 0 ? -rel : rel;
            int bk = n < 8 ? n : (2 + (31 - __builtin_clz((unsigned)(n * n)))); if (bk > 15) bk = 15;
            if (rel > 0) bk += 16;
            ((float*)(F.ws + WS_BIAS))[i] = A.in[I_RELB][bk * 8 + h] * LOG2E;
        }
    }
}

__device__ __forceinline__ void winattn_unit(Frame& F, int l, int unit) {
    const int b = unit >> 6, i = (unit >> 1) & 31, kvh = unit & 1;
    const int tid = F.tid, lane = F.lane, r32 = lane & 31, hi = lane >> 5, w = F.wave;
    const bf16_t* KA = (const bf16_t*)(F.ws + WS_KA); const bf16_t* VA = (const bf16_t*)(F.ws + WS_VA); bf16_t* QA = (bf16_t*)(F.ws + WS_QA);
    LAS unsigned char* Kt = F.lds; LAS unsigned char* Vt = F.lds + 49152; LAS float* bias = (LAS float*)(F.lds + 98304);
    LAS float* wsf = (LAS float*)(F.lds + WSF_OFF) + w * 64;
    const int start = 128 * i;
    for (int idx = tid; idx < 3072; idx += 512) {
        const int j = idx >> 3, ch = idx & 7, kpos = start - 128 + j;
        u32x4 kv = {0u, 0u, 0u, 0u}, vv = {0u, 0u, 0u, 0u};
        if (kpos >= 0 && kpos < SEQ) { const size_t off = (size_t)(b * SEQ + kpos) * 128 + kvh * 64 + ch * 8; kv = *(const u32x4*)(KA + off); vv = *(const u32x4*)(VA + off); }
        *(LAS u32x4*)(Kt + j * 128 + ((ch ^ ((j >> 1) & 7)) << 4)) = kv;
        *(LAS u32x4*)(Vt + ((ch >> 2) * 24 + (j >> 4)) * 1024 + (j & 15) * 64 + (ch & 3) * 16) = vv;
    }
    for (int idx = tid; idx < 4 * 257; idx += 512) bias[idx] = ((const float*)(F.ws + WS_BIAS))[(kvh * 4) * 257 + idx];
    __syncthreads();
    const int g = w >> 1, half = w & 1, h = kvh * 4 + g;
    const float sink2 = par(F, l, PAR_SINK)[h];
    const LAS float* bh = bias + g * 257;
    const int vlane = ((lane >> 4) & 1) * 32 + (lane & 3) * 8 + (4 * hi + ((lane & 15) >> 2)) * 64;
#pragma unroll 1
    for (int qq = 0; qq < 2; ++qq) {
        const int qb = 2 * half + qq, t = 32 * qb + r32;
        const size_t qrow = (size_t)(b * SEQ + start + t);
        bf16x8 qf[4];
#pragma unroll
        for (int ds = 0; ds < 4; ++ds) qf[ds] = *(const bf16x8*)(QA + qrow * 512 + h * 64 + 16 * ds + 8 * hi);
        float m = sink2, lsum = (hi == 0) ? 1.0f : 0.0f;
        f32x16 o[2]; o[0] = f32x16{}; o[1] = f32x16{};
#pragma unroll 1
        for (int kt = qb; kt <= qb + 8; ++kt) {
            const int kp0 = start - 128 + 32 * kt;
            if (kp0 + 31 < 0 || kp0 >= SEQ) continue;
            f32x16 s = f32x16{};
#pragma unroll
            for (int ds = 0; ds < 4; ++ds) {
                const int kr = 32 * kt + r32, ch = 2 * ds + hi;
                const bf16x8 kf = *(const LAS bf16x8*)(Kt + kr * 128 + ((ch ^ ((kr >> 1) & 7)) << 4));
                s = MFMA32(kf, qf[ds], s);
            }
            float rm = -1e30f;
#pragma unroll
            for (int r = 0; r < 16; ++r) {
                const int j = 32 * kt + crow(r, hi), rel = j - 128 - t, kpos = start - 128 + j;
                const bool ok = (rel >= -128) && (rel <= 128) && (kpos >= 0) && (kpos < SEQ);
                const int ridx = min(max(rel + 128, 0), 256);
                const float v = ok ? s[r] + bh[ridx] : -1e30f;
                s[r] = v; rm = fmaxf(rm, v);
            }
            rm = swapmax(rm);
            const float mn = fmaxf(m, rm), alpha = ex2(m - mn); m = mn;
            float ps = 0.f;
#pragma unroll
            for (int r = 0; r < 16; ++r) { const float p = ex2(s[r] - mn); s[r] = p; ps += p; }
            lsum = lsum * alpha + ps;
            if (!__all(alpha == 1.0f)) {
                if (hi == 0) wsf[r32] = alpha;
                asm volatile("s_waitcnt lgkmcnt(0)" ::: "memory");
#pragma unroll
                for (int r = 0; r < 16; ++r) { const float a = wsf[crow(r, hi)]; o[0][r] *= a; o[1][r] *= a; }
            }
            const bf16x8 p0 = pack8(s, 0), p1 = pack8(s, 1);
#pragma unroll
            for (int d0 = 0; d0 < 2; ++d0) {
                const LAS char* vb = (const LAS char*)Vt + (d0 * 24 + 2 * kt) * 1024 + vlane;
                const bf16x8 v0 = mk8(vtr(vb), vtr(vb + 512)), v1 = mk8(vtr(vb + 1024), vtr(vb + 1024 + 512));
                o[d0] = MFMA32(p0, v0, o[d0]); o[d0] = MFMA32(p1, v1, o[d0]);
            }
        }
        lsum = swapsum(lsum);
        if (hi == 0) wsf[32 + r32] = __builtin_amdgcn_rcpf(lsum);
        asm volatile("s_waitcnt lgkmcnt(0)" ::: "memory");
        bf16_t* Ob = QA + (size_t)(b * SEQ + start + 32 * qb) * 512 + h * 64 + r32;
#pragma unroll
        for (int r = 0; r < 16; ++r) { const float rl = wsf[32 + crow(r, hi)]; const int orow = crow(r, hi);
#pragma unroll
            for (int d0 = 0; d0 < 2; ++d0) Ob[(size_t)orow * 512 + 32 * d0] = (bf16_t)(cvtpk(o[d0][r] * rl, 0.f) & 0xffffu); }
    }
    __syncthreads();
}

__device__ __forceinline__ void memattn_unit(Frame& F, int l, int unit) {
    const int b = unit >> 5, h = (unit >> 3) & 3, rb = unit & 7;
    const int tid = F.tid, lane = F.lane, r32 = lane & 31, hi = lane >> 5, w = F.wave;
    const bf16_t* KV = (const bf16_t*)(F.ws + WS_KVM) + (size_t)l * TMEM * 1024; bf16_t* QM = (bf16_t*)(F.ws + WS_QM);
    LAS unsigned char* Kt = F.lds; LAS unsigned char* Vt = F.lds + 65536;
    LAS float* wsf = (LAS float*)(F.lds + WSF_OFF) + w * 64;
    const float* gkm = par(F, l, PAR_GKM);
    for (int idx = tid; idx < 4096; idx += 512) {
        const int j = idx >> 4, ch = idx & 15;
        const bf16_t* rp = KV + (size_t)(b * NMEM + j) * 1024 + h * 128 + ch * 8;
        const u32x4 kv = *(const u32x4*)rp, vv = *(const u32x4*)(rp + 512);
        float f[8] = {bflo(kv.x), bfhi(kv.x), bflo(kv.y), bfhi(kv.y), bflo(kv.z), bfhi(kv.z), bflo(kv.w), bfhi(kv.w)};
        float s = 0.f;
#pragma unroll
        for (int e = 0; e < 8; ++e) s += f[e] * f[e];
        s += __shfl_xor(s, 1); s += __shfl_xor(s, 2); s += __shfl_xor(s, 4); s += __shfl_xor(s, 8);
        const float rs = __builtin_amdgcn_rsqf(s * (1.0f / 128.0f) + EPS);
#pragma unroll
        for (int e = 0; e < 8; ++e) f[e] *= rs * gkm[ch * 8 + e];
        u32x4 ko; ko.x = cvtpk(f[0], f[1]); ko.y = cvtpk(f[2], f[3]); ko.z = cvtpk(f[4], f[5]); ko.w = cvtpk(f[6], f[7]);
        *(LAS u32x4*)(Kt + j * 256 + ((ch ^ (j & 15)) << 4)) = ko;
        *(LAS u32x4*)(Vt + ((ch >> 2) * 16 + (j >> 4)) * 1024 + (j & 15) * 64 + (ch & 3) * 16) = vv;
    }
    __syncthreads();
    const int vlane = ((lane >> 4) & 1) * 32 + (lane & 3) * 8 + (4 * hi + ((lane & 15) >> 2)) * 64;
#pragma unroll 1
    for (int qq = 0; qq < 2; ++qq) {
        const size_t q0 = (size_t)b * SEQ + rb * 512 + w * 64 + qq * 32;
        bf16x8 qf[8]; float qs = 0.f;
#pragma unroll
        for (int ds = 0; ds < 8; ++ds) { const u32x4 qv = *(const u32x4*)(QM + (q0 + r32) * 512 + h * 128 + 16 * ds + 8 * hi); qf[ds] = __builtin_bit_cast(bf16x8, qv);
            const float a0 = bflo(qv.x), a1 = bfhi(qv.x), a2 = bflo(qv.y), a3 = bfhi(qv.y), a4 = bflo(qv.z), a5 = bfhi(qv.z), a6 = bflo(qv.w), a7 = bfhi(qv.w);
            qs += (a0 * a0 + a1 * a1) + (a2 * a2 + a3 * a3) + (a4 * a4 + a5 * a5) + (a6 * a6 + a7 * a7); }
        qs = swapsum(qs);
        const float rq = __builtin_amdgcn_rsqf(qs * (1.0f / 128.0f) + EPS);
        float m = -1e30f, lsum = 0.f;
        f32x16 o[4]; o[0] = f32x16{}; o[1] = f32x16{}; o[2] = f32x16{}; o[3] = f32x16{};
#pragma unroll 1
        for (int kt = 0; kt < 8; ++kt) {
            f32x16 s = f32x16{};
#pragma unroll
            for (int ds = 0; ds < 8; ++ds) {
                const int kr = 32 * kt + r32, ch = 2 * ds + hi;
                const bf16x8 kf = *(const LAS bf16x8*)(Kt + kr * 256 + ((ch ^ (kr & 15)) << 4));
                s = MFMA32(kf, qf[ds], s);
            }
            float rm = -1e30f;
#pragma unroll
            for (int r = 0; r < 16; ++r) { s[r] *= rq; rm = fmaxf(rm, s[r]); }
            rm = swapmax(rm);
            const float mn = fmaxf(m, rm), alpha = ex2(m - mn); m = mn;
            float ps = 0.f;
#pragma unroll
            for (int r = 0; r < 16; ++r) { const float p = ex2(s[r] - mn); s[r] = p; ps += p; }
            lsum = lsum * alpha + ps;
            if (!__all(alpha == 1.0f)) {
                if (hi == 0) wsf[r32] = alpha;
                asm volatile("s_waitcnt lgkmcnt(0)" ::: "memory");
#pragma unroll
                for (int r = 0; r < 16; ++r) { const float a = wsf[crow(r, hi)]; o[0][r] *= a; o[1][r] *= a; o[2][r] *= a; o[3][r] *= a; }
            }
            const bf16x8 p0 = pack8(s, 0), p1 = pack8(s, 1);
#pragma unroll
            for (int d0 = 0; d0 < 4; ++d0) {
                const LAS char* vb = (const LAS char*)Vt + (d0 * 16 + 2 * kt) * 1024 + vlane;
                const bf16x8 v0 = mk8(vtr(vb), vtr(vb + 512)), v1 = mk8(vtr(vb + 1024), vtr(vb + 1024 + 512));
                o[d0] = MFMA32(p0, v0, o[d0]); o[d0] = MFMA32(p1, v1, o[d0]);
            }
        }
        lsum = swapsum(lsum);
        if (hi == 0) wsf[32 + r32] = __builtin_amdgcn_rcpf(lsum);
        asm volatile("s_waitcnt lgkmcnt(0)" ::: "memory");
        bf16_t* Ob = QM + q0 * 512 + h * 128 + r32;
#pragma unroll
        for (int r = 0; r < 16; ++r) { const float rl = wsf[32 + crow(r, hi)]; const int orow = crow(r, hi);
#pragma unroll
            for (int d0 = 0; d0 < 4; ++d0) Ob[(size_t)orow * 512 + 32 * d0] = (bf16_t)(cvtpk(o[d0][r] * rl, 0.f) & 0xffffu); }
    }
    __syncthreads();
}

__device__ __forceinline__ void st_tile(unsigned* p, const f32x16& x, int lane) {
#pragma unroll
    for (int i = 0; i < 8; ++i) p[i * 64 + lane] = cvtpk(x[2 * i], x[2 * i + 1]);
}
__device__ __forceinline__ void ld_tile_add(const unsigned* p, f32x16& x, int lane) {
#pragma unroll
    for (int i = 0; i < 8; ++i) { const unsigned w = p[i * 64 + lane]; x[2 * i] += bflo(w); x[2 * i + 1] += bfhi(w); }
}
__device__ __forceinline__ float wave_prefix(float v, int lane) {
#pragma unroll
    for (int o = 1; o < 64; o <<= 1) { const float t = __shfl_up(v, o); if (lane >= o) v += t; }
    return v;
}
__device__ __forceinline__ void gla_intra_unit(Frame& F, int l, int unit) {
    const int b = unit >> 8, n = (unit >> 2) & 63, h = unit & 3;
    const int tid = F.tid, lane = F.lane, r32 = lane & 31, hi = lane >> 5, w = F.wave;
    const size_t m0 = (size_t)b * SEQ + 64 * n;
    const bf16_t* QB = (const bf16_t*)(F.ws + WS_QB); const bf16_t* KB = (const bf16_t*)(F.ws + WS_KB); const bf16_t* VB = (const bf16_t*)(F.ws + WS_VB); const bf16_t* LR = (const bf16_t*)(F.ws + WS_LR);
    bf16_t* QD = (bf16_t*)(F.ws + WS_QD);
    LAS unsigned char* L = F.lds;
    for (int idx = tid; idx < 1024; idx += 512) { const int j = idx >> 4, ch = idx & 15;
        const u32x4 vv = *(const u32x4*)(VB + (m0 + j) * 512 + h * 128 + ch * 8);
        *(LAS u32x4*)(L + 49152 + ((ch >> 2) * 4 + (j >> 4)) * 1024 + (j & 15) * 64 + (ch & 3) * 16) = vv; }
    {
        const int c = lane;
        float lrf[32];
        { const u32x4* lp = (const u32x4*)(LR + (m0 + c) * 32);
#pragma unroll
          for (int q = 0; q < 4; ++q) { const u32x4 x = lp[q]; lrf[8 * q + 0] = bflo(x.x); lrf[8 * q + 1] = bfhi(x.x); lrf[8 * q + 2] = bflo(x.y); lrf[8 * q + 3] = bfhi(x.y); lrf[8 * q + 4] = bflo(x.z); lrf[8 * q + 5] = bfhi(x.z); lrf[8 * q + 6] = bflo(x.w); lrf[8 * q + 7] = bfhi(x.w); } }
        const u32x4 q8 = *(const u32x4*)(QB + (m0 + c) * 256 + h * 64 + 8 * w), k8 = *(const u32x4*)(KB + (m0 + c) * 256 + h * 64 + 8 * w);
        const float qv[8] = {bflo(q8.x), bfhi(q8.x), bflo(q8.y), bfhi(q8.y), bflo(q8.z), bfhi(q8.z), bflo(q8.w), bfhi(q8.w)};
        const float kv[8] = {bflo(k8.x), bfhi(k8.x), bflo(k8.y), bfhi(k8.y), bflo(k8.z), bfhi(k8.z), bflo(k8.w), bfhi(k8.w)};
        const float* wu = par(F, l, PAR_WDU); const float* bd = par(F, l, PAR_BDEC);
        float* DEC = (float*)(F.ws + WS_DEC) + (size_t)unit * 128;
#pragma unroll
        for (int dir = 0; dir < 2; ++dir) {
            float qd[8], kd[8], ke[8];
#pragma unroll
            for (int d = 0; d < 8; ++d) {
                const int dd = h * 64 + 8 * w + d;
                float lg = bd[dir * 256 + dd];
#pragma unroll
                for (int r = 0; r < 16; ++r) lg += lrf[dir * 16 + r] * wu[(dir * 16 + r) * 256 + dd];
                const float tt = ex2(-fabsf(lg) * LOG2E);
                const float la2 = (fminf(lg, 0.f) * LOG2E - __builtin_amdgcn_logf(1.0f + tt)) * (1.0f / 16.0f);
                const float pre = wave_prefix(la2, lane);
                const float tot = __shfl(pre, 63);
                const float bb = dir == 0 ? pre : (tot - pre + la2);
                const float e1 = ex2(bb), e2 = ex2(-bb), e3 = ex2(tot - bb);
                qd[d] = qv[d] * e1; kd[d] = kv[d] * e2; ke[d] = kv[d] * e3;
                if (lane == 0) DEC[dir * 64 + 8 * w + d] = ex2(tot);
            }
            u32x4 a, bq, cq;
            a.x = cvtpk(qd[0], qd[1]); a.y = cvtpk(qd[2], qd[3]); a.z = cvtpk(qd[4], qd[5]); a.w = cvtpk(qd[6], qd[7]);
            bq.x = cvtpk(kd[0], kd[1]); bq.y = cvtpk(kd[2], kd[3]); bq.z = cvtpk(kd[4], kd[5]); bq.w = cvtpk(kd[6], kd[7]);
            cq.x = cvtpk(ke[0], ke[1]); cq.y = cvtpk(ke[2], ke[3]); cq.z = cvtpk(ke[4], ke[5]); cq.w = cvtpk(ke[6], ke[7]);
            *(u32x4*)(QD + ((size_t)dir * T + m0 + c) * 256 + h * 64 + 8 * w) = a;
            const int kso = c * 128 + ((w ^ ((c >> 1) & 7)) << 4);
            *(LAS u32x4*)(L + dir * 16384 + kso) = a;
            *(LAS u32x4*)(L + dir * 16384 + 8192 + kso) = bq;
            *(LAS u32x4*)(L + 32768 + dir * 8192 + ((w >> 2) * 4 + (c >> 4)) * 1024 + (c & 15) * 64 + (w & 3) * 16) = cq;
        }
    }
    __syncthreads();
    const int vperm = ((lane >> 4) & 1) * 32 + (lane & 3) * 8 + (4 * hi + ((lane & 15) >> 2)) * 64;
    const int vnat = ((lane >> 4) & 1) * 32 + (lane & 3) * 8 + (8 * hi + ((lane & 15) >> 2)) * 64;
    {
        const int ct = w & 1, dvt = w >> 1;
        f32x16 o = f32x16{};
#pragma unroll
        for (int dir = 0; dir < 2; ++dir)
#pragma unroll
            for (int st = 0; st < 2; ++st) {
                if ((dir == 0 && st > ct) || (dir == 1 && st < ct)) continue;
                f32x16 x = f32x16{};
#pragma unroll
                for (int ds = 0; ds < 4; ++ds) {
                    const int sr = 32 * st + r32, cr = 32 * ct + r32, ch = 2 * ds + hi;
                    const bf16x8 kf = *(const LAS bf16x8*)(L + dir * 16384 + 8192 + sr * 128 + ((ch ^ ((sr >> 1) & 7)) << 4));
                    const bf16x8 qf = *(const LAS bf16x8*)(L + dir * 16384 + cr * 128 + ((ch ^ ((cr >> 1) & 7)) << 4));
                    x = MFMA32(kf, qf, x);
                }
                if (st == ct) {
#pragma unroll
                    for (int r = 0; r < 16; ++r) { const int s_ = crow(r, hi), c_ = r32; const bool keepv = dir == 0 ? (s_ <= c_) : (s_ > c_); if (!keepv) x[r] = 0.f; }
                }
                const bf16x8 p0 = pack8(x, 0), p1 = pack8(x, 1);
                const LAS char* vb = (const LAS char*)L + 49152 + (dvt * 4 + 2 * st) * 1024 + vperm;
                const bf16x8 v0 = mk8(vtr(vb), vtr(vb + 512)), v1 = mk8(vtr(vb + 1024), vtr(vb + 1024 + 512));
                o = MFMA32(p0, v0, o); o = MFMA32(p1, v1, o);
            }
        st_tile((unsigned*)(F.ws + WS_OI) + ((size_t)unit * 8 + ct * 4 + dvt) * 512, o, lane);
    }
    {
        const int dkt = w & 1, dvt = w >> 1;
#pragma unroll
        for (int dir = 0; dir < 2; ++dir) {
            f32x16 u = f32x16{};
#pragma unroll
            for (int t = 0; t < 4; ++t) {
                const LAS char* ka = (const LAS char*)L + 32768 + dir * 8192 + (dkt * 4 + t) * 1024 + vnat;
                const LAS char* vb = (const LAS char*)L + 49152 + (dvt * 4 + t) * 1024 + vnat;
                const bf16x8 af = mk8(vtr(ka), vtr(ka + 256)), bfr = mk8(vtr(vb), vtr(vb + 256));
                u = MFMA32(af, bfr, u);
            }
            st_tile((unsigned*)(F.ws + WS_U) + (((size_t)unit * 2 + dir) * 8 + dkt * 4 + dvt) * 512, u, lane);
        }
    }
    __syncthreads();
}
__device__ __forceinline__ void gla_scan(Frame& F, int chain) {
    const int b = chain >> 3, h = (chain >> 1) & 3, dir = chain & 1;
    const int lane = F.lane, r32 = lane & 31, hi = lane >> 5, dvt = F.wave;
    if (dvt >= 4) return;
    const bf16_t* QD = (const bf16_t*)(F.ws + WS_QD) + (size_t)dir * T * 256;
    f32x16 S0 = f32x16{}, S1 = f32x16{};
#pragma unroll 1
    for (int step = 0; step < 64; ++step) {
        const int n = dir == 0 ? step : 63 - step;
        const int unit = (b * 64 + n) * 4 + h;
        const size_t m0 = (size_t)b * SEQ + 64 * n;
        bf16x8 qa[2][4];
#pragma unroll
        for (int ct = 0; ct < 2; ++ct)
#pragma unroll
            for (int t = 0; t < 4; ++t) {
                const bf16_t* qp = QD + (m0 + 32 * ct + r32) * 256 + h * 64 + 16 * t + 4 * hi;
                const u32x2 lo = *(const u32x2*)qp, hh = *(const u32x2*)(qp + 8);
                u32x4 q4; q4.x = lo.x; q4.y = lo.y; q4.z = hh.x; q4.w = hh.y; qa[ct][t] = __builtin_bit_cast(bf16x8, q4);
            }
        const unsigned* up = (const unsigned*)(F.ws + WS_U) + (((size_t)unit * 2 + dir) * 8 + dvt) * 512;
        unsigned u0[8], u1[8];
#pragma unroll
        for (int i = 0; i < 8; ++i) { u0[i] = up[i * 64 + lane]; u1[i] = up[4 * 512 + i * 64 + lane]; }
        const float* dp = (const float*)(F.ws + WS_DEC) + (size_t)unit * 128 + dir * 64;
        f32x4 d0[4], d1[4];
#pragma unroll
        for (int q = 0; q < 4; ++q) { d0[q] = *(const f32x4*)(dp + 8 * q + 4 * hi); d1[q] = *(const f32x4*)(dp + 32 + 8 * q + 4 * hi); }
        const bf16x8 sb0 = pack8(S0, 0), sb1 = pack8(S0, 1), sb2 = pack8(S1, 0), sb3 = pack8(S1, 1);
        f32x16 oi[2];
#pragma unroll
        for (int ct = 0; ct < 2; ++ct) { f32x16 a = f32x16{}; a = MFMA32(qa[ct][0], sb0, a); a = MFMA32(qa[ct][1], sb1, a); a = MFMA32(qa[ct][2], sb2, a); a = MFMA32(qa[ct][3], sb3, a); oi[ct] = a; }
#pragma unroll
        for (int i = 0; i < 8; ++i) {
            S0[2 * i] = S0[2 * i] * d0[(2 * i) >> 2][(2 * i) & 3] + bflo(u0[i]); S0[2 * i + 1] = S0[2 * i + 1] * d0[(2 * i + 1) >> 2][(2 * i + 1) & 3] + bfhi(u0[i]);
            S1[2 * i] = S1[2 * i] * d1[(2 * i) >> 2][(2 * i) & 3] + bflo(u1[i]); S1[2 * i + 1] = S1[2 * i + 1] * d1[(2 * i + 1) >> 2][(2 * i + 1) & 3] + bfhi(u1[i]);
        }
        unsigned* op = (unsigned*)(F.ws + WS_OT) + (size_t)dir * (8 * MiB) + ((size_t)unit * 8 + dvt) * 512;
        st_tile(op, oi[0], lane); st_tile(op + 4 * 512, oi[1], lane);
    }
}
__device__ __forceinline__ void gla_final_unit(Frame& F, int l, int unit) {
    const int b = unit >> 8, n = (unit >> 2) & 63, h = unit & 3;
    const int tid = F.tid, lane = F.lane, r32 = lane & 31, hi = lane >> 5, w = F.wave;
    const size_t m0 = (size_t)b * SEQ + 64 * n;
    LAS float* Fz = (LAS float*)F.lds;
    {
        const int ct = w & 1, dvt = w >> 1;
        const size_t toff = ((size_t)unit * 8 + ct * 4 + dvt) * 512;
        f32x16 o = f32x16{};
        ld_tile_add((const unsigned*)(F.ws + WS_OI) + toff, o, lane);
        ld_tile_add((const unsigned*)(F.ws + WS_OT) + toff, o, lane);
        ld_tile_add((const unsigned*)(F.ws + WS_OT) + 8 * MiB + toff, o, lane);
#pragma unroll
        for (int r = 0; r < 16; ++r) Fz[(32 * ct + crow(r, hi)) * 132 + 32 * dvt + r32] = o[r];
    }
    __syncthreads();
    {
        const int row = tid >> 3, c0 = (tid & 7) * 16;
        f32x4 v[4]; float s = 0.f;
#pragma unroll
        for (int q = 0; q < 4; ++q) { v[q] = *(const LAS f32x4*)(Fz + row * 132 + c0 + 4 * q); s += (v[q].x * v[q].x + v[q].y * v[q].y) + (v[q].z * v[q].z + v[q].w * v[q].w); }
        s += __shfl_xor(s, 1); s += __shfl_xor(s, 2); s += __shfl_xor(s, 4);
        const float rs = __builtin_amdgcn_rsqf(s * (1.0f / 128.0f) + EPS);
        const float* gn = par(F, l, PAR_GLAG) + c0;
        const bf16_t* ogp = (const bf16_t*)(F.ws + WS_OG) + (m0 + row) * 512 + h * 128 + c0;
        const u32x4 g0 = *(const u32x4*)ogp, g1 = *(const u32x4*)(ogp + 8);
        const float og[16] = {bflo(g0.x), bfhi(g0.x), bflo(g0.y), bfhi(g0.y), bflo(g0.z), bfhi(g0.z), bflo(g0.w), bfhi(g0.w), bflo(g1.x), bfhi(g1.x), bflo(g1.y), bfhi(g1.y), bflo(g1.z), bfhi(g1.z), bflo(g1.w), bfhi(g1.w)};
        float r_[16];
#pragma unroll
        for (int q = 0; q < 4; ++q)
#pragma unroll
            for (int e = 0; e < 4; ++e) r_[4 * q + e] = v[q][e] * rs * gn[4 * q + e] * og[4 * q + e];
        bf16_t* op = (bf16_t*)(F.ws + WS_OB) + (m0 + row) * 512 + h * 128 + c0;
        u32x4 a, bq; a.x = cvtpk(r_[0], r_[1]); a.y = cvtpk(r_[2], r_[3]); a.z = cvtpk(r_[4], r_[5]); a.w = cvtpk(r_[6], r_[7]);
        bq.x = cvtpk(r_[8], r_[9]); bq.y = cvtpk(r_[10], r_[11]); bq.z = cvtpk(r_[12], r_[13]); bq.w = cvtpk(r_[14], r_[15]);
        *(u32x4*)op = a; *(u32x4*)(op + 8) = bq;
    }
    __syncthreads();
}

__global__ void __launch_bounds__(512, 2) fwd_kernel(Args args) {
    extern __shared__ __attribute__((aligned(16))) unsigned char lds_raw[];
    Frame F;
    F.lds = (LAS unsigned char*)lds_raw; F.ws = args.ws; F.tid = threadIdx.x; F.lane = F.tid & 63; F.wave = __builtin_amdgcn_readfirstlane(F.tid >> 6);
    F.G = gridDim.x; F.bid = blockIdx.x; F.out = args.out;
    volatile LAS unsigned* MISC = (volatile LAS unsigned*)(F.lds + MISC_OFF);
    if (F.tid < 32) MISC[F.tid] = 0u;
    __syncthreads();
    const int lo = args.ph_lo, hi_ = args.ph_hi;
    XcdBarrier bar; bar.bar = (unsigned*)(F.ws + WS_CTL) + CW_BAR; bar.x = 0; bar.st = nullptr;
    if (hi_ - lo > 1) bar = xcd_barrier_post((unsigned*)(F.ws + WS_CTL) + CW_BAR, MISC + 8);
#ifndef PH_MASK
#define PH_MASK 0x1ff
#endif
#define IN(k) (lo <= (k) && (k) < hi_)
#define PM(j) ((PH_MASK >> (j)) & 1)
#define FRESH() do { F.tid = opaque_v(threadIdx.x); F.lane = F.tid & 63; F.wave = __builtin_amdgcn_readfirstlane(F.tid >> 6); } while (0)
#define SEAM(k) do { if (IN(k) && IN((k) + 1)) xcd_barrier(bar); } while (0)
    float* SSb = (float*)(F.ws + WS_SS);

    if (PM(0) && IN(0)) { FRESH(); p0_prologue(F, args); }
    SEAM(0);
#pragma unroll 1
    for (int l = 0; l < 2; ++l) {
        const int pb = 1 + 8 * l;
        unsigned char* wl = F.ws + WS_W + (size_t)l * W_LAYER;
        if (PM(1) && IN(pb + 0)) {
            {
                pg8::Gemm g{(const bf16_t*)(F.ws + WS_XB), (const bf16_t*)(wl + W_INA), DM, DM, DM};
                pg8::Sched S; S.init(T, 3072, 1, F.G, F.bid, (size_t)256 * DM * 2, 0, (size_t)256 * DM * 2, 0);
                EpiQKV E{F.ws, SSb + (size_t)(2 * l) * T, par(F, l, PAR_GKA)};
                pg8::gemm_phase<EpiQKV, true, true>(F.lds, g, S, E);
            }
            if (l == 0) {
                pg8::Gemm g{(const bf16_t*)(F.ws + WS_MB), (const bf16_t*)(F.ws + WS_W + W_MKV), DM, DM, DM};
                pg8::Sched S; S.init(TMEM, 1024, 2, F.G, F.bid, (size_t)256 * DM * 2, 0, (size_t)256 * DM * 2, W_LAYER);
                EpiRowScale<0> E{(bf16_t*)(F.ws + WS_KVM), 1024, (size_t)TMEM * 1024, (const float*)(F.ws + WS_MSS)};
                pg8::gemm_phase<EpiRowScale<0>, true, true>(F.lds, g, S, E);
            }
        }
        SEAM(pb + 0);
        if (PM(2) && IN(pb + 1)) { FRESH(); for (int u = F.bid; u < 2048; u += F.G) gla_intra_unit(F, l, u); }
        SEAM(pb + 1);
        if (PM(3) && IN(pb + 2)) {
            FRESH();
            if (F.bid < 64) gla_scan(F, F.bid);
            else { const int nb = F.G - 64;
                for (int u = F.bid - 64; u < 512 + 256; u += nb) { if (u < 512) winattn_unit(F, l, u); else memattn_unit(F, l, u - 512); } }
        }
        SEAM(pb + 2);
        if (PM(4) && IN(pb + 3)) {
            FRESH();
            for (int u = F.bid; u < 2048; u += F.G) gla_final_unit(F, l, u);
            pg8::Gemm g{(const bf16_t*)(F.ws + WS_XB), (const bf16_t*)(wl + W_ING), DM, DM, DM};
            pg8::Sched S; S.init(T, 3072, 1, F.G, F.bid, (size_t)256 * DM * 2, 0, (size_t)256 * DM * 2, 0);
            EpiRowScale<1> E{(bf16_t*)(F.ws + WS_G), 3072, 0, SSb + (size_t)(2 * l) * T};
            pg8::gemm_phase<EpiRowScale<1>, true, true>(F.lds, g, S, E);
        }
        SEAM(pb + 3);
        if (PM(5) && IN(pb + 4)) {
            pg8::Gemm g{(const bf16_t*)(F.ws + WS_QA), (const bf16_t*)(wl + W_BR), 512, 1536, 512};
            pg8::Sched S; S.init(T, 1024, 3, F.G, F.bid, (size_t)256 * 512 * 2, 32 * MiB, (size_t)256 * 1536 * 2, 512 * 2);
            EpiMerge E{(const bf16_t*)(F.ws + WS_G), (bf16_t*)(F.ws + WS_MG)};
            pg8::gemm_phase<EpiMerge, true, true>(F.lds, g, S, E);
        }
        SEAM(pb + 4);
        if (PM(6) && IN(pb + 5)) {
            pg8::Gemm g{(const bf16_t*)(F.ws + WS_MG), (const bf16_t*)(wl + W_OUT), DM, DM, DM};
            pg8::Sched S; S.init(T, 1024, 1, F.G, F.bid, (size_t)256 * DM * 2, 0, (size_t)256 * DM * 2, 0);
            EpiRes E{F.out, F.out, (bf16_t*)(F.ws + WS_XB), SSb + (size_t)(2 * l + 1) * T};
            pg8::gemm_phase<EpiRes, true, true>(F.lds, g, S, E);
        }
        SEAM(pb + 5);
        if (PM(7) && IN(pb + 6)) {
            pg8::Gemm g{(const bf16_t*)(F.ws + WS_XB), (const bf16_t*)(wl + W_FI), DM, DM, DM};
            pg8::Sched S; S.init(T, 2 * DFF, 1, F.G, F.bid, (size_t)256 * DM * 2, 0, (size_t)256 * DM * 2, 0);
            EpiFFN E{(bf16_t*)(F.ws + WS_H), SSb + (size_t)(2 * l + 1) * T};
            pg8::gemm_phase<EpiFFN, true, true>(F.lds, g, S, E);
        }
        SEAM(pb + 6);
        if (PM(8) && IN(pb + 7)) {
            pg8::Gemm g{(const bf16_t*)(F.ws + WS_H), (const bf16_t*)(wl + W_FO), DFF, DFF, DFF};
            pg8::Sched S; S.init(T, 1024, 1, F.G, F.bid, (size_t)256 * DFF * 2, 0, (size_t)256 * DFF * 2, 0);
            EpiRes E{F.out, F.out, l == 0 ? (bf16_t*)(F.ws + WS_XB) : nullptr, SSb + (size_t)(2 * l + 2) * T};
            pg8::gemm_phase<EpiRes, true, true>(F.lds, g, S, E);
        }
        SEAM(pb + 7);
    }
#undef IN
#undef SEAM
}

extern "C" void kernel_launch(void* const* d_in, const int* in_sizes, int n_in, void* d_out, int out_size, void* d_ws, size_t ws_size, hipStream_t stream) {
    static int grid = 0;
    if (grid == 0) {
        if (n_in != 20 || ws_size < WS_END) { fprintf(stderr, "kernel_launch: unexpected n_in %d / ws %zu\n", n_in, ws_size); grid = -1; return; }
        int dev = 0, cus = 0, per_cu = 0;
        if (hipGetDevice(&dev) != hipSuccess || hipDeviceGetAttribute(&cus, hipDeviceAttributeMultiprocessorCount, dev) != hipSuccess) { grid = -1; return; }
        if (hipFuncSetAttribute((const void*)fwd_kernel, hipFuncAttributeMaxDynamicSharedMemorySize, LDS_BYTES) != hipSuccess) { fprintf(stderr, "kernel_launch: hipFuncSetAttribute failed\n"); grid = -1; return; }
        if (hipOccupancyMaxActiveBlocksPerMultiprocessor(&per_cu, (const void*)fwd_kernel, 512, LDS_BYTES) != hipSuccess || per_cu < 1) { fprintf(stderr, "kernel_launch: occupancy query says %d blocks/CU\n", per_cu); per_cu = 1; }
        (void)hipGetLastError();
        grid = cus;
    }
    if (grid < 0) return;
    (void)hipMemsetAsync((char*)d_ws + WS_CTL, 0, 1 * MiB, stream);
    Args a{};
    for (int i = 0; i < 20; ++i) a.in[i] = (const float*)d_in[i];
    a.out = (float*)d_out; a.ws = (unsigned char*)d_ws;
#if MK_N_LAUNCHES == 1
    a.ph_lo = 0; a.ph_hi = NPH;
    hipLaunchKernelGGL(fwd_kernel, dim3(grid), dim3(512), LDS_BYTES, stream, a);
#else
    for (int p = 0; p < NPH; ++p) { a.ph_lo = p; a.ph_hi = p + 1; hipLaunchKernelGGL(fwd_kernel, dim3(grid), dim3(512), LDS_BYTES, stream, a); }
#endif
}
```

```cpp
#include <hip/hip_runtime.h>
#include <cstdio>
#include <cstdint>

#ifndef MK_N_LAUNCHES
#define MK_N_LAUNCHES 1
#endif

#ifndef PROBE_PHASE
#define PROBE_PHASE -1
#define PROBE_REPS 0
#endif
#define LAS __attribute__((address_space(3)))
#define GAS __attribute__((address_space(1)))
typedef unsigned short bf16_t;
typedef short bf16x8 __attribute__((ext_vector_type(8)));
typedef short s16x4 __attribute__((ext_vector_type(4)));
typedef short v4i16_t __attribute__((ext_vector_type(4)));
typedef float f32x2 __attribute__((ext_vector_type(2)));
typedef float f32x4 __attribute__((ext_vector_type(4)));
typedef float f32x16 __attribute__((ext_vector_type(16)));
typedef unsigned u32x2 __attribute__((ext_vector_type(2)));
typedef unsigned u32x4 __attribute__((ext_vector_type(4)));
typedef __bf16 bf16x2_t __attribute__((ext_vector_type(2)));

constexpr int DM = 1024, BATCH = 8, SEQ = 4096, T = BATCH * SEQ, NMEM = 256, TMEM = BATCH * NMEM;
constexpr int DFF = 2816, DIN = 5920;
constexpr float EPS = 1e-6f, LOG2E = 1.4426950408889634f;
constexpr int NPH = 17;

constexpr size_t MiB = 1u << 20;
constexpr size_t WS_CTL = 0;
constexpr size_t WS_SS = 512 * 1024;
constexpr size_t WS_MSS = 1 * MiB;
constexpr size_t WS_BIAS = 1 * MiB + 64 * 1024;
constexpr size_t WS_PAR = 1 * MiB + 128 * 1024;
constexpr int PAR_GKA = 0, PAR_SINK = 64, PAR_GKM = 128, PAR_GLAG = 256, PAR_BDEC = 384, PAR_WDU = 896, PAR_LAYER = 896 + 8192;
constexpr size_t WS_DEC = 2 * MiB;
constexpr size_t WS_KVM = 3 * MiB;
constexpr size_t WS_MB = 11 * MiB;
constexpr size_t WS_W = 16 * MiB;
constexpr size_t W_INA = 0, W_ING = 6 * MiB, W_MKV = 12 * MiB, W_BR = 14 * MiB, W_OUT = 17 * MiB, W_FI = 19 * MiB, W_FO = 30 * MiB, W_LAYER = 35 * MiB + 512 * 1024;
constexpr size_t WS_XB = 88 * MiB;
constexpr size_t WS_QA = 152 * MiB;
constexpr size_t WS_OB = 184 * MiB;
constexpr size_t WS_QM = 216 * MiB;
constexpr size_t WS_KA = 248 * MiB, WS_VA = 256 * MiB;
constexpr size_t WS_QB = 264 * MiB, WS_KB = 280 * MiB;
constexpr size_t WS_VB = 296 * MiB, WS_OG = 328 * MiB;
constexpr size_t WS_LR = 360 * MiB;
constexpr size_t WS_QD = 362 * MiB;
constexpr size_t WS_U = 394 * MiB;
constexpr size_t WS_OI = 458 * MiB;
constexpr size_t WS_OT = 264 * MiB;
constexpr size_t WS_G = 248 * MiB;
constexpr size_t WS_MG = 440 * MiB;
constexpr size_t WS_H = 248 * MiB;
constexpr size_t WS_END = 512 * MiB;
static_assert(WS_OI + 32 * MiB <= WS_END && WS_MG + 64 * MiB <= WS_END && WS_W + 2 * W_LAYER <= WS_XB && WS_G + 192 * MiB <= WS_MG && WS_H + 176 * MiB <= WS_END, "ws map");

constexpr int CW_BAR = 4096;

constexpr int RING_BYTES = 131072;
constexpr int MISC_OFF = RING_BYTES;
constexpr int WSF_OFF = RING_BYTES + 1024;
constexpr int LDS_BYTES = 147456;

__device__ __forceinline__ unsigned cvtpk(float lo, float hi) { f32x2 v = {lo, hi}; bf16x2_t b = __builtin_convertvector(v, bf16x2_t); return __builtin_bit_cast(unsigned, b); }
__device__ __forceinline__ float bflo(unsigned w) { return __uint_as_float(w << 16); }
__device__ __forceinline__ float bfhi(unsigned w) { return __uint_as_float(w & 0xffff0000u); }
__device__ __forceinline__ float ex2(float x) { return __builtin_amdgcn_exp2f(x); }
__device__ __forceinline__ float sigmoidf_(float x) { return __builtin_amdgcn_rcpf(1.0f + ex2(-x * LOG2E)); }
__device__ __forceinline__ float siluf_(float x) { return x * sigmoidf_(x); }
__device__ __forceinline__ int crow(int r, int hi) { return (r & 3) + 8 * (r >> 2) + 4 * hi; }
__device__ __forceinline__ float swapmax(float v) { auto rr = __builtin_amdgcn_permlane32_swap(__float_as_uint(v), __float_as_uint(v), false, false); return fmaxf(__uint_as_float(rr[0]), __uint_as_float(rr[1])); }
__device__ __forceinline__ float swapsum(float v) { auto rr = __builtin_amdgcn_permlane32_swap(__float_as_uint(v), __float_as_uint(v), false, false); return __uint_as_float(rr[0]) + __uint_as_float(rr[1]); }
__device__ __forceinline__ s16x4 vtr(const LAS char* p) { return __builtin_bit_cast(s16x4, __builtin_amdgcn_ds_read_tr16_b64_v4i16((LAS v4i16_t*)p)); }
#define MFMA32(a, b, c) __builtin_amdgcn_mfma_f32_32x32x16_bf16((a), (b), (c), 0, 0, 0)
__device__ __forceinline__ bf16x8 pack8(const f32x16& x, int s) {
    u32x4 p; p.x = cvtpk(x[8 * s], x[8 * s + 1]); p.y = cvtpk(x[8 * s + 2], x[8 * s + 3]); p.z = cvtpk(x[8 * s + 4], x[8 * s + 5]); p.w = cvtpk(x[8 * s + 6], x[8 * s + 7]);
    return __builtin_bit_cast(bf16x8, p);
}
__device__ __forceinline__ bf16x8 mk8(s16x4 lo, s16x4 hi) { return (bf16x8){lo[0], lo[1], lo[2], lo[3], hi[0], hi[1], hi[2], hi[3]}; }

__device__ __forceinline__ int opaque_v(int v) { asm volatile("" : "+v"(v)); return v; }
namespace pg8 {
constexpr int BM = 256, BK = 64, HALF = 128, HTB = HALF * BK * 2, NXCD = 8, WGM = 8;
__host__ __device__ __forceinline__ int lds_byte(int r, int c) { const int st = (r >> 4) * 2 + (c >> 5), rr = r & 15, cc = c & 31, ob = rr * 64 + cc * 2; return st * 1024 + (ob ^ (((ob >> 9) & 1) << 5)); }
__host__ __device__ __forceinline__ void stage_rc(int b, int& R, int& C) { const int st = b / 1024, sb = b % 1024, swz = sb ^ (((sb >> 9) & 1) << 5); R = (st >> 1) * 16 + swz / 64; C = (st & 1) * 32 + (swz % 64) / 2; }
__host__ __device__ __forceinline__ int perm32(int rho) { const int n = rho >> 4, i = rho & 15; return 8 * (i >> 2) + 4 * n + (i & 3); }

struct Unit { int pm, pn, sub; unsigned aoff, boff; };
struct Gemm { const bf16_t* A; const bf16_t* Bt; int lda, ldb, K; };

struct Sched {
    int nM, nN, nSub, nwg, G, c; unsigned a_pm, a_sub, b_pn, b_sub;
    __device__ void init(int M, int N, int nSub_, int G_, int c_, unsigned a_pm_, unsigned a_sub_, unsigned b_pn_, unsigned b_sub_) {
        nM = M / BM; nN = N / BM; nSub = nSub_; nwg = nM * nN; G = G_; c = c_; a_pm = a_pm_; a_sub = a_sub_; b_pn = b_pn_; b_sub = b_sub_; }
    __device__ bool next(int i, Unit& u) const {
        const int round = i / nSub, sub = i - round * nSub;
        const long L = (long)round * G + c; if (L >= nwg) return false;
        int wgid = (int)L; { const int q = nwg / NXCD, r = nwg % NXCD, xcd = wgid % NXCD, off = wgid / NXCD; wgid = (xcd < r ? xcd * (q + 1) : r * (q + 1) + (xcd - r) * q) + off; }
        const int nig = WGM * nN, gid = wgid / nig, fm = gid * WGM, gsz = (nM - fm) < WGM ? (nM - fm) : WGM;
        u.pm = fm + ((wgid % nig) % gsz); u.pn = (wgid % nig) / gsz; u.sub = sub;
        u.aoff = (unsigned)u.pm * a_pm + (unsigned)sub * a_sub; u.boff = (unsigned)u.pn * b_pn + (unsigned)sub * b_sub; return true;
    }
};

template <class Epi, bool ALIGN_EPI, bool SP2>
__device__ __forceinline__ void gemm_phase(LAS unsigned char* lds, const Gemm g, const Sched& S, const Epi& E) {
    const int tid = opaque_v(threadIdx.x), wid = __builtin_amdgcn_readfirstlane(tid >> 6), lane = tid & 63, wr = wid >> 2, wc = wid & 3, fr = lane & 15, fq = lane >> 4;
    const int K = g.K, nt = K / BK;
    unsigned voffA[2], voffB[2];
#pragma unroll
    for (int i = 0; i < 2; ++i) { int R, C; stage_rc(tid * 16 + i * 8192, R, C); const int Rb = (R & ~31) + perm32(R & 31);
        voffA[i] = (unsigned)(R * g.lda + C) * 2u; voffB[i] = (unsigned)(Rb * g.ldb + C) * 2u; }
    const size_t kstep = (size_t)(BK * 2);
    const size_t hstepA = (size_t)HALF * g.lda * 2, hstepB = (size_t)HALF * g.ldb * 2;
    const unsigned ldsw = (unsigned)wid * 1024u;
    const int aoff = lds_byte(wr * 64 + fr, fq * 8), boff = lds_byte(wc * 32 + fr, fq * 8);
#define PG8_SA(b, h) (((b) * 2 + (h)) * HTB)
#define PG8_SB(b, h) ((4 + (b) * 2 + (h)) * HTB)
#define PG8_STAGE(bufoff, gbase, voff) do { _Pragma("unroll") for (int _i = 0; _i < 2; ++_i) \
        __builtin_amdgcn_global_load_lds((const unsigned*)((const char*)(gbase) + (voff)[_i]), (LAS unsigned*)(lds + (bufoff) + ldsw + _i * 8192), 16, 0, 0); } while (0)
#define PG8_LDA(dst, b, h) do { _Pragma("unroll") for (int m = 0; m < 4; ++m) _Pragma("unroll") for (int k = 0; k < 2; ++k) dst[m][k] = *(const LAS bf16x8*)(lds + PG8_SA(b, h) + aoff + m * 2048 + k * 1024); } while (0)
#define PG8_LDB(dst, b, h) do { _Pragma("unroll") for (int n = 0; n < 2; ++n) _Pragma("unroll") for (int k = 0; k < 2; ++k) dst[n][k] = *(const LAS bf16x8*)(lds + PG8_SB(b, h) + boff + n * 2048 + k * 1024); } while (0)
#define PG8_MMA(ai, bj, At, Bt) do { __builtin_amdgcn_s_setprio(1); _Pragma("unroll") for (int m = 0; m < 4; ++m) _Pragma("unroll") for (int n = 0; n < 2; ++n) _Pragma("unroll") for (int k = 0; k < 2; ++k) \
        acc[ai][bj][m][n] = __builtin_amdgcn_mfma_f32_16x16x32_bf16(Bt[n][k], At[m][k], acc[ai][bj][m][n], 0, 0, 0); __builtin_amdgcn_s_setprio(0); } while (0)
#define PG8_WAIT_V(n) asm volatile("s_waitcnt vmcnt(" #n ")" ::: "memory")
#define PG8_WAIT_L(n) asm volatile("s_waitcnt lgkmcnt(" #n ")" ::: "memory")
#define PG8_BAR __builtin_amdgcn_s_barrier()
#define PG8_SCHED __builtin_amdgcn_sched_barrier(0)
    Unit cur, nxt; int ui = 0;
    if (!S.next(0, cur)) return;
    f32x4 acc[2][2][4][2];
#pragma unroll
    for (int a = 0; a < 2; ++a)
#pragma unroll
        for (int b = 0; b < 2; ++b)
#pragma unroll
            for (int m = 0; m < 4; ++m)
#pragma unroll
                for (int n = 0; n < 2; ++n) acc[a][b][m][n] = (f32x4){0.f, 0.f, 0.f, 0.f};
    bf16x8 At[4][2], B0[2][2], B1[2][2];
    const char* cA = (const char*)g.A + cur.aoff; const char* cB = (const char*)g.Bt + cur.boff;
    if constexpr (SP2) {
        PG8_STAGE(PG8_SB(0, 0), cB, voffB); PG8_STAGE(PG8_SB(0, 1), cB + hstepB, voffB); PG8_STAGE(PG8_SA(0, 0), cA, voffA); PG8_STAGE(PG8_SA(0, 1), cA + hstepA, voffA);
        if (wr == 1) PG8_BAR;
        PG8_WAIT_V(2); PG8_BAR;
        PG8_STAGE(PG8_SB(1, 0), cB + kstep, voffB); PG8_STAGE(PG8_SA(1, 0), cA + kstep, voffA); PG8_STAGE(PG8_SB(1, 1), cB + hstepB + kstep, voffB);
        PG8_WAIT_V(6); PG8_BAR;
    } else {
        PG8_STAGE(PG8_SB(0, 0), cB, voffB); PG8_STAGE(PG8_SA(0, 0), cA, voffA); PG8_STAGE(PG8_SB(0, 1), cB + hstepB, voffB); PG8_STAGE(PG8_SA(0, 1), cA + hstepA, voffA);
        if (wr == 1) PG8_BAR;
        PG8_WAIT_V(4); PG8_BAR;
        PG8_STAGE(PG8_SB(1, 0), cB + kstep, voffB); PG8_STAGE(PG8_SA(1, 0), cA + kstep, voffA); PG8_STAGE(PG8_SB(1, 1), cB + hstepB + kstep, voffB);
        PG8_WAIT_V(6); PG8_BAR;
    }
    for (;;) {
        const bool has_next = S.next(ui + 1, nxt);
        const char* nA = has_next ? (const char*)g.A + nxt.aoff : cA; const char* nB = has_next ? (const char*)g.Bt + nxt.boff : cB;
        for (int t = 0; t < nt; t += 2) {
            const bool last = (t == nt - 2);
            const char* a1 = cA + (size_t)(t + 1) * kstep;
            const char* a2 = last ? nA : cA + (size_t)(t + 2) * kstep; const char* b2 = last ? nB : cB + (size_t)(t + 2) * kstep;
            const char* a3 = a2 + kstep; const char* b3 = b2 + kstep;
            if constexpr (SP2) {
            PG8_LDB(B0, 0, 0); PG8_LDB(B1, 0, 1); PG8_SCHED; PG8_LDA(At, 0, 0); PG8_STAGE(PG8_SA(1, 1), a1 + hstepA, voffA);
            PG8_WAIT_V(8); PG8_WAIT_L(0); PG8_BAR; PG8_MMA(0, 0, At, B0); PG8_MMA(0, 1, At, B1); PG8_BAR; PG8_SCHED;
            PG8_LDA(At, 0, 1); PG8_STAGE(PG8_SB(0, 0), b2, voffB); PG8_STAGE(PG8_SB(0, 1), b2 + hstepB, voffB); PG8_STAGE(PG8_SA(0, 0), a2, voffA);
            PG8_WAIT_V(8); PG8_WAIT_L(0); PG8_BAR; PG8_MMA(1, 0, At, B0); PG8_MMA(1, 1, At, B1); PG8_BAR; PG8_SCHED;
            PG8_LDB(B0, 1, 0); PG8_LDB(B1, 1, 1); PG8_SCHED; PG8_LDA(At, 1, 0); PG8_STAGE(PG8_SA(0, 1), a2 + hstepA, voffA);
            PG8_WAIT_V(8); PG8_WAIT_L(0); PG8_BAR; PG8_MMA(0, 0, At, B0); PG8_MMA(0, 1, At, B1); PG8_BAR; PG8_SCHED;
            PG8_LDA(At, 1, 1); PG8_STAGE(PG8_SB(1, 0), b3, voffB); PG8_STAGE(PG8_SB(1, 1), b3 + hstepB, voffB); PG8_STAGE(PG8_SA(1, 0), a3, voffA);
            PG8_WAIT_V(8); PG8_WAIT_L(0); PG8_BAR; PG8_MMA(1, 0, At, B0); PG8_MMA(1, 1, At, B1); PG8_BAR; PG8_SCHED;
            } else {
            PG8_LDB(B0, 0, 0); PG8_SCHED; PG8_LDA(At, 0, 0); PG8_STAGE(PG8_SA(1, 1), a1 + hstepA, voffA);
            PG8_WAIT_L(8); PG8_BAR; PG8_WAIT_L(0); PG8_MMA(0, 0, At, B0); PG8_BAR; PG8_SCHED;
            PG8_LDB(B1, 0, 1); PG8_STAGE(PG8_SB(0, 0), b2, voffB);
            PG8_BAR; PG8_WAIT_L(0); PG8_MMA(0, 1, At, B1); PG8_BAR;
            PG8_LDA(At, 0, 1); PG8_STAGE(PG8_SA(0, 0), a2, voffA);
            PG8_BAR; PG8_WAIT_L(0); PG8_MMA(1, 0, At, B0); PG8_BAR; PG8_SCHED;
            PG8_STAGE(PG8_SB(0, 1), b2 + hstepB, voffB);
            PG8_WAIT_V(6); PG8_BAR; PG8_MMA(1, 1, At, B1); PG8_BAR;
            PG8_LDB(B0, 1, 0); PG8_SCHED; PG8_LDA(At, 1, 0); PG8_STAGE(PG8_SA(0, 1), a2 + hstepA, voffA);
            PG8_WAIT_L(8); PG8_BAR; PG8_WAIT_L(0); PG8_MMA(0, 0, At, B0); PG8_BAR; PG8_SCHED;
            PG8_LDB(B1, 1, 1); PG8_STAGE(PG8_SB(1, 0), b3, voffB);
            PG8_BAR; PG8_WAIT_L(0); PG8_MMA(0, 1, At, B1); PG8_BAR;
            PG8_LDA(At, 1, 1); PG8_STAGE(PG8_SA(1, 0), a3, voffA);
            PG8_BAR; PG8_WAIT_L(0); PG8_MMA(1, 0, At, B0); PG8_BAR; PG8_SCHED;
            PG8_STAGE(PG8_SB(1, 1), b3 + hstepB, voffB);
            PG8_WAIT_V(6); PG8_BAR; PG8_MMA(1, 1, At, B1); PG8_BAR;
            }
        }
        if constexpr (ALIGN_EPI) { if (wr == 0) PG8_BAR; }
        const bool keep = E(acc, cur, wr, wc, fr, fq);
        if (!has_next) break;
        if (!keep) {
#pragma unroll
        for (int a = 0; a < 2; ++a)
#pragma unroll
            for (int b = 0; b < 2; ++b)
#pragma unroll
                for (int m = 0; m < 4; ++m)
#pragma unroll
                    for (int n = 0; n < 2; ++n) acc[a][b][m][n] = (f32x4){0.f, 0.f, 0.f, 0.f};
        }
        cur = nxt; cA = nA; cB = nB; ++ui;
        if constexpr (ALIGN_EPI) { if (wr == 1) PG8_BAR; }
    }
    PG8_WAIT_V(0);
    if constexpr (!ALIGN_EPI) { if (wr == 0) PG8_BAR; }
    PG8_BAR;
#undef PG8_SA
#undef PG8_SB
#undef PG8_STAGE
#undef PG8_LDA
#undef PG8_LDB
#undef PG8_MMA
#undef PG8_WAIT_V
#undef PG8_WAIT_L
#undef PG8_BAR
#undef PG8_SCHED
}
}
typedef f32x4 Acc[2][2][4][2];
using pg8::Unit;

__device__ __forceinline__ void st8(bf16_t* p, const f32x4 a, const f32x4 b) { u32x4 w; w.x = cvtpk(a[0], a[1]); w.y = cvtpk(a[2], a[3]); w.z = cvtpk(b[0], b[1]); w.w = cvtpk(b[2], b[3]); *(u32x4*)p = w; }

struct EpiQKV {
    unsigned char* ws; const float* ss; const float* gka;
    __device__ __forceinline__ bool operator()(Acc& acc, const Unit& u, int wr, int wc, int fr, int fq) const {
        const int G = 4 * u.pn + wc;
        if (G >= 45) return false;
        unsigned dmib; int ld, g0, op;
        if (G < 8) { dmib = WS_QA / MiB; ld = 512; g0 = 0; op = 1; }
        else if (G < 10) { dmib = WS_KA / MiB; ld = 128; g0 = 8; op = 2; }
        else if (G < 12) { dmib = WS_VA / MiB; ld = 128; g0 = 10; op = 0; }
        else if (G < 16) { dmib = WS_QB / MiB; ld = 256; g0 = 12; op = 3; }
        else if (G < 20) { dmib = WS_KB / MiB; ld = 256; g0 = 16; op = 0; }
        else if (G < 28) { dmib = WS_VB / MiB; ld = 512; g0 = 20; op = 0; }
        else if (G < 36) { dmib = WS_OG / MiB; ld = 512; g0 = 28; op = 4; }
        else if (G < 44) { dmib = WS_QM / MiB; ld = 512; g0 = 36; op = 0; }
        else { dmib = WS_LR / MiB; ld = 32; g0 = 44; op = 5; }
        bf16_t* base = (bf16_t*)(ws + (size_t)dmib * MiB); const int col = 64 * (G - g0);
        f32x4 gk[2][2];
#pragma unroll
        for (int bj = 0; bj < 2; ++bj)
#pragma unroll
            for (int n = 0; n < 2; ++n) {
                gk[bj][n] = (f32x4){1.f, 1.f, 1.f, 1.f};
                if (op == 2) { const int d = 32 * bj + 8 * fq + 4 * n; gk[bj][n] = *(const f32x4*)(gka + d); }
            }
        const int row0 = u.pm * 256 + wr * 64 + fr;
#pragma unroll
        for (int ai = 0; ai < 2; ++ai)
#pragma unroll
            for (int m = 0; m < 4; ++m) {
                const int row = row0 + ai * 128 + m * 16;
                const float rs = __builtin_amdgcn_rsqf(ss[row] * (1.0f / DM) + EPS);
                f32x4 v[2][2];
#pragma unroll
                for (int bj = 0; bj < 2; ++bj)
#pragma unroll
                    for (int n = 0; n < 2; ++n) v[bj][n] = acc[ai][bj][m][n] * rs;
                if (op == 1 || op == 2) {
                    float s = 0.f;
#pragma unroll
                    for (int bj = 0; bj < 2; ++bj)
#pragma unroll
                        for (int n = 0; n < 2; ++n) { const f32x4 x = v[bj][n]; s += (x[0] * x[0] + x[1] * x[1]) + (x[2] * x[2] + x[3] * x[3]); }
                    s += __shfl_xor(s, 16); s += __shfl_xor(s, 32);
                    const float r2 = __builtin_amdgcn_rsqf(s * (1.0f / 64.0f) + EPS);
#pragma unroll
                    for (int bj = 0; bj < 2; ++bj)
#pragma unroll
                        for (int n = 0; n < 2; ++n) v[bj][n] = v[bj][n] * r2 * gk[bj][n];
                } else if (op == 3) {
#pragma unroll
                    for (int bj = 0; bj < 2; ++bj)
#pragma unroll
                        for (int n = 0; n < 2; ++n) v[bj][n] = v[bj][n] * 0.125f;
                } else if (op == 4) {
#pragma unroll
                    for (int bj = 0; bj < 2; ++bj)
#pragma unroll
                        for (int n = 0; n < 2; ++n)
#pragma unroll
                            for (int e = 0; e < 4; ++e) v[bj][n][e] = siluf_(v[bj][n][e]);
                }
                bf16_t* rp = base + (size_t)row * ld + col + 8 * fq;
                st8(rp, v[0][0], v[0][1]);
                if (op != 5) st8(rp + 32, v[1][0], v[1][1]);
            }
        return false;
    }
};
template <int ACT> struct EpiRowScale {
    bf16_t* O; int ldc; size_t sub_stride; const float* ss;
    __device__ __forceinline__ bool operator()(Acc& acc, const Unit& u, int wr, int wc, int fr, int fq) const {
        const int row0 = u.pm * 256 + wr * 64 + fr, col0 = u.pn * 256 + wc * 32 + 8 * fq;
        bf16_t* base = O + (size_t)u.sub * sub_stride;
#pragma unroll
        for (int ai = 0; ai < 2; ++ai)
#pragma unroll
            for (int m = 0; m < 4; ++m) {
                const int row = row0 + ai * 128 + m * 16;
                const float rs = __builtin_amdgcn_rsqf(ss[row] * (1.0f / DM) + EPS);
#pragma unroll
                for (int bj = 0; bj < 2; ++bj) {
                    f32x4 a = acc[ai][bj][m][0] * rs, b = acc[ai][bj][m][1] * rs;
                    if (ACT == 1) {
#pragma unroll
                        for (int e = 0; e < 4; ++e) { a[e] = sigmoidf_(a[e]); b[e] = sigmoidf_(b[e]); }
                    }
                    st8(base + (size_t)row * ldc + col0 + bj * 128, a, b);
                }
            }
        return false;
    }
};
struct EpiMerge {
    const bf16_t* GT; bf16_t* O;
    __device__ __forceinline__ bool operator()(Acc& acc, const Unit& u, int wr, int wc, int fr, int fq) const {
        const int row0 = u.pm * 256 + wr * 64 + fr, col0 = u.pn * 256 + wc * 32 + 8 * fq;
        const int sub = u.sub;
#pragma unroll
        for (int ai = 0; ai < 2; ++ai)
#pragma unroll
            for (int m = 0; m < 4; ++m) {
                const int row = row0 + ai * 128 + m * 16;
#pragma unroll
                for (int bj = 0; bj < 2; ++bj) {
                    const bf16_t* gp = GT + (size_t)row * 3072 + sub * 1024 + col0 + bj * 128;
                    const u32x4 ga = *(const u32x4*)gp;
                    float f[8] = {bflo(ga.x), bfhi(ga.x), bflo(ga.y), bfhi(ga.y), bflo(ga.z), bfhi(ga.z), bflo(ga.w), bfhi(ga.w)};
                    if (sub < 2) {
                        const u32x4 gb = *(const u32x4*)(gp + 1024);
                        const float d[8] = {bflo(gb.x), bfhi(gb.x), bflo(gb.y), bfhi(gb.y), bflo(gb.z), bfhi(gb.z), bflo(gb.w), bfhi(gb.w)};
#pragma unroll
                        for (int e = 0; e < 8; ++e) f[e] = f[e] * __builtin_amdgcn_rcpf(fmaxf(d[e], 1e-30f));
                    }
                    f32x4 a = acc[ai][bj][m][0], b = acc[ai][bj][m][1];
#pragma unroll
                    for (int e = 0; e < 4; ++e) { a[e] *= f[e]; b[e] *= f[4 + e]; }
                    acc[ai][bj][m][0] = a; acc[ai][bj][m][1] = b;
                    if (sub == 2) st8(O + (size_t)row * DM + col0 + bj * 128, a, b);
                }
            }
        return sub < 2;
    }
};
struct EpiRes {
    const float* xin; float* xout; bf16_t* XB; float* ss; bool dry;
    __device__ __forceinline__ bool operator()(Acc& acc, const Unit& u, int wr, int wc, int fr, int fq) const {
        const int row0 = u.pm * 256 + wr * 64 + fr, col0 = u.pn * 256 + wc * 32 + 8 * fq;
#pragma unroll
        for (int ai = 0; ai < 2; ++ai)
#pragma unroll
            for (int m = 0; m < 4; ++m) {
                const int row = row0 + ai * 128 + m * 16; float s = 0.f;
#pragma unroll
                for (int bj = 0; bj < 2; ++bj) {
                    const size_t off = (size_t)row * DM + col0 + bj * 128;
                    const f32x4 a = *(const f32x4*)(xin + off) + acc[ai][bj][m][0], b = *(const f32x4*)(xin + off + 4) + acc[ai][bj][m][1];
                    if (!dry) { *(f32x4*)(xout + off) = a; *(f32x4*)(xout + off + 4) = b; }
                    if (XB && !dry) { st8(XB + off, a, b); s += (a[0] * a[0] + a[1] * a[1]) + (a[2] * a[2] + a[3] * a[3]) + (b[0] * b[0] + b[1] * b[1]) + (b[2] * b[2] + b[3] * b[3]); }
                }
                if (XB && !dry) { s += __shfl_xor(s, 16); s += __shfl_xor(s, 32); if (fq == 0) atomicAdd(ss + row, s); }
            }
        return false;
    }
};
struct EpiFFN {
    bf16_t* H; const float* ss;
    __device__ __forceinline__ bool operator()(Acc& acc, const Unit& u, int wr, int wc, int fr, int fq) const {
        const int row0 = u.pm * 256 + wr * 64 + fr, col0 = u.pn * 128 + wc * 32 + 8 * fq;
#pragma unroll
        for (int ai = 0; ai < 2; ++ai)
#pragma unroll
            for (int m = 0; m < 4; ++m) {
                const int row = row0 + ai * 128 + m * 16;
                const float rs = __builtin_amdgcn_rsqf(ss[row] * (1.0f / DM) + EPS);
                f32x4 h[2];
#pragma unroll
                for (int n = 0; n < 2; ++n)
#pragma unroll
                    for (int e = 0; e < 4; ++e) { const float gt = acc[ai][0][m][n][e] * rs, up = acc[ai][1][m][n][e] * rs; h[n][e] = siluf_(gt) * up; }
                st8(H + (size_t)row * DFF + col0, h[0], h[1]);
            }
        return false;
    }
};

typedef GAS unsigned gu32;
#define XB_TMO      128
#define XB_XCNT(j)  (256  + 64 * (j))
#define XB_XSUB(j)  (1280 + 64 * (j))
#define XB_XGEN(j)  (2304 + 64 * (j))
#define XB_TOP      3328
#define XB_TOPGEN   3392
#define XCD_BAR_WORDS 3456
#define XB_SPIN_CAP (1u << 22)
__device__ __forceinline__ unsigned xb_ld(unsigned* p)              { return __hip_atomic_load(p, __ATOMIC_RELAXED, __HIP_MEMORY_SCOPE_AGENT); }
__device__ __forceinline__ unsigned xb_add(unsigned* p, unsigned v) { return __hip_atomic_fetch_add(p, v, __ATOMIC_RELAXED, __HIP_MEMORY_SCOPE_AGENT); }
__device__ __forceinline__ unsigned xb_xcc_id() { return (unsigned)__builtin_amdgcn_s_getreg((3 << 11) | 20) & 0xFu; }
#define XB_SPIN(cond, bar) do { unsigned _sp = 0; while (cond) { __builtin_amdgcn_s_sleep(1); \
    if ((++_sp & 255u) == 0u) { if (xb_ld(&(bar)[XB_TMO])) break; if (_sp > XB_SPIN_CAP) { atomicAdd(&(bar)[XB_TMO], 1u); break; } } } } while (0)
struct XcdBarrier { unsigned* bar; unsigned x; volatile LAS unsigned* st; };
__device__ __forceinline__ XcdBarrier xcd_barrier_post(unsigned* bar, volatile LAS unsigned* st) {
    XcdBarrier b; b.bar = bar; b.x = xb_xcc_id(); b.st = st;
    if (threadIdx.x == 0) (void)xb_add(&bar[XB_XCNT(b.x)], 1u);
    return b;
}
__device__ __forceinline__ void xcd_barrier_complete(unsigned* bar, unsigned x, unsigned& nloc, unsigned& nx) {
    const unsigned G = gridDim.x * gridDim.y * gridDim.z;
    unsigned sum, cnt, mine, sp = 0u;
    for (;;) {
        sum = 0u; cnt = 0u; mine = 0u;
#pragma unroll
        for (unsigned j = 0; j < 16; ++j) { const unsigned c = xb_ld(&bar[XB_XCNT(j)]); sum += c; cnt += (c > 0u) ? 1u : 0u; mine = (j == x) ? c : mine; }
        if (sum == G) break;
        __builtin_amdgcn_s_sleep(1);
        if ((++sp & 255u) == 0u) { if (xb_ld(&bar[XB_TMO])) break; if (sp > XB_SPIN_CAP) { atomicAdd(&bar[XB_TMO], 1u); break; } }
    }
    nloc = mine > 0u ? mine : 1u; nx = cnt > 0u ? cnt : 1u;
}
__device__ __forceinline__ void xcd_barrier(const XcdBarrier& b) {
    asm volatile("s_waitcnt vmcnt(0)" ::: "memory");
    __syncthreads();
    if (threadIdx.x == 0) {
        unsigned* bar = b.bar;
        __builtin_amdgcn_s_waitcnt(0);
        unsigned nloc = b.st[0], nx = b.st[1];
        if (nloc == 0u) { xcd_barrier_complete(bar, b.x, nloc, nx); b.st[0] = nloc; b.st[1] = nx; }
        const unsigned old = xb_add(&bar[XB_XSUB(b.x)], 1u);
        const unsigned gen = old / nloc;
        if (old + 1u == (gen + 1u) * nloc) {
            __builtin_amdgcn_fence(__ATOMIC_RELEASE, "agent");
            asm volatile("s_waitcnt vmcnt(0)" ::: "memory");
            const unsigned og = xb_add(&bar[XB_TOP], 1u);
            const unsigned tg = og / nx;
            if (og + 1u == (tg + 1u) * nx) xb_add(&bar[XB_TOPGEN], 1u);
            else XB_SPIN(xb_ld(&bar[XB_TOPGEN]) == tg, bar);
            __builtin_amdgcn_fence(__ATOMIC_ACQUIRE, "agent");
            xb_add(&bar[XB_XGEN(b.x)], 1u);
            asm volatile("s_waitcnt vmcnt(0)" ::: "memory");
        } else {
            XB_SPIN(xb_ld(&bar[XB_XGEN(b.x)]) == gen, bar);
            __builtin_amdgcn_fence(__ATOMIC_ACQUIRE, "agent");
            asm volatile("s_waitcnt vmcnt(0)" ::: "memory");
        }
    }
    __syncthreads();
}

struct Args { const float* in[20]; float* out; unsigned char* ws; int ph_lo, ph_hi; };
struct Frame {
    LAS unsigned char* lds; unsigned char* ws; int tid, lane, wave, G, bid;
    float* out;
};
__device__ __forceinline__ const float* par(const Frame& F, int l, int off) { return (const float*)(F.ws + WS_PAR) + l * PAR_LAYER + off; }
enum { I_X = 0, I_MEM, I_RELB, I_NMIX, I_NFFN, I_NMEM, I_WIN, I_QNA, I_KNA, I_SINK, I_WDU, I_BDEC, I_GLAG, I_WMKV, I_QNM, I_KNM, I_WBR, I_WOUT, I_WFI, I_WFO };

__device__ __forceinline__ float wave_sum(float v) {
#pragma unroll
    for (int o = 1; o < 64; o <<= 1) v += __shfl_xor(v, o);
    return v;
}

__device__ __forceinline__ void tr_item(const float* W, int ldw, int s0, int k0, bf16_t* Bt, int ldb, int n0, int kd0, const float* gain, LAS float* scr, int lane) {
#pragma unroll
    for (int i = 0; i < 32; ++i) { const int kk = 2 * i + (lane >> 5); float v = 0.f; if (s0 >= 0) { v = W[(size_t)(k0 + kk) * ldw + s0 + (lane & 31)]; if (gain) v *= gain[k0 + kk]; } scr[kk * 33 + (lane & 31)] = v; }
    asm volatile("s_waitcnt lgkmcnt(0)" ::: "memory");
    const int c = lane & 7;
#pragma unroll
    for (int j = 0; j < 4; ++j) { const int n = (lane >> 3) + 8 * j; const LAS float* s = scr + (8 * c) * 33 + n;
        u32x4 o; o.x = cvtpk(s[0 * 33], s[1 * 33]); o.y = cvtpk(s[2 * 33], s[3 * 33]); o.z = cvtpk(s[4 * 33], s[5 * 33]); o.w = cvtpk(s[6 * 33], s[7 * 33]);
        *(u32x4*)(Bt + (size_t)(n0 + n) * ldb + kd0 + k0 + 8 * c) = o; }
    asm volatile("s_waitcnt lgkmcnt(0)" ::: "memory");
}
__device__ __forceinline__ int ina_src(int n0) {
    const int pn = n0 >> 8, c = n0 & 255, bj = c >> 7, wc = (c >> 5) & 3;
    const int x = 64 * (4 * pn + wc) + 32 * bj;
    if (x < 2304) return x;
    if (x < 2816) return x + 32;
    if (x < 2848) return 2304 + (x - 2816);
    return -1;
}
__device__ __forceinline__ void p0_prologue(Frame& F, const Args& A) {
    LAS float* scr = (LAS float*)(F.lds + F.wave * 16384);
    const int gw = F.bid * 8 + F.wave, NGW = F.G * 8;
    constexpr int I_A = 96 * 16, I_G = 96 * 16, I_M = 32 * 16, I_B = 3 * 32 * 8, I_O = 32 * 16, I_FI = 176 * 16, I_FO = 32 * 44;
    constexpr int I_LAYER = I_A + I_G + I_M + I_B + I_O + I_FI + I_FO;
    for (int it = gw; it < 2 * I_LAYER; it += NGW) {
        const int l = it / I_LAYER; int r = it - l * I_LAYER;
        unsigned char* wl = F.ws + WS_W + (size_t)l * W_LAYER;
        if (r < I_A) { const int nb = r >> 4, kb = r & 15; tr_item(A.in[I_WIN] + (size_t)l * DM * DIN, DIN, ina_src(32 * nb), 64 * kb, (bf16_t*)(wl + W_INA), DM, 32 * nb, 0, A.in[I_NMIX] + l * DM, scr, F.lane); continue; } r -= I_A;
        if (r < I_G) { const int nb = r >> 4, kb = r & 15; tr_item(A.in[I_WIN] + (size_t)l * DM * DIN, DIN, 2848 + 32 * nb, 64 * kb, (bf16_t*)(wl + W_ING), DM, 32 * nb, 0, A.in[I_NMIX] + l * DM, scr, F.lane); continue; } r -= I_G;
        if (r < I_M) { const int nb = r >> 4, kb = r & 15; tr_item(A.in[I_WMKV] + (size_t)l * DM * 1024, 1024, 32 * nb, 64 * kb, (bf16_t*)(wl + W_MKV), DM, 32 * nb, 0, A.in[I_NMEM] + l * DM, scr, F.lane); continue; } r -= I_M;
        if (r < I_B) { const int j = r / 256, q = r % 256, nb = q >> 3, kb = q & 7; tr_item(A.in[I_WBR] + ((size_t)l * 3 + j) * 512 * DM, DM, 32 * nb, 64 * kb, (bf16_t*)(wl + W_BR), 1536, 32 * nb, 512 * j, nullptr, scr, F.lane); continue; } r -= I_B;
        if (r < I_O) { const int nb = r >> 4, kb = r & 15; tr_item(A.in[I_WOUT] + (size_t)l * DM * DM, DM, 32 * nb, 64 * kb, (bf16_t*)(wl + W_OUT), DM, 32 * nb, 0, nullptr, scr, F.lane); continue; } r -= I_O;
        if (r < I_FI) { const int nb = r >> 4, kb = r & 15, n0 = 32 * nb; const int src = 2816 * ((n0 >> 7) & 1) + 128 * (n0 >> 8) + (n0 & 127);
            tr_item(A.in[I_WFI] + (size_t)l * DM * 2 * DFF, 2 * DFF, src, 64 * kb, (bf16_t*)(wl + W_FI), DM, n0, 0, A.in[I_NFFN] + l * DM, scr, F.lane); continue; } r -= I_FI;
        { const int nb = r / 44, kb = r % 44; tr_item(A.in[I_WFO] + (size_t)l * DFF * DM, DM, 32 * nb, 64 * kb, (bf16_t*)(wl + W_FO), DFF, 32 * nb, 0, nullptr, scr, F.lane); }
    }
    for (int m = gw; m < T + TMEM; m += NGW) {
        const bool ism = m >= T; const int r = ism ? m - T : m;
        const f32x4* xr = (const f32x4*)((ism ? A.in[I_MEM] : A.in[I_X]) + (size_t)r * DM) + F.lane;
        bf16_t* orow = (bf16_t*)(F.ws + (ism ? WS_MB : WS_XB)) + (size_t)r * DM;
        float s = 0.f;
#pragma unroll
        for (int j = 0; j < 4; ++j) { const f32x4 v = xr[64 * j]; s += (v.x * v.x + v.y * v.y) + (v.z * v.z + v.w * v.w);
            u32x2 w; w.x = cvtpk(v.x, v.y); w.y = cvtpk(v.z, v.w); *(u32x2*)(orow + 256 * j + 4 * F.lane) = w; }
        s = wave_sum(s);
        if (F.lane == 0) ((float*)(F.ws + (ism ? WS_MSS : WS_SS)))[r] = s;
    }
    if (F.bid == 1) {
        for (int i = F.tid; i < 2 * PAR_LAYER; i += 512) {
            const int l = i / PAR_LAYER, o = i % PAR_LAYER; float v = 0.f;
            if (o < 64) v = A.in[I_QNA][l * 64 + o] * A.in[I_KNA][l * 64 + o] * (0.125f * LOG2E);
            else if (o < 72) v = A.in[I_SINK][l * 8 + (o - 64)] * LOG2E;
            else if (o < 128) v = 0.f;
            else if (o < 256) v = A.in[I_QNM][l * 128 + (o - 128)] * A.in[I_KNM][l * 128 + (o - 128)] * (0.08838834764831845f * LOG2E);
            else if (o < 384) v = A.in[I_GLAG][l * 128 + (o - 256)];
            else if (o < 896) v = A.in[I_BDEC][l * 512 + (o - 384)];
            else v = A.in[I_WDU][l * 8192 + (o - 896)];
            ((float*)(F.ws + WS_PAR))[i] = v;
        }
    }
    if (F.bid == 0) {
        for (int i = F.tid; i < 8 * 257; i += 512) {
            const int h = i / 257, rel = i % 257 - 128, n = rel < 0 ? -rel : rel;
            int bk = n < 8 ? n : (2 + (31 - __builtin_clz((unsigned)(n * n)))); if (bk > 15) bk = 15;
            if (rel > 0) bk += 16;
            ((float*)(F.ws + WS_BIAS))[i] = A.in[I_RELB][bk * 8 + h] * LOG2E;
        }
    }
}

__device__ __forceinline__ void winattn_unit(Frame& F, int l, int unit, bool dry) {
    const int b = unit >> 6, i = (unit >> 1) & 31, kvh = unit & 1;
    const int tid = F.tid, lane = F.lane, r32 = lane & 31, hi = lane >> 5, w = F.wave;
    const bf16_t* KA = (const bf16_t*)(F.ws + WS_KA); const bf16_t* VA = (const bf16_t*)(F.ws + WS_VA); bf16_t* QA = (bf16_t*)(F.ws + WS_QA);
    LAS unsigned char* Kt = F.lds; LAS unsigned char* Vt = F.lds + 49152; LAS float* bias = (LAS float*)(F.lds + 98304);
    LAS float* wsf = (LAS float*)(F.lds + WSF_OFF) + w * 64;
    const int start = 128 * i;
    for (int idx = tid; idx < 3072; idx += 512) {
        const int j = idx >> 3, ch = idx & 7, kpos = start - 128 + j;
        u32x4 kv = {0u, 0u, 0u, 0u}, vv = {0u, 0u, 0u, 0u};
        if (kpos >= 0 && kpos < SEQ) { const size_t off = (size_t)(b * SEQ + kpos) * 128 + kvh * 64 + ch * 8; kv = *(const u32x4*)(KA + off); vv = *(const u32x4*)(VA + off); }
        *(LAS u32x4*)(Kt + j * 128 + ((ch ^ ((j >> 1) & 7)) << 4)) = kv;
        *(LAS u32x4*)(Vt + ((ch >> 2) * 24 + (j >> 4)) * 1024 + (j & 15) * 64 + (ch & 3) * 16) = vv;
    }
    for (int idx = tid; idx < 4 * 321; idx += 512) { const int g_ = idx / 321, rel = idx % 321 - 160;
        bias[idx] = (rel >= -128 && rel <= 128) ? ((const float*)(F.ws + WS_BIAS))[(kvh * 4 + g_) * 257 + rel + 128] : -1e30f; }
    asm volatile("s_waitcnt lgkmcnt(0)\n\ts_barrier" ::: "memory");
    const int g = w >> 1, half = w & 1, h = kvh * 4 + g;
    const float sink2 = par(F, l, PAR_SINK)[h];
    const LAS float* bh = bias + g * 321;
    const int vlane = ((lane >> 4) & 1) * 32 + (lane & 3) * 8 + (4 * hi + ((lane & 15) >> 2)) * 64;
#pragma unroll 1
    for (int qq = 0; qq < 2; ++qq) {
        const int qb = 2 * half + qq, t = 32 * qb + r32;
        const size_t qrow = (size_t)(b * SEQ + start + t);
        bf16x8 qf[4];
#pragma unroll
        for (int ds = 0; ds < 4; ++ds) qf[ds] = *(const bf16x8*)(QA + qrow * 512 + h * 64 + 16 * ds + 8 * hi);
        float m = sink2, lsum = (hi == 0) ? 1.0f : 0.0f;
        f32x16 o[2]; o[0] = f32x16{}; o[1] = f32x16{};
#pragma unroll 1
        for (int kt = qb; kt <= qb + 8; ++kt) {
            const int kp0 = start - 128 + 32 * kt;
            if (kp0 + 31 < 0 || kp0 >= SEQ) continue;
            f32x16 s = f32x16{};
#pragma unroll
            for (int ds = 0; ds < 4; ++ds) {
                const int kr = 32 * kt + r32, ch = 2 * ds + hi;
                const bf16x8 kf = *(const LAS bf16x8*)(Kt + kr * 128 + ((ch ^ ((kr >> 1) & 7)) << 4));
                s = MFMA32(kf, qf[ds], s);
            }
            float rm = -1e30f;
            const LAS float* bt = bh + (32 * (kt - qb) + 32 - r32 + 4 * hi);
#pragma unroll
            for (int r = 0; r < 16; ++r) { const float v = s[r] + bt[(r & 3) + 8 * (r >> 2)]; s[r] = v; rm = fmaxf(rm, v); }
            rm = swapmax(rm);
            const float mn = fmaxf(m, rm), alpha = ex2(m - mn); m = mn;
            float ps = 0.f;
#pragma unroll
            for (int r = 0; r < 16; ++r) { const float p = ex2(s[r] - mn); s[r] = p; ps += p; }
            lsum = lsum * alpha + ps;
            if (!__all(alpha == 1.0f)) {
                if (hi == 0) wsf[r32] = alpha;
                asm volatile("s_waitcnt lgkmcnt(0)" ::: "memory");
#pragma unroll
                for (int r = 0; r < 16; ++r) { const float a = wsf[crow(r, hi)]; o[0][r] *= a; o[1][r] *= a; }
            }
            const bf16x8 p0 = pack8(s, 0), p1 = pack8(s, 1);
#pragma unroll
            for (int d0 = 0; d0 < 2; ++d0) {
                const LAS char* vb = (const LAS char*)Vt + (d0 * 24 + 2 * kt) * 1024 + vlane;
                const bf16x8 v0 = mk8(vtr(vb), vtr(vb + 512)), v1 = mk8(vtr(vb + 1024), vtr(vb + 1024 + 512));
                o[d0] = MFMA32(p0, v0, o[d0]); o[d0] = MFMA32(p1, v1, o[d0]);
            }
        }
        lsum = swapsum(lsum);
        if (hi == 0) wsf[32 + r32] = __builtin_amdgcn_rcpf(lsum);
        asm volatile("s_waitcnt lgkmcnt(0)" ::: "memory");
        bf16_t* Ob = QA + (size_t)(b * SEQ + start + 32 * qb) * 512 + h * 64 + r32;
#pragma unroll
        for (int r = 0; r < 16; ++r) { const float rl = wsf[32 + crow(r, hi)]; const int orow = crow(r, hi);
#pragma unroll
            for (int d0 = 0; d0 < 2; ++d0) { const bf16_t ov = (bf16_t)(cvtpk(o[d0][r] * rl, 0.f) & 0xffffu); if (!dry) Ob[(size_t)orow * 512 + 32 * d0] = ov; } }
    }
    asm volatile("s_waitcnt lgkmcnt(0)\n\ts_barrier" ::: "memory");
}

__device__ __forceinline__ void memattn_unit(Frame& F, int l, int unit, bool dry) {
    const int b = unit >> 5, h = (unit >> 3) & 3, rb = unit & 7;
    const int tid = F.tid, lane = F.lane, r32 = lane & 31, hi = lane >> 5, w = F.wave;
    const bf16_t* KV = (const bf16_t*)(F.ws + WS_KVM) + (size_t)l * TMEM * 1024; bf16_t* QM = (bf16_t*)(F.ws + WS_QM);
    LAS unsigned char* Kt = F.lds; LAS unsigned char* Vt = F.lds + 65536;
    LAS float* wsf = (LAS float*)(F.lds + WSF_OFF) + w * 64;
    const float* gkm = par(F, l, PAR_GKM);
    for (int idx = tid; idx < 4096; idx += 512) {
        const int j = idx >> 4, ch = idx & 15;
        const bf16_t* rp = KV + (size_t)(b * NMEM + j) * 1024 + h * 128 + ch * 8;
        const u32x4 kv = *(const u32x4*)rp, vv = *(const u32x4*)(rp + 512);
        float f[8] = {bflo(kv.x), bfhi(kv.x), bflo(kv.y), bfhi(kv.y), bflo(kv.z), bfhi(kv.z), bflo(kv.w), bfhi(kv.w)};
        float s = 0.f;
#pragma unroll
        for (int e = 0; e < 8; ++e) s += f[e] * f[e];
        s += __shfl_xor(s, 1); s += __shfl_xor(s, 2); s += __shfl_xor(s, 4); s += __shfl_xor(s, 8);
        const float rs = __builtin_amdgcn_rsqf(s * (1.0f / 128.0f) + EPS);
#pragma unroll
        for (int e = 0; e < 8; ++e) f[e] *= rs * gkm[ch * 8 + e];
        u32x4 ko; ko.x = cvtpk(f[0], f[1]); ko.y = cvtpk(f[2], f[3]); ko.z = cvtpk(f[4], f[5]); ko.w = cvtpk(f[6], f[7]);
        *(LAS u32x4*)(Kt + j * 256 + ((ch ^ (j & 15)) << 4)) = ko;
        *(LAS u32x4*)(Vt + ((ch >> 2) * 16 + (j >> 4)) * 1024 + (j & 15) * 64 + (ch & 3) * 16) = vv;
    }
    asm volatile("s_waitcnt lgkmcnt(0)\n\ts_barrier" ::: "memory");
    const int vlane = ((lane >> 4) & 1) * 32 + (lane & 3) * 8 + (4 * hi + ((lane & 15) >> 2)) * 64;
#pragma unroll 1
    for (int qq = 0; qq < 2; ++qq) {
        const size_t q0 = (size_t)b * SEQ + rb * 512 + w * 64 + qq * 32;
        bf16x8 qf[8]; float qs = 0.f;
#pragma unroll
        for (int ds = 0; ds < 8; ++ds) { const u32x4 qv = *(const u32x4*)(QM + (q0 + r32) * 512 + h * 128 + 16 * ds + 8 * hi); qf[ds] = __builtin_bit_cast(bf16x8, qv);
            const float a0 = bflo(qv.x), a1 = bfhi(qv.x), a2 = bflo(qv.y), a3 = bfhi(qv.y), a4 = bflo(qv.z), a5 = bfhi(qv.z), a6 = bflo(qv.w), a7 = bfhi(qv.w);
            qs += (a0 * a0 + a1 * a1) + (a2 * a2 + a3 * a3) + (a4 * a4 + a5 * a5) + (a6 * a6 + a7 * a7); }
        qs = swapsum(qs);
        const float rq = __builtin_amdgcn_rsqf(qs * (1.0f / 128.0f) + EPS);
        float m = -1e30f, lsum = 0.f;
        f32x16 o[4]; o[0] = f32x16{}; o[1] = f32x16{}; o[2] = f32x16{}; o[3] = f32x16{};
#pragma unroll 1
        for (int kt = 0; kt < 8; ++kt) {
            f32x16 s = f32x16{};
#pragma unroll
            for (int ds = 0; ds < 8; ++ds) {
                const int kr = 32 * kt + r32, ch = 2 * ds + hi;
                const bf16x8 kf = *(const LAS bf16x8*)(Kt + kr * 256 + ((ch ^ (kr & 15)) << 4));
                s = MFMA32(kf, qf[ds], s);
            }
            float rm = -1e30f;
#pragma unroll
            for (int r = 0; r < 16; ++r) { s[r] *= rq; rm = fmaxf(rm, s[r]); }
            rm = swapmax(rm);
            const float mn = fmaxf(m, rm), alpha = ex2(m - mn); m = mn;
            float ps = 0.f;
#pragma unroll
            for (int r = 0; r < 16; ++r) { const float p = ex2(s[r] - mn); s[r] = p; ps += p; }
            lsum = lsum * alpha + ps;
            if (!__all(alpha == 1.0f)) {
                if (hi == 0) wsf[r32] = alpha;
                asm volatile("s_waitcnt lgkmcnt(0)" ::: "memory");
#pragma unroll
                for (int r = 0; r < 16; ++r) { const float a = wsf[crow(r, hi)]; o[0][r] *= a; o[1][r] *= a; o[2][r] *= a; o[3][r] *= a; }
            }
            const bf16x8 p0 = pack8(s, 0), p1 = pack8(s, 1);
#pragma unroll
            for (int d0 = 0; d0 < 4; ++d0) {
                const LAS char* vb = (const LAS char*)Vt + (d0 * 16 + 2 * kt) * 1024 + vlane;
                const bf16x8 v0 = mk8(vtr(vb), vtr(vb + 512)), v1 = mk8(vtr(vb + 1024), vtr(vb + 1024 + 512));
                o[d0] = MFMA32(p0, v0, o[d0]); o[d0] = MFMA32(p1, v1, o[d0]);
            }
        }
        lsum = swapsum(lsum);
        if (hi == 0) wsf[32 + r32] = __builtin_amdgcn_rcpf(lsum);
        asm volatile("s_waitcnt lgkmcnt(0)" ::: "memory");
        bf16_t* Ob = QM + q0 * 512 + h * 128 + r32;
#pragma unroll
        for (int r = 0; r < 16; ++r) { const float rl = wsf[32 + crow(r, hi)]; const int orow = crow(r, hi);
#pragma unroll
            for (int d0 = 0; d0 < 4; ++d0) { const bf16_t ov = (bf16_t)(cvtpk(o[d0][r] * rl, 0.f) & 0xffffu); if (!dry) Ob[(size_t)orow * 512 + 32 * d0] = ov; } }
    }
    asm volatile("s_waitcnt lgkmcnt(0)\n\ts_barrier" ::: "memory");
}

__device__ __forceinline__ void st_tile(unsigned* p, const f32x16& x, int lane) {
#pragma unroll
    for (int i = 0; i < 8; ++i) p[i * 64 + lane] = cvtpk(x[2 * i], x[2 * i + 1]);
}
__device__ __forceinline__ void st_nat(bf16_t* p, const f32x16& x, int r32, int hi) {
#pragma unroll
    for (int r = 0; r < 16; ++r) p[(size_t)crow(r, hi) * 512 + r32] = (bf16_t)(cvtpk(x[r], 0.f) & 0xffffu);
}
__device__ __forceinline__ void ld_tile_add(const unsigned* p, f32x16& x, int lane) {
#pragma unroll
    for (int i = 0; i < 8; ++i) { const unsigned w = p[i * 64 + lane]; x[2 * i] += bflo(w); x[2 * i + 1] += bfhi(w); }
}
__device__ __forceinline__ float wave_prefix(float v, int lane) {
#pragma unroll
    for (int o = 1; o < 64; o <<= 1) { const float t = __shfl_up(v, o); if (lane >= o) v += t; }
    return v;
}
struct IntraPre { u32x4 lr[4]; u32x4 q8, k8, v0, v1; };
__device__ __forceinline__ void gla_intra_load(const Frame& F, int unit, IntraPre& P) {
    const int b = unit >> 8, n = (unit >> 2) & 63, h = unit & 3, c = F.lane, w = F.wave;
    const size_t m0 = (size_t)b * SEQ + 64 * n;
    const u32x4* lp = (const u32x4*)((const bf16_t*)(F.ws + WS_LR) + (m0 + c) * 32);
#pragma unroll
    for (int q = 0; q < 4; ++q) P.lr[q] = lp[q];
    P.q8 = *(const u32x4*)((const bf16_t*)(F.ws + WS_QB) + (m0 + c) * 256 + h * 64 + 8 * w);
    P.k8 = *(const u32x4*)((const bf16_t*)(F.ws + WS_KB) + (m0 + c) * 256 + h * 64 + 8 * w);
    const bf16_t* VB = (const bf16_t*)(F.ws + WS_VB);
    { const int idx = F.tid, j = idx >> 4, ch = idx & 15; P.v0 = *(const u32x4*)(VB + (m0 + j) * 512 + h * 128 + ch * 8); }
    { const int idx = F.tid + 512, j = idx >> 4, ch = idx & 15; P.v1 = *(const u32x4*)(VB + (m0 + j) * 512 + h * 128 + ch * 8); }
}
__device__ __forceinline__ void gla_intra_unit(Frame& F, int l, int unit, const IntraPre& P) {
    const int b = unit >> 8, n = (unit >> 2) & 63, h = unit & 3;
    const int tid = F.tid, lane = F.lane, r32 = lane & 31, hi = lane >> 5, w = F.wave;
    const size_t m0 = (size_t)b * SEQ + 64 * n;
    bf16_t* QD = (bf16_t*)(F.ws + WS_QD);
    LAS unsigned char* L = F.lds;
    { const int idx = tid, j = idx >> 4, ch = idx & 15; *(LAS u32x4*)(L + 49152 + ((ch >> 2) * 4 + (j >> 4)) * 1024 + (j & 15) * 64 + (ch & 3) * 16) = P.v0; }
    { const int idx = tid + 512, j = idx >> 4, ch = idx & 15; *(LAS u32x4*)(L + 49152 + ((ch >> 2) * 4 + (j >> 4)) * 1024 + (j & 15) * 64 + (ch & 3) * 16) = P.v1; }
    {
        const int c = lane;
        float lrf[32];
#pragma unroll
        for (int q = 0; q < 4; ++q) { const u32x4 x = P.lr[q]; lrf[8 * q + 0] = bflo(x.x); lrf[8 * q + 1] = bfhi(x.x); lrf[8 * q + 2] = bflo(x.y); lrf[8 * q + 3] = bfhi(x.y); lrf[8 * q + 4] = bflo(x.z); lrf[8 * q + 5] = bfhi(x.z); lrf[8 * q + 6] = bflo(x.w); lrf[8 * q + 7] = bfhi(x.w); }
        const u32x4 q8 = P.q8, k8 = P.k8;
        const float qv[8] = {bflo(q8.x), bfhi(q8.x), bflo(q8.y), bfhi(q8.y), bflo(q8.z), bfhi(q8.z), bflo(q8.w), bfhi(q8.w)};
        const float kv[8] = {bflo(k8.x), bfhi(k8.x), bflo(k8.y), bfhi(k8.y), bflo(k8.z), bfhi(k8.z), bflo(k8.w), bfhi(k8.w)};
        const LAS float* WUl = (const LAS float*)(L + 65536) + 8 * w; const LAS float* BDl = (const LAS float*)(L + 73728) + 8 * w;
        float* DEC = (float*)(F.ws + WS_DEC) + (size_t)unit * 128;
#pragma unroll
        for (int dir = 0; dir < 2; ++dir) {
            float lg[8];
            { const f32x4 b0 = *(const LAS f32x4*)(BDl + dir * 64), b1 = *(const LAS f32x4*)(BDl + dir * 64 + 4);
              lg[0] = b0.x; lg[1] = b0.y; lg[2] = b0.z; lg[3] = b0.w; lg[4] = b1.x; lg[5] = b1.y; lg[6] = b1.z; lg[7] = b1.w; }
#pragma unroll
            for (int r = 0; r < 16; ++r) {
                const f32x4 w0 = *(const LAS f32x4*)(WUl + (dir * 16 + r) * 64), w1 = *(const LAS f32x4*)(WUl + (dir * 16 + r) * 64 + 4);
                const float x = lrf[dir * 16 + r];
                lg[0] += x * w0.x; lg[1] += x * w0.y; lg[2] += x * w0.z; lg[3] += x * w0.w; lg[4] += x * w1.x; lg[5] += x * w1.y; lg[6] += x * w1.z; lg[7] += x * w1.w;
            }
            float qd[8], kd[8], ke[8], dc[8];
#pragma unroll
            for (int d = 0; d < 8; ++d) {
                const float tt = ex2(-fabsf(lg[d]) * LOG2E);
                const float la2 = (fminf(lg[d], 0.f) * LOG2E - __builtin_amdgcn_logf(1.0f + tt)) * (1.0f / 16.0f);
                const float pre = wave_prefix(la2, lane);
                const float tot = __shfl(pre, 63);
                const float bb = dir == 0 ? pre : (tot - pre + la2);
                const float e1 = ex2(bb), e2 = ex2(-bb), e3 = ex2(tot - bb);
                qd[d] = qv[d] * e1; kd[d] = kv[d] * e2; ke[d] = kv[d] * e3; dc[d] = ex2(tot);
            }
            if (lane == 0) { *(f32x4*)(DEC + dir * 64 + 8 * w) = (f32x4){dc[0], dc[1], dc[2], dc[3]}; *(f32x4*)(DEC + dir * 64 + 8 * w + 4) = (f32x4){dc[4], dc[5], dc[6], dc[7]}; }
            u32x4 a, bq, cq;
            a.x = cvtpk(qd[0], qd[1]); a.y = cvtpk(qd[2], qd[3]); a.z = cvtpk(qd[4], qd[5]); a.w = cvtpk(qd[6], qd[7]);
            bq.x = cvtpk(kd[0], kd[1]); bq.y = cvtpk(kd[2], kd[3]); bq.z = cvtpk(kd[4], kd[5]); bq.w = cvtpk(kd[6], kd[7]);
            cq.x = cvtpk(ke[0], ke[1]); cq.y = cvtpk(ke[2], ke[3]); cq.z = cvtpk(ke[4], ke[5]); cq.w = cvtpk(ke[6], ke[7]);
            *(u32x4*)(QD + ((size_t)dir * T + m0 + c) * 256 + h * 64 + 8 * w) = a;
            const int kso = c * 128 + ((w ^ ((c >> 1) & 7)) << 4);
            *(LAS u32x4*)(L + dir * 16384 + kso) = a;
            *(LAS u32x4*)(L + dir * 16384 + 8192 + kso) = bq;
            *(LAS u32x4*)(L + 32768 + dir * 8192 + ((w >> 2) * 4 + (c >> 4)) * 1024 + (c & 15) * 64 + (w & 3) * 16) = cq;
        }
    }
    asm volatile("s_waitcnt lgkmcnt(0)\n\ts_barrier" ::: "memory");
    const int vperm = ((lane >> 4) & 1) * 32 + (lane & 3) * 8 + (4 * hi + ((lane & 15) >> 2)) * 64;
    const int vnat = ((lane >> 4) & 1) * 32 + (lane & 3) * 8 + (8 * hi + ((lane & 15) >> 2)) * 64;
    {
        const int ct = w & 1, dvt = w >> 1;
        f32x16 o = f32x16{};
#pragma unroll
        for (int dir = 0; dir < 2; ++dir)
#pragma unroll
            for (int st = 0; st < 2; ++st) {
                if ((dir == 0 && st > ct) || (dir == 1 && st < ct)) continue;
                f32x16 x = f32x16{};
#pragma unroll
                for (int ds = 0; ds < 4; ++ds) {
                    const int sr = 32 * st + r32, cr = 32 * ct + r32, ch = 2 * ds + hi;
                    const bf16x8 kf = *(const LAS bf16x8*)(L + dir * 16384 + 8192 + sr * 128 + ((ch ^ ((sr >> 1) & 7)) << 4));
                    const bf16x8 qf = *(const LAS bf16x8*)(L + dir * 16384 + cr * 128 + ((ch ^ ((cr >> 1) & 7)) << 4));
                    x = MFMA32(kf, qf, x);
                }
                if (st == ct) {
#pragma unroll
                    for (int r = 0; r < 16; ++r) { const int s_ = crow(r, hi), c_ = r32; const bool keepv = dir == 0 ? (s_ <= c_) : (s_ > c_); if (!keepv) x[r] = 0.f; }
                }
                const bf16x8 p0 = pack8(x, 0), p1 = pack8(x, 1);
                const LAS char* vb = (const LAS char*)L + 49152 + (dvt * 4 + 2 * st) * 1024 + vperm;
                const bf16x8 v0 = mk8(vtr(vb), vtr(vb + 512)), v1 = mk8(vtr(vb + 1024), vtr(vb + 1024 + 512));
                o = MFMA32(p0, v0, o); o = MFMA32(p1, v1, o);
            }
        st_nat((bf16_t*)(F.ws + WS_OI) + (m0 + 32 * ct) * 512 + h * 128 + 32 * dvt, o, r32, hi);
    }
    {
        const int dkt = w & 1, dvt = w >> 1;
#pragma unroll
        for (int dir = 0; dir < 2; ++dir) {
            f32x16 u = f32x16{};
#pragma unroll
            for (int t = 0; t < 4; ++t) {
                const LAS char* ka = (const LAS char*)L + 32768 + dir * 8192 + (dkt * 4 + t) * 1024 + vnat;
                const LAS char* vb = (const LAS char*)L + 49152 + (dvt * 4 + t) * 1024 + vnat;
                const bf16x8 af = mk8(vtr(ka), vtr(ka + 256)), bfr = mk8(vtr(vb), vtr(vb + 256));
                u = MFMA32(af, bfr, u);
            }
            st_tile((unsigned*)(F.ws + WS_U) + (((size_t)unit * 2 + dir) * 8 + dkt * 4 + dvt) * 512, u, lane);
        }
    }
    asm volatile("s_waitcnt lgkmcnt(0)\n\ts_barrier" ::: "memory");
}
__device__ __forceinline__ void gla_intra_phase(Frame& F, int l) {
    int u = F.bid; if (u >= 2048) return;
    IntraPre cur, nxt; int hs = -1;
    gla_intra_load(F, u, cur);
#pragma unroll 1
    for (; u < 2048; u += F.G) {
        const int un = u + F.G; const bool hn = un < 2048;
        if (hn) gla_intra_load(F, un, nxt);
        const int h = u & 3;
        if (h != hs) {
            const float* wu = par(F, l, PAR_WDU); const float* bd = par(F, l, PAR_BDEC);
            for (int i = F.tid; i < 2048; i += 512) ((LAS float*)(F.lds + 65536))[i] = wu[(i >> 6) * 256 + h * 64 + (i & 63)];
            if (F.tid < 128) ((LAS float*)(F.lds + 73728))[F.tid] = bd[(F.tid >> 6) * 256 + h * 64 + (F.tid & 63)];
            hs = h;
            asm volatile("s_waitcnt lgkmcnt(0)\n\ts_barrier" ::: "memory");
        }
        gla_intra_unit(F, l, u, cur);
        if (hn) cur = nxt;
    }
}
__device__ __forceinline__ void gla_scan(Frame& F, int chain) {
    const int b = chain >> 3, h = (chain >> 1) & 3, dir = chain & 1;
    const int lane = F.lane, r32 = lane & 31, hi = lane >> 5, dvt = F.wave;
    if (dvt >= 4) return;
    const bf16_t* QD = (const bf16_t*)(F.ws + WS_QD) + (size_t)dir * T * 256;
    f32x16 S0 = f32x16{}, S1 = f32x16{};
#pragma unroll 1
    for (int step = 0; step < 64; ++step) {
        const int n = dir == 0 ? step : 63 - step;
        const int unit = (b * 64 + n) * 4 + h;
        const size_t m0 = (size_t)b * SEQ + 64 * n;
        bf16x8 qa[2][4];
#pragma unroll
        for (int ct = 0; ct < 2; ++ct)
#pragma unroll
            for (int t = 0; t < 4; ++t) {
                const bf16_t* qp = QD + (m0 + 32 * ct + r32) * 256 + h * 64 + 16 * t + 4 * hi;
                const u32x2 lo = *(const u32x2*)qp, hh = *(const u32x2*)(qp + 8);
                u32x4 q4; q4.x = lo.x; q4.y = lo.y; q4.z = hh.x; q4.w = hh.y; qa[ct][t] = __builtin_bit_cast(bf16x8, q4);
            }
        const unsigned* up = (const unsigned*)(F.ws + WS_U) + (((size_t)unit * 2 + dir) * 8 + dvt) * 512;
        unsigned u0[8], u1[8];
#pragma unroll
        for (int i = 0; i < 8; ++i) { u0[i] = up[i * 64 + lane]; u1[i] = up[4 * 512 + i * 64 + lane]; }
        const float* dp = (const float*)(F.ws + WS_DEC) + (size_t)unit * 128 + dir * 64;
        f32x4 d0[4], d1[4];
#pragma unroll
        for (int q = 0; q < 4; ++q) { d0[q] = *(const f32x4*)(dp + 8 * q + 4 * hi); d1[q] = *(const f32x4*)(dp + 32 + 8 * q + 4 * hi); }
        const bf16x8 sb0 = pack8(S0, 0), sb1 = pack8(S0, 1), sb2 = pack8(S1, 0), sb3 = pack8(S1, 1);
        f32x16 oi[2];
#pragma unroll
        for (int ct = 0; ct < 2; ++ct) { f32x16 a = f32x16{}; a = MFMA32(qa[ct][0], sb0, a); a = MFMA32(qa[ct][1], sb1, a); a = MFMA32(qa[ct][2], sb2, a); a = MFMA32(qa[ct][3], sb3, a); oi[ct] = a; }
#pragma unroll
        for (int i = 0; i < 8; ++i) {
            S0[2 * i] = S0[2 * i] * d0[(2 * i) >> 2][(2 * i) & 3] + bflo(u0[i]); S0[2 * i + 1] = S0[2 * i + 1] * d0[(2 * i + 1) >> 2][(2 * i + 1) & 3] + bfhi(u0[i]);
            S1[2 * i] = S1[2 * i] * d1[(2 * i) >> 2][(2 * i) & 3] + bflo(u1[i]); S1[2 * i + 1] = S1[2 * i + 1] * d1[(2 * i + 1) >> 2][(2 * i + 1) & 3] + bfhi(u1[i]);
        }
        bf16_t* op = (bf16_t*)(F.ws + WS_OT) + (size_t)dir * T * 512 + m0 * 512 + h * 128 + 32 * dvt;
        st_nat(op, oi[0], r32, hi); st_nat(op + 32 * 512, oi[1], r32, hi);
    }
}
__device__ __forceinline__ void gla_final_stream(Frame& F, int l) {
    const u32x4* OI = (const u32x4*)(F.ws + WS_OI); const u32x4* OF = (const u32x4*)(F.ws + WS_OT); const u32x4* OBk = OF + (size_t)T * 512 / 8;
    const u32x4* OG = (const u32x4*)(F.ws + WS_OG); u32x4* OUT = (u32x4*)(F.ws + WS_OB);
    const float* gn = par(F, l, PAR_GLAG) + (F.tid & 15) * 8;
    const f32x4 g0 = *(const f32x4*)gn, g1 = *(const f32x4*)(gn + 4);
    const float gg[8] = {g0.x, g0.y, g0.z, g0.w, g1.x, g1.y, g1.z, g1.w};
    const int n16 = T * 512 / 8, stride = F.G * 512;
#pragma unroll 2
    for (int idx = F.bid * 512 + F.tid; idx < n16; idx += stride) {
        const u32x4 a = OI[idx], b = OF[idx], c = OBk[idx], g = OG[idx];
        float v[8] = {bflo(a.x) + bflo(b.x) + bflo(c.x), bfhi(a.x) + bfhi(b.x) + bfhi(c.x), bflo(a.y) + bflo(b.y) + bflo(c.y), bfhi(a.y) + bfhi(b.y) + bfhi(c.y),
                      bflo(a.z) + bflo(b.z) + bflo(c.z), bfhi(a.z) + bfhi(b.z) + bfhi(c.z), bflo(a.w) + bflo(b.w) + bflo(c.w), bfhi(a.w) + bfhi(b.w) + bfhi(c.w)};
        const float og[8] = {bflo(g.x), bfhi(g.x), bflo(g.y), bfhi(g.y), bflo(g.z), bfhi(g.z), bflo(g.w), bfhi(g.w)};
        float s = 0.f;
#pragma unroll
        for (int e = 0; e < 8; ++e) s += v[e] * v[e];
        s += __shfl_xor(s, 1); s += __shfl_xor(s, 2); s += __shfl_xor(s, 4); s += __shfl_xor(s, 8);
        const float rs = __builtin_amdgcn_rsqf(s * (1.0f / 128.0f) + EPS);
#pragma unroll
        for (int e = 0; e < 8; ++e) v[e] = v[e] * rs * gg[e] * og[e];
        u32x4 o; o.x = cvtpk(v[0], v[1]); o.y = cvtpk(v[2], v[3]); o.z = cvtpk(v[4], v[5]); o.w = cvtpk(v[6], v[7]);
        OUT[idx] = o;
    }
}

__global__ void __launch_bounds__(512, 2) fwd_kernel(Args args) {
    extern __shared__ __attribute__((aligned(16))) unsigned char lds_raw[];
    Frame F;
    F.lds = (LAS unsigned char*)lds_raw; F.ws = args.ws; F.tid = threadIdx.x; F.lane = F.tid & 63; F.wave = __builtin_amdgcn_readfirstlane(F.tid >> 6);
    F.G = gridDim.x; F.bid = blockIdx.x; F.out = args.out;
    volatile LAS unsigned* MISC = (volatile LAS unsigned*)(F.lds + MISC_OFF);
    if (F.tid < 32) MISC[F.tid] = 0u;
    __syncthreads();
    const int lo = args.ph_lo, hi_ = args.ph_hi;
    XcdBarrier bar; bar.bar = (unsigned*)(F.ws + WS_CTL) + CW_BAR; bar.x = 0; bar.st = nullptr;
    if (hi_ - lo > 1) bar = xcd_barrier_post((unsigned*)(F.ws + WS_CTL) + CW_BAR, MISC + 8);
#ifndef PH_MASK
#define PH_MASK 0x1ff
#endif
#define IN(k) (lo <= (k) && (k) < hi_)
#define PM(j) ((PH_MASK >> (j)) & 1)
#define FRESH() do { F.tid = opaque_v(threadIdx.x); F.lane = F.tid & 63; F.wave = __builtin_amdgcn_readfirstlane(F.tid >> 6); } while (0)
#define SEAM(k) do { if (IN(k) && IN((k) + 1)) xcd_barrier(bar); } while (0)
    float* SSb = (float*)(F.ws + WS_SS);

#define REPS(j) (((j) == PROBE_PHASE && hi_ - lo > 1) ? 1 + PROBE_REPS : 1)
#define PHASE_BEGIN(j) for (int rep = 0; rep < REPS(j); ++rep) { const bool dry = rep + 1 < REPS(j); (void)dry; FRESH();
#define PHASE_END() if (dry) xcd_barrier(bar); }
    if (PM(0) && IN(0)) { PHASE_BEGIN(0) p0_prologue(F, args); PHASE_END() }
    SEAM(0);
#pragma unroll 1
    for (int l = 0; l < 2; ++l) {
        const int pb = 1 + 8 * l;
        unsigned char* wl = F.ws + WS_W + (size_t)l * W_LAYER;
        if (PM(1) && IN(pb + 0)) { PHASE_BEGIN(1)
            {
                pg8::Gemm g{(const bf16_t*)(F.ws + WS_XB), (const bf16_t*)(wl + W_INA), DM, DM, DM};
                pg8::Sched S; S.init(T, 3072, 1, F.G, F.bid, 256 * DM * 2, 0, 256 * DM * 2, 0);
                EpiQKV E{F.ws, SSb + (size_t)(2 * l) * T, par(F, l, PAR_GKA)};
                pg8::gemm_phase<EpiQKV, true, true>(F.lds, g, S, E);
            }
            if (l == 0) {
                pg8::Gemm g{(const bf16_t*)(F.ws + WS_MB), (const bf16_t*)(F.ws + WS_W + W_MKV), DM, DM, DM};
                pg8::Sched S; S.init(TMEM, 1024, 2, F.G, F.bid, 256 * DM * 2, 0, 256 * DM * 2, (unsigned)W_LAYER);
                EpiRowScale<0> E{(bf16_t*)(F.ws + WS_KVM), 1024, (size_t)TMEM * 1024, (const float*)(F.ws + WS_MSS)};
                pg8::gemm_phase<EpiRowScale<0>, true, true>(F.lds, g, S, E);
            }
        PHASE_END() }
        SEAM(pb + 0);
        if (PM(2) && IN(pb + 1)) { PHASE_BEGIN(2) gla_intra_phase(F, l); PHASE_END() }
        SEAM(pb + 1);
        if (PM(3) && IN(pb + 2)) { PHASE_BEGIN(3)
            if (F.bid < 64) gla_scan(F, F.bid);
            else { const int nb = F.G - 64;
                for (int u = F.bid - 64; u < 512 + 256; u += nb) { if (u < 512) winattn_unit(F, l, u, dry); else memattn_unit(F, l, u - 512, dry); } }
        PHASE_END() }
        SEAM(pb + 2);
        if (PM(4) && IN(pb + 3)) { PHASE_BEGIN(4)
            gla_final_stream(F, l);
            pg8::Gemm g{(const bf16_t*)(F.ws + WS_XB), (const bf16_t*)(wl + W_ING), DM, DM, DM};
            pg8::Sched S; S.init(T, 3072, 1, F.G, F.bid, 256 * DM * 2, 0, 256 * DM * 2, 0);
            EpiRowScale<1> E{(bf16_t*)(F.ws + WS_G), 3072, 0, SSb + (size_t)(2 * l) * T};
            pg8::gemm_phase<EpiRowScale<1>, true, true>(F.lds, g, S, E);
        PHASE_END() }
        SEAM(pb + 3);
        if (PM(5) && IN(pb + 4)) { PHASE_BEGIN(5)
            pg8::Gemm g{(const bf16_t*)(F.ws + WS_QA), (const bf16_t*)(wl + W_BR), 512, 1536, 512};
            pg8::Sched S; S.init(T, 1024, 3, F.G, F.bid, 256 * 512 * 2, 32 * MiB, 256 * 1536 * 2, 512 * 2);
            EpiMerge E{(const bf16_t*)(F.ws + WS_G), (bf16_t*)(F.ws + WS_MG)};
            pg8::gemm_phase<EpiMerge, true, true>(F.lds, g, S, E);
        PHASE_END() }
        SEAM(pb + 4);
        if (PM(6) && IN(pb + 5)) { PHASE_BEGIN(6)
            pg8::Gemm g{(const bf16_t*)(F.ws + WS_MG), (const bf16_t*)(wl + W_OUT), DM, DM, DM};
            pg8::Sched S; S.init(T, 1024, 1, F.G, F.bid, 256 * DM * 2, 0, 256 * DM * 2, 0);
            EpiRes E{l == 0 ? args.in[I_X] : F.out, F.out, (bf16_t*)(F.ws + WS_XB), SSb + (size_t)(2 * l + 1) * T, dry};
            pg8::gemm_phase<EpiRes, true, true>(F.lds, g, S, E);
        PHASE_END() }
        SEAM(pb + 5);
        if (PM(7) && IN(pb + 6)) { PHASE_BEGIN(7)
            pg8::Gemm g{(const bf16_t*)(F.ws + WS_XB), (const bf16_t*)(wl + W_FI), DM, DM, DM};
            pg8::Sched S; S.init(T, 2 * DFF, 1, F.G, F.bid, 256 * DM * 2, 0, 256 * DM * 2, 0);
            EpiFFN E{(bf16_t*)(F.ws + WS_H), SSb + (size_t)(2 * l + 1) * T};
            pg8::gemm_phase<EpiFFN, true, true>(F.lds, g, S, E);
        PHASE_END() }
        SEAM(pb + 6);
        if (PM(8) && IN(pb + 7)) { PHASE_BEGIN(8)
            pg8::Gemm g{(const bf16_t*)(F.ws + WS_H), (const bf16_t*)(wl + W_FO), DFF, DFF, DFF};
            pg8::Sched S; S.init(T, 1024, 1, F.G, F.bid, 256 * DFF * 2, 0, 256 * DFF * 2, 0);
            EpiRes E{F.out, F.out, l == 0 ? (bf16_t*)(F.ws + WS_XB) : nullptr, SSb + (size_t)(2 * l + 2) * T, dry};
            pg8::gemm_phase<EpiRes, true, true>(F.lds, g, S, E);
        PHASE_END() }
        SEAM(pb + 7);
    }
#undef IN
#undef SEAM
}

extern "C" void kernel_launch(void* const* d_in, const int* in_sizes, int n_in, void* d_out, int out_size, void* d_ws, size_t ws_size, hipStream_t stream) {
    static int grid = 0;
    if (grid == 0) {
        if (n_in != 20 || ws_size < WS_END) { fprintf(stderr, "kernel_launch: unexpected n_in %d / ws %zu\n", n_in, ws_size); grid = -1; return; }
        int dev = 0, cus = 0, per_cu = 0;
        if (hipGetDevice(&dev) != hipSuccess || hipDeviceGetAttribute(&cus, hipDeviceAttributeMultiprocessorCount, dev) != hipSuccess) { grid = -1; return; }
        if (hipFuncSetAttribute((const void*)fwd_kernel, hipFuncAttributeMaxDynamicSharedMemorySize, LDS_BYTES) != hipSuccess) { fprintf(stderr, "kernel_launch: hipFuncSetAttribute failed\n"); grid = -1; return; }
        if (hipOccupancyMaxActiveBlocksPerMultiprocessor(&per_cu, (const void*)fwd_kernel, 512, LDS_BYTES) != hipSuccess || per_cu < 1) { fprintf(stderr, "kernel_launch: occupancy query says %d blocks/CU\n", per_cu); per_cu = 1; }
        (void)hipGetLastError();
        grid = cus;
    }
    if (grid < 0) return;
    (void)hipMemsetAsync((char*)d_ws + WS_CTL, 0, 1 * MiB, stream);
    Args a{};
    for (int i = 0; i < 20; ++i) a.in[i] = (const float*)d_in[i];
    a.out = (float*)d_out; a.ws = (unsigned char*)d_ws;
#if MK_N_LAUNCHES == 1
    a.ph_lo = 0; a.ph_hi = NPH;
    hipLaunchKernelGGL(fwd_kernel, dim3(grid), dim3(512), LDS_BYTES, stream, a);
#else
    for (int p = 0; p < NPH; ++p) { a.ph_lo = p; a.ph_hi = p + 1; hipLaunchKernelGGL(fwd_kernel, dim3(grid), dim3(512), LDS_BYTES, stream, a); }
#endif
}
```

```cpp
#include <hip/hip_runtime.h>
#include <cstdio>
#include <cstdint>

#ifndef MK_N_LAUNCHES
#define MK_N_LAUNCHES 1
#endif

#ifndef PROBE_PHASE
#define PROBE_PHASE -1
#define PROBE_REPS 0
#endif
#ifndef TSEC
#define TSEC -1
#define TGAIN 4
#endif
#ifndef TPH
#define TPH -1
#endif
#define LAS __attribute__((address_space(3)))
#define GAS __attribute__((address_space(1)))
typedef unsigned short bf16_t;
typedef short bf16x8 __attribute__((ext_vector_type(8)));
typedef short s16x4 __attribute__((ext_vector_type(4)));
typedef short v4i16_t __attribute__((ext_vector_type(4)));
typedef float f32x2 __attribute__((ext_vector_type(2)));
typedef float f32x4 __attribute__((ext_vector_type(4)));
typedef float f32x16 __attribute__((ext_vector_type(16)));
typedef unsigned u32x2 __attribute__((ext_vector_type(2)));
typedef unsigned u32x4 __attribute__((ext_vector_type(4)));
typedef __bf16 bf16x2_t __attribute__((ext_vector_type(2)));

constexpr int DM = 1024, BATCH = 8, SEQ = 4096, T = BATCH * SEQ, NMEM = 256, TMEM = BATCH * NMEM;
constexpr int DFF = 2816, DIN = 5920;
constexpr float EPS = 1e-6f, LOG2E = 1.4426950408889634f;
constexpr int NPH = 17;

constexpr size_t MiB = 1u << 20;
constexpr size_t WS_CTL = 0;
constexpr size_t WS_SS = 512 * 1024;
constexpr size_t WS_MSS = 1 * MiB;
constexpr size_t WS_BIAS = 1 * MiB + 64 * 1024;
constexpr size_t WS_PAR = 1 * MiB + 128 * 1024;
constexpr int PAR_GKA = 0, PAR_SINK = 64, PAR_GKM = 128, PAR_GLAG = 256, PAR_BDEC = 384, PAR_WDU = 896, PAR_LAYER = 896 + 8192;
constexpr size_t WS_DEC = 2 * MiB;
constexpr size_t WS_KVM = 3 * MiB;
constexpr size_t WS_MB = 11 * MiB;
constexpr size_t WS_W = 16 * MiB;
constexpr size_t W_INA = 0, W_ING = 6 * MiB, W_MKV = 12 * MiB, W_BR = 14 * MiB, W_OUT = 17 * MiB, W_FI = 19 * MiB, W_FO = 30 * MiB, W_LAYER = 35 * MiB + 512 * 1024;
constexpr size_t WS_XB = 88 * MiB;
constexpr size_t WS_QA = 152 * MiB;
constexpr size_t WS_OB = 184 * MiB;
constexpr size_t WS_QM = 216 * MiB;
constexpr size_t WS_KA = 248 * MiB, WS_VA = 256 * MiB;
constexpr size_t WS_QB = 264 * MiB, WS_KB = 280 * MiB;
constexpr size_t WS_VB = 296 * MiB, WS_OG = 328 * MiB;
constexpr size_t WS_LR = 360 * MiB;
constexpr size_t WS_QD = 362 * MiB;
constexpr size_t WS_U = 394 * MiB;
constexpr size_t WS_OI = 458 * MiB;
constexpr size_t WS_OT = 264 * MiB;
constexpr size_t WS_G = 248 * MiB;
constexpr size_t WS_MG = 440 * MiB;
constexpr size_t WS_H = 248 * MiB;
constexpr size_t WS_END = 512 * MiB;
static_assert(WS_OI + 32 * MiB <= WS_END && WS_MG + 64 * MiB <= WS_END && WS_W + 2 * W_LAYER <= WS_XB && WS_G + 192 * MiB <= WS_MG && WS_H + 176 * MiB <= WS_END, "ws map");

constexpr int CW_BAR = 4096;

constexpr int RING_BYTES = 131072;
constexpr int MISC_OFF = 155648;
constexpr int WSF_OFF = 156672;
constexpr int LDS_BYTES = 163840;

__device__ __forceinline__ unsigned cvtpk(float lo, float hi) { f32x2 v = {lo, hi}; bf16x2_t b = __builtin_convertvector(v, bf16x2_t); return __builtin_bit_cast(unsigned, b); }
__device__ __forceinline__ float bflo(unsigned w) { return __uint_as_float(w << 16); }
__device__ __forceinline__ float bfhi(unsigned w) { return __uint_as_float(w & 0xffff0000u); }
__device__ __forceinline__ float ex2(float x) { return __builtin_amdgcn_exp2f(x); }
__device__ __forceinline__ float sigmoidf_(float x) { return __builtin_amdgcn_rcpf(1.0f + ex2(-x * LOG2E)); }
__device__ __forceinline__ float siluf_(float x) { return x * sigmoidf_(x); }
__device__ __forceinline__ int crow(int r, int hi) { return (r & 3) + 8 * (r >> 2) + 4 * hi; }
__device__ __forceinline__ float swapmax(float v) { auto rr = __builtin_amdgcn_permlane32_swap(__float_as_uint(v), __float_as_uint(v), false, false); return fmaxf(__uint_as_float(rr[0]), __uint_as_float(rr[1])); }
__device__ __forceinline__ float swapsum(float v) { auto rr = __builtin_amdgcn_permlane32_swap(__float_as_uint(v), __float_as_uint(v), false, false); return __uint_as_float(rr[0]) + __uint_as_float(rr[1]); }
__device__ __forceinline__ s16x4 vtr(const LAS char* p) { return __builtin_bit_cast(s16x4, __builtin_amdgcn_ds_read_tr16_b64_v4i16((LAS v4i16_t*)p)); }
#define MFMA32(a, b, c) __builtin_amdgcn_mfma_f32_32x32x16_bf16((a), (b), (c), 0, 0, 0)
__device__ __forceinline__ bf16x8 pack8(const f32x16& x, int s) {
    u32x4 p; p.x = cvtpk(x[8 * s], x[8 * s + 1]); p.y = cvtpk(x[8 * s + 2], x[8 * s + 3]); p.z = cvtpk(x[8 * s + 4], x[8 * s + 5]); p.w = cvtpk(x[8 * s + 6], x[8 * s + 7]);
    return __builtin_bit_cast(bf16x8, p);
}
__device__ __forceinline__ bf16x8 mk8(s16x4 lo, s16x4 hi) { return (bf16x8){lo[0], lo[1], lo[2], lo[3], hi[0], hi[1], hi[2], hi[3]}; }

__device__ __forceinline__ int opaque_v(int v) { asm volatile("" : "+v"(v)); return v; }
namespace pg8 {
constexpr int BM = 256, BK = 64, HALF = 128, HTB = HALF * BK * 2, NXCD = 8, WGM = 4;
__host__ __device__ __forceinline__ int lds_byte(int r, int c) { const int st = (r >> 4) * 2 + (c >> 5), rr = r & 15, cc = c & 31, ob = rr * 64 + cc * 2; return st * 1024 + (ob ^ (((ob >> 9) & 1) << 5)); }
__host__ __device__ __forceinline__ void stage_rc(int b, int& R, int& C) { const int st = b / 1024, sb = b % 1024, swz = sb ^ (((sb >> 9) & 1) << 5); R = (st >> 1) * 16 + swz / 64; C = (st & 1) * 32 + (swz % 64) / 2; }
__host__ __device__ __forceinline__ int perm32(int rho) { const int n = rho >> 4, i = rho & 15; return 8 * (i >> 2) + 4 * n + (i & 3); }

struct Unit { int pm, pn, sub; unsigned aoff, boff; };
struct Gemm { const bf16_t* A; const bf16_t* Bt; int lda, ldb, K; unsigned* tp; };

struct Sched {
    int nM, nN, nSub, nwg, G, c; unsigned a_pm, a_sub, b_pn, b_sub; bool subFast;
    __device__ void init(int M, int N, int nSub_, int G_, int c_, unsigned a_pm_, unsigned a_sub_, unsigned b_pn_, unsigned b_sub_) {
        nM = M / BM; nN = N / BM; nSub = nSub_; nwg = nM * nN; G = G_; c = c_; a_pm = a_pm_; a_sub = a_sub_; b_pn = b_pn_; b_sub = b_sub_; subFast = true; }
    __device__ bool next(int i, Unit& u) const {
        int round, sub; long L;
        if (subFast) { round = i / nSub; sub = i - round * nSub; L = (long)round * G + c; if (L >= nwg) return false; }
        else { const long LL = (long)i * G + c; if (LL >= (long)nwg * nSub) return false; sub = (int)(LL / nwg); L = LL - (long)sub * nwg; }
        int wgid = (int)L; { const int q = nwg / NXCD, r = nwg % NXCD, xcd = wgid % NXCD, off = wgid / NXCD; wgid = (xcd < r ? xcd * (q + 1) : r * (q + 1) + (xcd - r) * q) + off; }
        const int nig = WGM * nN, gid = wgid / nig, fm = gid * WGM, gsz = (nM - fm) < WGM ? (nM - fm) : WGM;
        u.pm = fm + ((wgid % nig) % gsz); u.pn = (wgid % nig) / gsz; u.sub = sub;
        u.aoff = (unsigned)u.pm * a_pm + (unsigned)sub * a_sub; u.boff = (unsigned)u.pn * b_pn + (unsigned)sub * b_sub; return true;
    }
};

template <class Epi, bool ALIGN_EPI, bool SP2>
__device__ __forceinline__ void gemm_phase(LAS unsigned char* lds, const Gemm g, const Sched& S, const Epi& E) {
    const int tid = opaque_v(threadIdx.x), wid = __builtin_amdgcn_readfirstlane(tid >> 6), lane = tid & 63, wr = wid >> 2, wc = wid & 3, fr = lane & 15, fq = lane >> 4;
    const int K = g.K, nt = K / BK;
    unsigned voffA[2], voffB[2];
#pragma unroll
    for (int i = 0; i < 2; ++i) { int R, C; stage_rc(tid * 16 + i * 8192, R, C); const int Rb = (R & ~31) + perm32(R & 31);
        voffA[i] = (unsigned)(R * g.lda + C) * 2u; voffB[i] = (unsigned)(Rb * g.ldb + C) * 2u; }
    const size_t kstep = (size_t)(BK * 2);
    const size_t hstepA = (size_t)HALF * g.lda * 2, hstepB = (size_t)HALF * g.ldb * 2;
    const unsigned ldsw = (unsigned)wid * 1024u;
    const int aoff = lds_byte(wr * 64 + fr, fq * 8), boff = lds_byte(wc * 32 + fr, fq * 8);
#define PG8_SA(b, h) (((b) * 2 + (h)) * HTB)
#define PG8_SB(b, h) ((4 + (b) * 2 + (h)) * HTB)
#define PG8_STAGE(bufoff, gbase, voff) do { _Pragma("unroll") for (int _i = 0; _i < 2; ++_i) \
        __builtin_amdgcn_global_load_lds((const unsigned*)((const char*)(gbase) + (voff)[_i]), (LAS unsigned*)(lds + (bufoff) + ldsw + _i * 8192), 16, 0, 0); } while (0)
#define PG8_LDA(dst, b, h) do { _Pragma("unroll") for (int m = 0; m < 4; ++m) _Pragma("unroll") for (int k = 0; k < 2; ++k) dst[m][k] = *(const LAS bf16x8*)(lds + PG8_SA(b, h) + aoff + m * 2048 + k * 1024); } while (0)
#define PG8_LDB(dst, b, h) do { _Pragma("unroll") for (int n = 0; n < 2; ++n) _Pragma("unroll") for (int k = 0; k < 2; ++k) dst[n][k] = *(const LAS bf16x8*)(lds + PG8_SB(b, h) + boff + n * 2048 + k * 1024); } while (0)
#define PG8_MMA(ai, bj, At, Bt) do { __builtin_amdgcn_s_setprio(1); _Pragma("unroll") for (int m = 0; m < 4; ++m) _Pragma("unroll") for (int n = 0; n < 2; ++n) _Pragma("unroll") for (int k = 0; k < 2; ++k) \
        acc[ai][bj][m][n] = __builtin_amdgcn_mfma_f32_16x16x32_bf16(Bt[n][k], At[m][k], acc[ai][bj][m][n], 0, 0, 0); __builtin_amdgcn_s_setprio(0); } while (0)
#define PG8_WAIT_V(n) asm volatile("s_waitcnt vmcnt(" #n ")" ::: "memory")
#define PG8_WAIT_L(n) asm volatile("s_waitcnt lgkmcnt(" #n ")" ::: "memory")
#define PG8_BAR __builtin_amdgcn_s_barrier()
#define PG8_SCHED __builtin_amdgcn_sched_barrier(0)
    Unit cur, nxt; int ui = 0;
    if (!S.next(0, cur)) return;
    f32x4 acc[2][2][4][2];
#pragma unroll
    for (int a = 0; a < 2; ++a)
#pragma unroll
        for (int b = 0; b < 2; ++b)
#pragma unroll
            for (int m = 0; m < 4; ++m)
#pragma unroll
                for (int n = 0; n < 2; ++n) acc[a][b][m][n] = (f32x4){0.f, 0.f, 0.f, 0.f};
    bf16x8 At[4][2], B0[2][2], B1[2][2];
    const char* cA = (const char*)g.A + cur.aoff; const char* cB = (const char*)g.Bt + cur.boff;
    if constexpr (SP2) {
        PG8_STAGE(PG8_SB(0, 0), cB, voffB); PG8_STAGE(PG8_SB(0, 1), cB + hstepB, voffB); PG8_STAGE(PG8_SA(0, 0), cA, voffA); PG8_STAGE(PG8_SA(0, 1), cA + hstepA, voffA);
        if (wr == 1) PG8_BAR;
        PG8_WAIT_V(2); PG8_BAR;
        PG8_STAGE(PG8_SB(1, 0), cB + kstep, voffB); PG8_STAGE(PG8_SA(1, 0), cA + kstep, voffA); PG8_STAGE(PG8_SB(1, 1), cB + hstepB + kstep, voffB);
        PG8_WAIT_V(6); PG8_BAR;
    } else {
        PG8_STAGE(PG8_SB(0, 0), cB, voffB); PG8_STAGE(PG8_SA(0, 0), cA, voffA); PG8_STAGE(PG8_SB(0, 1), cB + hstepB, voffB); PG8_STAGE(PG8_SA(0, 1), cA + hstepA, voffA);
        if (wr == 1) PG8_BAR;
        PG8_WAIT_V(4); PG8_BAR;
        PG8_STAGE(PG8_SB(1, 0), cB + kstep, voffB); PG8_STAGE(PG8_SA(1, 0), cA + kstep, voffA); PG8_STAGE(PG8_SB(1, 1), cB + hstepB + kstep, voffB);
        PG8_WAIT_V(6); PG8_BAR;
    }
    for (;;) {
        const bool has_next = S.next(ui + 1, nxt);
        const char* nA = has_next ? (const char*)g.A + nxt.aoff : cA; const char* nB = has_next ? (const char*)g.Bt + nxt.boff : cB;
        const unsigned long long tk0_ = (TSEC == 9) ? __builtin_amdgcn_s_memrealtime() : ((TSEC == 13) ? __builtin_amdgcn_s_memtime() : 0ull);
        for (int t = 0; t < nt; t += 2) {
            const bool last = (t == nt - 2);
            const char* a1 = cA + (size_t)(t + 1) * kstep;
            const char* a2 = last ? nA : cA + (size_t)(t + 2) * kstep; const char* b2 = last ? nB : cB + (size_t)(t + 2) * kstep;
            const char* a3 = a2 + kstep; const char* b3 = b2 + kstep;
            if constexpr (SP2) {
            PG8_LDB(B0, 0, 0); PG8_LDB(B1, 0, 1); PG8_SCHED; PG8_LDA(At, 0, 0); PG8_STAGE(PG8_SA(1, 1), a1 + hstepA, voffA);
            PG8_WAIT_V(8); PG8_WAIT_L(0); PG8_BAR; PG8_MMA(0, 0, At, B0); PG8_MMA(0, 1, At, B1); PG8_BAR; PG8_SCHED;
            PG8_LDA(At, 0, 1); PG8_STAGE(PG8_SB(0, 0), b2, voffB); PG8_STAGE(PG8_SB(0, 1), b2 + hstepB, voffB); PG8_STAGE(PG8_SA(0, 0), a2, voffA);
            PG8_WAIT_V(8); PG8_WAIT_L(0); PG8_BAR; PG8_MMA(1, 0, At, B0); PG8_MMA(1, 1, At, B1); PG8_BAR; PG8_SCHED;
            PG8_LDB(B0, 1, 0); PG8_LDB(B1, 1, 1); PG8_SCHED; PG8_LDA(At, 1, 0); PG8_STAGE(PG8_SA(0, 1), a2 + hstepA, voffA);
            PG8_WAIT_V(8); PG8_WAIT_L(0); PG8_BAR; PG8_MMA(0, 0, At, B0); PG8_MMA(0, 1, At, B1); PG8_BAR; PG8_SCHED;
            PG8_LDA(At, 1, 1); PG8_STAGE(PG8_SB(1, 0), b3, voffB); PG8_STAGE(PG8_SB(1, 1), b3 + hstepB, voffB); PG8_STAGE(PG8_SA(1, 0), a3, voffA);
            PG8_WAIT_V(8); PG8_WAIT_L(0); PG8_BAR; PG8_MMA(1, 0, At, B0); PG8_MMA(1, 1, At, B1); PG8_BAR; PG8_SCHED;
            } else {
            PG8_LDB(B0, 0, 0); PG8_SCHED; PG8_LDA(At, 0, 0); PG8_STAGE(PG8_SA(1, 1), a1 + hstepA, voffA);
            PG8_WAIT_L(8); PG8_BAR; PG8_WAIT_L(0); PG8_MMA(0, 0, At, B0); PG8_BAR; PG8_SCHED;
            PG8_LDB(B1, 0, 1); PG8_STAGE(PG8_SB(0, 0), b2, voffB);
            PG8_BAR; PG8_WAIT_L(0); PG8_MMA(0, 1, At, B1); PG8_BAR;
            PG8_LDA(At, 0, 1); PG8_STAGE(PG8_SA(0, 0), a2, voffA);
            PG8_BAR; PG8_WAIT_L(0); PG8_MMA(1, 0, At, B0); PG8_BAR; PG8_SCHED;
            PG8_STAGE(PG8_SB(0, 1), b2 + hstepB, voffB);
            PG8_WAIT_V(6); PG8_BAR; PG8_MMA(1, 1, At, B1); PG8_BAR;
            PG8_LDB(B0, 1, 0); PG8_SCHED; PG8_LDA(At, 1, 0); PG8_STAGE(PG8_SA(0, 1), a2 + hstepA, voffA);
            PG8_WAIT_L(8); PG8_BAR; PG8_WAIT_L(0); PG8_MMA(0, 0, At, B0); PG8_BAR; PG8_SCHED;
            PG8_LDB(B1, 1, 1); PG8_STAGE(PG8_SB(1, 0), b3, voffB);
            PG8_BAR; PG8_WAIT_L(0); PG8_MMA(0, 1, At, B1); PG8_BAR;
            PG8_LDA(At, 1, 1); PG8_STAGE(PG8_SA(1, 0), a3, voffA);
            PG8_BAR; PG8_WAIT_L(0); PG8_MMA(1, 0, At, B0); PG8_BAR; PG8_SCHED;
            PG8_STAGE(PG8_SB(1, 1), b3 + hstepB, voffB);
            PG8_WAIT_V(6); PG8_BAR; PG8_MMA(1, 1, At, B1); PG8_BAR;
            }
        }
        if ((TSEC == 9 || TSEC == 13) && g.tp && tid == 0 && blockIdx.x == 0) { const unsigned long long d_ = ((TSEC == 9) ? __builtin_amdgcn_s_memrealtime() : __builtin_amdgcn_s_memtime()) - tk0_; *g.tp += (unsigned)((TSEC == 9) ? d_ : (d_ >> 5)); }
        if constexpr (ALIGN_EPI) { if (wr == 0) PG8_BAR; }
        const unsigned long long te0_ = (TSEC == 8) ? __builtin_amdgcn_s_memrealtime() : 0ull;
        const bool keep = E(acc, cur, wr, wc, fr, fq);
        if (TSEC == 8 && g.tp && tid == 0 && blockIdx.x == 0) { asm volatile("s_waitcnt vmcnt(0)" ::: "memory"); *g.tp += (unsigned)(__builtin_amdgcn_s_memrealtime() - te0_); }
        if (!has_next) break;
        if (!keep) {
#pragma unroll
        for (int a = 0; a < 2; ++a)
#pragma unroll
            for (int b = 0; b < 2; ++b)
#pragma unroll
                for (int m = 0; m < 4; ++m)
#pragma unroll
                    for (int n = 0; n < 2; ++n) acc[a][b][m][n] = (f32x4){0.f, 0.f, 0.f, 0.f};
        }
        cur = nxt; cA = nA; cB = nB; ++ui;
        if constexpr (ALIGN_EPI) { if (wr == 1) PG8_BAR; }
    }
    PG8_WAIT_V(0);
    if constexpr (!ALIGN_EPI) { if (wr == 0) PG8_BAR; }
    PG8_BAR;
#undef PG8_SA
#undef PG8_SB
#undef PG8_STAGE
#undef PG8_LDA
#undef PG8_LDB
#undef PG8_MMA
#undef PG8_WAIT_V
#undef PG8_WAIT_L
#undef PG8_BAR
#undef PG8_SCHED
}
}
typedef f32x4 Acc[2][2][4][2];
using pg8::Unit;

__device__ __forceinline__ void st16_wt(void* p, const u32x4 w) { asm volatile("global_store_dwordx4 %0, %1, off sc1\n\ts_nop 1" : : "v"(p), "v"(w) : "memory"); }
__device__ __forceinline__ void st8(bf16_t* p, const f32x4 a, const f32x4 b) { u32x4 w; w.x = cvtpk(a[0], a[1]); w.y = cvtpk(a[2], a[3]); w.z = cvtpk(b[0], b[1]); w.w = cvtpk(b[2], b[3]); st16_wt(p, w); }

struct EpiQKV {
    unsigned char* ws; const float* ss; const float* gka;
    __device__ __forceinline__ bool operator()(Acc& acc, const Unit& u, int wr, int wc, int fr, int fq) const {
        const int G = 4 * u.pn + wc;
        if (G >= 45) return false;
        unsigned dmib; int ld, g0, op;
        if (G < 8) { dmib = WS_QA / MiB; ld = 512; g0 = 0; op = 1; }
        else if (G < 10) { dmib = WS_KA / MiB; ld = 128; g0 = 8; op = 2; }
        else if (G < 12) { dmib = WS_VA / MiB; ld = 128; g0 = 10; op = 0; }
        else if (G < 16) { dmib = WS_QB / MiB; ld = 256; g0 = 12; op = 3; }
        else if (G < 20) { dmib = WS_KB / MiB; ld = 256; g0 = 16; op = 0; }
        else if (G < 28) { dmib = WS_VB / MiB; ld = 512; g0 = 20; op = 0; }
        else if (G < 36) { dmib = WS_OG / MiB; ld = 512; g0 = 28; op = 4; }
        else if (G < 44) { dmib = WS_QM / MiB; ld = 512; g0 = 36; op = 0; }
        else { dmib = WS_LR / MiB; ld = 32; g0 = 44; op = 5; }
        bf16_t* base = (bf16_t*)(ws + (size_t)dmib * MiB); const int col = 64 * (G - g0);
        f32x4 gk[2][2];
#pragma unroll
        for (int bj = 0; bj < 2; ++bj)
#pragma unroll
            for (int n = 0; n < 2; ++n) {
                gk[bj][n] = (f32x4){1.f, 1.f, 1.f, 1.f};
                if (op == 2) { const int d = 32 * bj + 8 * fq + 4 * n; gk[bj][n] = *(const f32x4*)(gka + d); }
            }
        const int row0 = u.pm * 256 + wr * 64 + fr;
        float rsv[2][4];
#pragma unroll
        for (int ai = 0; ai < 2; ++ai)
#pragma unroll
            for (int m = 0; m < 4; ++m) rsv[ai][m] = ss[row0 + ai * 128 + m * 16];
#pragma unroll
        for (int ai = 0; ai < 2; ++ai)
#pragma unroll
            for (int m = 0; m < 4; ++m) {
                const int row = row0 + ai * 128 + m * 16;
                const float rs = __builtin_amdgcn_rsqf(rsv[ai][m] * (1.0f / DM) + EPS);
                f32x4 v[2][2];
#pragma unroll
                for (int bj = 0; bj < 2; ++bj)
#pragma unroll
                    for (int n = 0; n < 2; ++n) v[bj][n] = acc[ai][bj][m][n] * rs;
                if (op == 1 || op == 2) {
                    float s = 0.f;
#pragma unroll
                    for (int bj = 0; bj < 2; ++bj)
#pragma unroll
                        for (int n = 0; n < 2; ++n) { const f32x4 x = v[bj][n]; s += (x[0] * x[0] + x[1] * x[1]) + (x[2] * x[2] + x[3] * x[3]); }
                    s += __shfl_xor(s, 16); s += __shfl_xor(s, 32);
                    const float r2 = __builtin_amdgcn_rsqf(s * (1.0f / 64.0f) + EPS);
#pragma unroll
                    for (int bj = 0; bj < 2; ++bj)
#pragma unroll
                        for (int n = 0; n < 2; ++n) v[bj][n] = v[bj][n] * r2 * gk[bj][n];
                } else if (op == 3) {
#pragma unroll
                    for (int bj = 0; bj < 2; ++bj)
#pragma unroll
                        for (int n = 0; n < 2; ++n) v[bj][n] = v[bj][n] * 0.125f;
                } else if (op == 4) {
#pragma unroll
                    for (int bj = 0; bj < 2; ++bj)
#pragma unroll
                        for (int n = 0; n < 2; ++n)
#pragma unroll
                            for (int e = 0; e < 4; ++e) v[bj][n][e] = siluf_(v[bj][n][e]);
                }
                bf16_t* rp = base + (size_t)row * ld + col + 8 * fq;
                st8(rp, v[0][0], v[0][1]);
                if (op != 5) st8(rp + 32, v[1][0], v[1][1]);
            }
        return false;
    }
};
template <int ACT> struct EpiRowScale {
    bf16_t* O; int ldc; size_t sub_stride; const float* ss;
    __device__ __forceinline__ bool operator()(Acc& acc, const Unit& u, int wr, int wc, int fr, int fq) const {
        const int row0 = u.pm * 256 + wr * 64 + fr, col0 = u.pn * 256 + wc * 32 + 8 * fq;
        bf16_t* base = O + (size_t)u.sub * sub_stride;
#pragma unroll
        for (int ai = 0; ai < 2; ++ai)
#pragma unroll
            for (int m = 0; m < 4; ++m) {
                const int row = row0 + ai * 128 + m * 16;
                const float rs = __builtin_amdgcn_rsqf(ss[row] * (1.0f / DM) + EPS);
#pragma unroll
                for (int bj = 0; bj < 2; ++bj) {
                    f32x4 a = acc[ai][bj][m][0] * rs, b = acc[ai][bj][m][1] * rs;
                    if (ACT == 1) {
#pragma unroll
                        for (int e = 0; e < 4; ++e) { a[e] = sigmoidf_(a[e]); b[e] = sigmoidf_(b[e]); }
                    }
                    st8(base + (size_t)row * ldc + col0 + bj * 128, a, b);
                }
            }
        return false;
    }
};
struct EpiGate {
    u32x4* GT; const float* ss; unsigned* fin_cnt; unsigned fin_need; mutable bool fin_ok;
    __device__ __forceinline__ bool operator()(Acc& acc, const Unit& u, int wr, int wc, int fr, int fq) const {
        if (!fin_ok) { fin_ok = true; unsigned sp = 0; while (__hip_atomic_load(fin_cnt, __ATOMIC_RELAXED, __HIP_MEMORY_SCOPE_AGENT) < fin_need && ++sp < (1u << 22)) __builtin_amdgcn_s_sleep(2); }
        const int row0 = u.pm * 256 + wr * 64 + fr, lane = fq * 16 + fr, j = u.sub;
        const size_t gstride = (size_t)128 * 4 * 8 * 16 * 64;
        u32x4* gp = GT + (size_t)j * gstride + ((((size_t)u.pm * 4 + u.pn) * 8 + (wr * 4 + wc)) * 16) * 64 + lane;
        float rs[2][4];
#pragma unroll
        for (int ai = 0; ai < 2; ++ai)
#pragma unroll
            for (int m = 0; m < 4; ++m) rs[ai][m] = ss[row0 + ai * 128 + m * 16];
#pragma unroll
        for (int ai = 0; ai < 2; ++ai) {
            u32x4 pv[4][2];
            if (j > 0) {
#pragma unroll
                for (int m = 0; m < 4; ++m)
#pragma unroll
                    for (int bj = 0; bj < 2; ++bj) pv[m][bj] = *(const u32x4*)(gp - gstride + ((ai * 4 + m) * 2 + bj) * 64);
            }
#pragma unroll
            for (int m = 0; m < 4; ++m) {
                const float r = __builtin_amdgcn_rsqf(rs[ai][m] * (1.0f / DM) + EPS);
#pragma unroll
                for (int bj = 0; bj < 2; ++bj) {
                    const f32x4 a = acc[ai][bj][m][0] * (-r * LOG2E), b = acc[ai][bj][m][1] * (-r * LOG2E);
                    float t[8] = {1.0f + ex2(a[0]), 1.0f + ex2(a[1]), 1.0f + ex2(a[2]), 1.0f + ex2(a[3]), 1.0f + ex2(b[0]), 1.0f + ex2(b[1]), 1.0f + ex2(b[2]), 1.0f + ex2(b[3])};
#pragma unroll
                    for (int e = 0; e < 8; ++e) t[e] = fminf(t[e], 1e30f);
                    u32x4* cp = gp + ((ai * 4 + m) * 2 + bj) * 64;
                    if (j < 2) { u32x4 w; w.x = cvtpk(t[0], t[1]); w.y = cvtpk(t[2], t[3]); w.z = cvtpk(t[4], t[5]); w.w = cvtpk(t[6], t[7]); *cp = w; }
                    else { u32x4 w; w.x = cvtpk(__builtin_amdgcn_rcpf(t[0]), __builtin_amdgcn_rcpf(t[1])); w.y = cvtpk(__builtin_amdgcn_rcpf(t[2]), __builtin_amdgcn_rcpf(t[3]));
                           w.z = cvtpk(__builtin_amdgcn_rcpf(t[4]), __builtin_amdgcn_rcpf(t[5])); w.w = cvtpk(__builtin_amdgcn_rcpf(t[6]), __builtin_amdgcn_rcpf(t[7])); st16_wt(cp, w); }
                    if (j > 0) {
                        const u32x4 p = pv[m][bj];
                        const float n_[8] = {bflo(p.x), bfhi(p.x), bflo(p.y), bfhi(p.y), bflo(p.z), bfhi(p.z), bflo(p.w), bfhi(p.w)};
                        float q[8];
#pragma unroll
                        for (int e = 0; e < 8; ++e) q[e] = t[e] * __builtin_amdgcn_rcpf(n_[e]);
                        u32x4 rr; rr.x = cvtpk(q[0], q[1]); rr.y = cvtpk(q[2], q[3]); rr.z = cvtpk(q[4], q[5]); rr.w = cvtpk(q[6], q[7]);
                        st16_wt(cp - gstride, rr);
                    }
                }
            }
        }
        return false;
    }
};
struct EpiMerge {
    const u32x4* GT; bf16_t* O;
    __device__ __forceinline__ bool operator()(Acc& acc, const Unit& u, int wr, int wc, int fr, int fq) const {
        const int row0 = u.pm * 256 + wr * 64 + fr, col0 = u.pn * 256 + wc * 32 + 8 * fq, lane = fq * 16 + fr;
        const int sub = u.sub;
        const size_t gstride = (size_t)128 * 4 * 8 * 16 * 64;
        const u32x4* gp = GT + (size_t)sub * gstride + ((((size_t)u.pm * 4 + u.pn) * 8 + (wr * 4 + wc)) * 16) * 64 + lane;
        u32x4 ga[2][4][2];
#pragma unroll
        for (int ai = 0; ai < 2; ++ai)
#pragma unroll
            for (int m = 0; m < 4; ++m)
#pragma unroll
                for (int bj = 0; bj < 2; ++bj) ga[ai][m][bj] = gp[((ai * 4 + m) * 2 + bj) * 64];
#pragma unroll
        for (int ai = 0; ai < 2; ++ai)
#pragma unroll
            for (int m = 0; m < 4; ++m) {
                const int row = row0 + ai * 128 + m * 16;
#pragma unroll
                for (int bj = 0; bj < 2; ++bj) {
                    const u32x4 x = ga[ai][m][bj];
                    const float f[8] = {bflo(x.x), bfhi(x.x), bflo(x.y), bfhi(x.y), bflo(x.z), bfhi(x.z), bflo(x.w), bfhi(x.w)};
                    f32x4 a = acc[ai][bj][m][0], b = acc[ai][bj][m][1];
#pragma unroll
                    for (int e = 0; e < 4; ++e) { a[e] *= f[e]; b[e] *= f[4 + e]; }
                    acc[ai][bj][m][0] = a; acc[ai][bj][m][1] = b;
                    if (sub == 2) st8(O + (size_t)row * DM + col0 + bj * 128, a, b);
                }
            }
        return sub < 2;
    }
};
struct EpiRes {
    bf16_t* XB; float* xout; float* ss; bool dry;
    __device__ __forceinline__ bool operator()(Acc& acc, const Unit& u, int wr, int wc, int fr, int fq) const {
        const int row0 = u.pm * 256 + wr * 64 + fr, col0 = u.pn * 256 + wc * 32 + 8 * fq;
#pragma unroll
        for (int ai = 0; ai < 2; ++ai) {
            u32x4 xr[4][2];
#pragma unroll
            for (int m = 0; m < 4; ++m)
#pragma unroll
                for (int bj = 0; bj < 2; ++bj) xr[m][bj] = *(const u32x4*)(XB + (size_t)(row0 + ai * 128 + m * 16) * DM + col0 + bj * 128);
            asm volatile("" ::: "memory");
#pragma unroll
            for (int m = 0; m < 4; ++m) {
                const int row = row0 + ai * 128 + m * 16; float s = 0.f;
#pragma unroll
                for (int bj = 0; bj < 2; ++bj) {
                    const size_t off = (size_t)row * DM + col0 + bj * 128; const u32x4 x = xr[m][bj];
                    const f32x4 a = (f32x4){bflo(x.x), bfhi(x.x), bflo(x.y), bfhi(x.y)} + acc[ai][bj][m][0], b = (f32x4){bflo(x.z), bfhi(x.z), bflo(x.w), bfhi(x.w)} + acc[ai][bj][m][1];
                    if (xout) { if (!dry) { *(f32x4*)(xout + off) = a; *(f32x4*)(xout + off + 4) = b; } }
                    else if (!dry) { st8(XB + off, a, b); s += (a[0] * a[0] + a[1] * a[1]) + (a[2] * a[2] + a[3] * a[3]) + (b[0] * b[0] + b[1] * b[1]) + (b[2] * b[2] + b[3] * b[3]); }
                }
                if (!xout && !dry) { s += __shfl_xor(s, 16); s += __shfl_xor(s, 32); if (fq == 0) atomicAdd(ss + row, s); }
            }
            asm volatile("" ::: "memory");
        }
        return false;
    }
};
struct EpiFFN {
    bf16_t* H; const float* ss;
    __device__ __forceinline__ bool operator()(Acc& acc, const Unit& u, int wr, int wc, int fr, int fq) const {
        const int row0 = u.pm * 256 + wr * 64 + fr, col0 = u.pn * 128 + wc * 32 + 8 * fq;
        float rsv[2][4];
#pragma unroll
        for (int ai = 0; ai < 2; ++ai)
#pragma unroll
            for (int m = 0; m < 4; ++m) rsv[ai][m] = ss[row0 + ai * 128 + m * 16];
#pragma unroll
        for (int ai = 0; ai < 2; ++ai)
#pragma unroll
            for (int m = 0; m < 4; ++m) {
                const int row = row0 + ai * 128 + m * 16;
                const float rs = __builtin_amdgcn_rsqf(rsv[ai][m] * (1.0f / DM) + EPS);
                f32x4 h[2];
#pragma unroll
                for (int n = 0; n < 2; ++n)
#pragma unroll
                    for (int e = 0; e < 4; ++e) { const float gt = acc[ai][0][m][n][e] * rs, up = acc[ai][1][m][n][e] * rs; h[n][e] = siluf_(gt) * up; }
                st8(H + (size_t)row * DFF + col0, h[0], h[1]);
            }
        return false;
    }
};

typedef GAS unsigned gu32;
#define XB_TMO      128
#define XB_XCNT(j)  (256  + 64 * (j))
#define XB_XSUB(j)  (1280 + 64 * (j))
#define XB_XGEN(j)  (2304 + 64 * (j))
#define XB_TOP      3328
#define XB_TOPGEN   3392
#define XCD_BAR_WORDS 3456
#define XB_SPIN_CAP (1u << 22)
__device__ __forceinline__ unsigned xb_ld(unsigned* p)              { return __hip_atomic_load(p, __ATOMIC_RELAXED, __HIP_MEMORY_SCOPE_AGENT); }
__device__ __forceinline__ unsigned xb_add(unsigned* p, unsigned v) { return __hip_atomic_fetch_add(p, v, __ATOMIC_RELAXED, __HIP_MEMORY_SCOPE_AGENT); }
__device__ __forceinline__ unsigned xb_xcc_id() { return (unsigned)__builtin_amdgcn_s_getreg((3 << 11) | 20) & 0xFu; }
#define XB_SPIN(cond, bar) do { unsigned _sp = 0; while (cond) { __builtin_amdgcn_s_sleep(1); \
    if ((++_sp & 255u) == 0u) { if (xb_ld(&(bar)[XB_TMO])) break; if (_sp > XB_SPIN_CAP) { atomicAdd(&(bar)[XB_TMO], 1u); break; } } } } while (0)
struct XcdBarrier { unsigned* bar; unsigned x; volatile LAS unsigned* st; };
__device__ __forceinline__ XcdBarrier xcd_barrier_post(unsigned* bar, volatile LAS unsigned* st) {
    XcdBarrier b; b.bar = bar; b.x = xb_xcc_id(); b.st = st;
    if (threadIdx.x == 0) (void)xb_add(&bar[XB_XCNT(b.x)], 1u);
    return b;
}
__device__ __forceinline__ void xcd_barrier_complete(unsigned* bar, unsigned x, unsigned& nloc, unsigned& nx) {
    const unsigned G = gridDim.x * gridDim.y * gridDim.z;
    unsigned sum, cnt, mine, sp = 0u;
    for (;;) {
        sum = 0u; cnt = 0u; mine = 0u;
#pragma unroll
        for (unsigned j = 0; j < 16; ++j) { const unsigned c = xb_ld(&bar[XB_XCNT(j)]); sum += c; cnt += (c > 0u) ? 1u : 0u; mine = (j == x) ? c : mine; }
        if (sum == G) break;
        __builtin_amdgcn_s_sleep(1);
        if ((++sp & 255u) == 0u) { if (xb_ld(&bar[XB_TMO])) break; if (sp > XB_SPIN_CAP) { atomicAdd(&bar[XB_TMO], 1u); break; } }
    }
    nloc = mine > 0u ? mine : 1u; nx = cnt > 0u ? cnt : 1u;
}
__device__ __forceinline__ void xcd_barrier(const XcdBarrier& b) {
    asm volatile("s_waitcnt vmcnt(0)" ::: "memory");
    __syncthreads();
    if (threadIdx.x == 0) {
        unsigned* bar = b.bar;
        __builtin_amdgcn_s_waitcnt(0);
        unsigned nloc = b.st[0], nx = b.st[1];
        if (nloc == 0u) { xcd_barrier_complete(bar, b.x, nloc, nx); b.st[0] = nloc; b.st[1] = nx; }
        const unsigned old = xb_add(&bar[XB_XSUB(b.x)], 1u);
        const unsigned gen = old / nloc;
        if (old + 1u == (gen + 1u) * nloc) {
            __builtin_amdgcn_fence(__ATOMIC_RELEASE, "agent");
            asm volatile("s_waitcnt vmcnt(0)" ::: "memory");
            const unsigned og = xb_add(&bar[XB_TOP], 1u);
            const unsigned tg = og / nx;
            if (og + 1u == (tg + 1u) * nx) xb_add(&bar[XB_TOPGEN], 1u);
            else XB_SPIN(xb_ld(&bar[XB_TOPGEN]) == tg, bar);
            __builtin_amdgcn_fence(__ATOMIC_ACQUIRE, "agent");
            xb_add(&bar[XB_XGEN(b.x)], 1u);
            asm volatile("s_waitcnt vmcnt(0)" ::: "memory");
        } else {
            XB_SPIN(xb_ld(&bar[XB_XGEN(b.x)]) == gen, bar);
            __builtin_amdgcn_fence(__ATOMIC_ACQUIRE, "agent");
            asm volatile("s_waitcnt vmcnt(0)" ::: "memory");
        }
    }
    __syncthreads();
}

struct Args { const float* in[20]; float* out; unsigned char* ws; int ph_lo, ph_hi; };
struct Frame {
    LAS unsigned char* lds; unsigned char* ws; int tid, lane, wave, G, bid;
    float* out;
};
__device__ __forceinline__ const float* par(const Frame& F, int l, int off) { return (const float*)(F.ws + WS_PAR) + l * PAR_LAYER + off; }
enum { I_X = 0, I_MEM, I_RELB, I_NMIX, I_NFFN, I_NMEM, I_WIN, I_QNA, I_KNA, I_SINK, I_WDU, I_BDEC, I_GLAG, I_WMKV, I_QNM, I_KNM, I_WBR, I_WOUT, I_WFI, I_WFO };

__device__ __forceinline__ float wave_sum(float v) {
#pragma unroll
    for (int o = 1; o < 64; o <<= 1) v += __shfl_xor(v, o);
    return v;
}

#define T_BEGIN() const unsigned long long t_begin_ = (TSEC >= 0) ? __builtin_amdgcn_s_memrealtime() : 0ull
#define T_END(id) do { if (TSEC == (id) && F.bid == 0 && F.tid == 0) { unsigned* p_ = (unsigned*)(F.ws + WS_CTL) + 8192; *p_ += (unsigned)(__builtin_amdgcn_s_memrealtime() - t_begin_); } } while (0)
__device__ __forceinline__ int ina_src(int n0);
__device__ __forceinline__ int src32(int kind, int pn, int jb) {
    if (kind == 1) return ina_src(256 * pn + 32 * jb);
    if (kind == 2) return 2848 + 256 * pn + 32 * jb;
    if (kind == 3) return 2816 * (jb >> 2) + 128 * pn + 32 * (jb & 3);
    return 256 * pn + 32 * jb;
}
struct TrItem { const float* W; int ldw, kind, pn, k0; bf16_t* Bt; int ldb, kd0; const float* gain; };
__device__ __forceinline__ void tr_load(const Frame& F, const TrItem& I, f32x4 (&v)[8]) {
    const int lane = F.lane, w = F.wave;
    const int sc = src32(I.kind, I.pn, lane >> 3);
#pragma unroll
    for (int i = 0; i < 8; ++i) { const int k = w + 8 * i; v[i] = (f32x4){0.f, 0.f, 0.f, 0.f}; if (sc >= 0) v[i] = *(const f32x4*)(I.W + (size_t)(I.k0 + k) * I.ldw + sc + 4 * (lane & 7)); }
}
__device__ __forceinline__ void tr_process(Frame& F, const TrItem& I, const f32x4 (&v)[8]) {
    LAS float* Tl = (LAS float*)F.lds;
    const int lane = F.lane, w = F.wave, tid = F.tid;
#pragma unroll
    for (int i = 0; i < 8; ++i) { const int k = w + 8 * i; f32x4 x = v[i]; if (I.gain) x = x * I.gain[I.k0 + k]; *(LAS f32x4*)(Tl + k * 260 + 4 * lane) = x; }
    asm volatile("s_waitcnt lgkmcnt(0)\n\ts_barrier" ::: "memory");
    const int n = tid & 255, kh = tid >> 8;
#pragma unroll
    for (int c = 0; c < 4; ++c) { const int k8 = 32 * kh + 8 * c; const LAS float* sp = Tl + k8 * 260 + n;
        u32x4 o; o.x = cvtpk(sp[0], sp[260]); o.y = cvtpk(sp[2 * 260], sp[3 * 260]); o.z = cvtpk(sp[4 * 260], sp[5 * 260]); o.w = cvtpk(sp[6 * 260], sp[7 * 260]);
        *(u32x4*)(I.Bt + (size_t)(256 * I.pn + n) * I.ldb + I.kd0 + I.k0 + k8) = o; }
    asm volatile("s_waitcnt lgkmcnt(0)\n\ts_barrier" ::: "memory");
}
__device__ __forceinline__ int ina_src(int n0) {
    const int pn = n0 >> 8, c = n0 & 255, bj = c >> 7, wc = (c >> 5) & 3;
    const int x = 64 * (4 * pn + wc) + 32 * bj;
    if (x < 2304) return x;
    if (x < 2816) return x + 32;
    if (x < 2848) return 2304 + (x - 2816);
    return -1;
}
__device__ __forceinline__ void p0_prologue(Frame& F, const Args& A) {
    const int gw = F.bid * 8 + F.wave, NGW = F.G * 8;
    constexpr int I_A = 12 * 16, I_G = 12 * 16, I_M = 4 * 16, I_B = 3 * 4 * 8, I_O = 4 * 16, I_FI = 22 * 16, I_FO = 4 * 44;
    constexpr int I_LAYER = I_A + I_G + I_M + I_B + I_O + I_FI + I_FO;
    T_BEGIN();
    auto decode = [&](int it, TrItem& I) {
        const int l = it / I_LAYER; int r = it - l * I_LAYER;
        unsigned char* wl = F.ws + WS_W + (size_t)l * W_LAYER;
        if (r < I_A) { I = TrItem{A.in[I_WIN] + (size_t)l * DM * DIN, DIN, 1, r % 12, 64 * (r / 12), (bf16_t*)(wl + W_INA), DM, 0, A.in[I_NMIX] + l * DM}; return; } r -= I_A;
        if (r < I_G) { I = TrItem{A.in[I_WIN] + (size_t)l * DM * DIN, DIN, 2, r % 12, 64 * (r / 12), (bf16_t*)(wl + W_ING), DM, 0, A.in[I_NMIX] + l * DM}; return; } r -= I_G;
        if (r < I_M) { I = TrItem{A.in[I_WMKV] + (size_t)l * DM * 1024, 1024, 0, r & 3, 64 * (r >> 2), (bf16_t*)(wl + W_MKV), DM, 0, A.in[I_NMEM] + l * DM}; return; } r -= I_M;
        if (r < I_B) { const int j = r / 32, q = r % 32; I = TrItem{A.in[I_WBR] + ((size_t)l * 3 + j) * 512 * DM, DM, 0, q & 3, 64 * (q >> 2), (bf16_t*)(wl + W_BR), 1536, 512 * j, nullptr}; return; } r -= I_B;
        if (r < I_O) { I = TrItem{A.in[I_WOUT] + (size_t)l * DM * DM, DM, 0, r & 3, 64 * (r >> 2), (bf16_t*)(wl + W_OUT), DM, 0, nullptr}; return; } r -= I_O;
        if (r < I_FI) { I = TrItem{A.in[I_WFI] + (size_t)l * DM * 2 * DFF, 2 * DFF, 3, r % 22, 64 * (r / 22), (bf16_t*)(wl + W_FI), DM, 0, A.in[I_NFFN] + l * DM}; return; } r -= I_FI;
        I = TrItem{A.in[I_WFO] + (size_t)l * DFF * DM, DM, 0, r & 3, 64 * (r >> 2), (bf16_t*)(wl + W_FO), DFF, 0, nullptr};
    };
    if (F.bid < 2 * I_LAYER) {
        TrItem cur, nxt; f32x4 vc[8], vn[8];
        decode(F.bid, cur); tr_load(F, cur, vc);
#pragma unroll 1
        for (int it = F.bid; it < 2 * I_LAYER; it += F.G) {
            const int itn = it + F.G < 2 * I_LAYER ? it + F.G : it;
            decode(itn, nxt); tr_load(F, nxt, vn);
            tr_process(F, cur, vc);
            cur = nxt;
#pragma unroll
            for (int i = 0; i < 8; ++i) vc[i] = vn[i];
        }
    }
    T_END(5);
    const unsigned long long t_x0_ = (TSEC >= 0) ? __builtin_amdgcn_s_memrealtime() : 0ull;
    for (int m = gw; m < T + TMEM; m += 2 * NGW) {
        const int m2 = m + NGW; const bool has2 = m2 < T + TMEM;
        const bool ism = m >= T, ism2 = m2 >= T; const int r = ism ? m - T : m, r2 = ism2 ? m2 - T : m2;
        const f32x4* xr = (const f32x4*)((ism ? A.in[I_MEM] : A.in[I_X]) + (size_t)r * DM) + F.lane;
        const f32x4* xr2 = (const f32x4*)((ism2 ? A.in[I_MEM] : A.in[I_X]) + (size_t)r2 * DM) + F.lane;
        f32x4 v[4], v2[4];
#pragma unroll
        for (int j = 0; j < 4; ++j) v[j] = xr[64 * j];
        if (has2) {
#pragma unroll
            for (int j = 0; j < 4; ++j) v2[j] = xr2[64 * j];
        }
        {
            bf16_t* orow = (bf16_t*)(F.ws + (ism ? WS_MB : WS_XB)) + (size_t)r * DM; float s = 0.f;
#pragma unroll
            for (int j = 0; j < 4; ++j) { s += (v[j].x * v[j].x + v[j].y * v[j].y) + (v[j].z * v[j].z + v[j].w * v[j].w); u32x2 w; w.x = cvtpk(v[j].x, v[j].y); w.y = cvtpk(v[j].z, v[j].w); *(u32x2*)(orow + 256 * j + 4 * F.lane) = w; }
            s = wave_sum(s);
            if (F.lane == 0) ((float*)(F.ws + (ism ? WS_MSS : WS_SS)))[r] = s;
        }
        if (has2) {
            bf16_t* orow = (bf16_t*)(F.ws + (ism2 ? WS_MB : WS_XB)) + (size_t)r2 * DM; float s = 0.f;
#pragma unroll
            for (int j = 0; j < 4; ++j) { s += (v2[j].x * v2[j].x + v2[j].y * v2[j].y) + (v2[j].z * v2[j].z + v2[j].w * v2[j].w); u32x2 w; w.x = cvtpk(v2[j].x, v2[j].y); w.y = cvtpk(v2[j].z, v2[j].w); *(u32x2*)(orow + 256 * j + 4 * F.lane) = w; }
            s = wave_sum(s);
            if (F.lane == 0) ((float*)(F.ws + (ism2 ? WS_MSS : WS_SS)))[r2] = s;
        }
    }
    if (TSEC == 6 && F.bid == 0 && F.tid == 0) { unsigned* p_ = (unsigned*)(F.ws + WS_CTL) + 8192; *p_ += (unsigned)(__builtin_amdgcn_s_memrealtime() - t_x0_); }
    if (F.bid == 1) {
        for (int i = F.tid; i < 2 * PAR_LAYER; i += 512) {
            const int l = i / PAR_LAYER, o = i % PAR_LAYER; float v = 0.f;
            if (o < 64) v = A.in[I_QNA][l * 64 + o] * A.in[I_KNA][l * 64 + o] * (0.125f * LOG2E);
            else if (o < 72) v = A.in[I_SINK][l * 8 + (o - 64)] * LOG2E;
            else if (o < 128) v = 0.f;
            else if (o < 256) v = A.in[I_QNM][l * 128 + (o - 128)] * A.in[I_KNM][l * 128 + (o - 128)] * (0.08838834764831845f * LOG2E);
            else if (o < 384) v = A.in[I_GLAG][l * 128 + (o - 256)];
            else if (o < 896) v = A.in[I_BDEC][l * 512 + (o - 384)];
            else v = A.in[I_WDU][l * 8192 + (o - 896)];
            ((float*)(F.ws + WS_PAR))[i] = v;
        }
    }
    if (F.bid == 0) {
        for (int i = F.tid; i < 8 * 257; i += 512) {
            const int h = i / 257, rel = i % 257 - 128, n = rel < 0 ? -rel : rel;
            int bk = n < 8 ? n : (2 + (31 - __builtin_clz((unsigned)(n * n)))); if (bk > 15) bk = 15;
            if (rel > 0) bk += 16;
            ((float*)(F.ws + WS_BIAS))[i] = A.in[I_RELB][bk * 8 + h] * LOG2E;
        }
    }
}

struct WinQ { bf16x8 qf[4]; float m, l; f32x16 o0, o1; };
__device__ __forceinline__ float max3f_(float a, float b, float c) { return fmaxf(fmaxf(a, b), c); }
__device__ __forceinline__ void win_step(WinQ& q, const bf16x8 (&kf)[4], const bf16x8 (&vf)[2][2], const LAS float* bt, LAS float* wsf, int r32, int hi) {
    f32x16 s;
#pragma unroll
    for (int r = 0; r < 16; ++r) s[r] = bt[(r & 3) + 8 * (r >> 2)];
#pragma unroll
    for (int ds = 0; ds < 4; ++ds) s = MFMA32(kf[ds], q.qf[ds], s);
    float rm = max3f_(max3f_(s[0], s[1], s[2]), max3f_(s[3], s[4], s[5]), max3f_(s[6], s[7], s[8]));
    rm = max3f_(rm, max3f_(s[9], s[10], s[11]), max3f_(s[12], s[13], max3f_(s[14], s[15], -1e30f)));
    rm = swapmax(rm);
    if (__any(rm > q.m + 8.0f)) {
        const float mn = fmaxf(q.m, rm), alpha = ex2(q.m - mn); q.m = mn; q.l *= alpha;
        if (hi == 0) wsf[r32] = alpha;
        asm volatile("s_waitcnt lgkmcnt(0)" ::: "memory");
#pragma unroll
        for (int r = 0; r < 16; ++r) { const float a = wsf[crow(r, hi)]; q.o0[r] *= a; q.o1[r] *= a; }
    }
    float ps = 0.f;
#pragma unroll
    for (int r = 0; r < 16; ++r) { const float p = ex2(s[r] - q.m); s[r] = p; ps += p; }
    q.l += ps;
    const bf16x8 p0 = pack8(s, 0), p1 = pack8(s, 1);
    q.o0 = MFMA32(p0, vf[0][0], q.o0); q.o0 = MFMA32(p1, vf[0][1], q.o0);
    q.o1 = MFMA32(p0, vf[1][0], q.o1); q.o1 = MFMA32(p1, vf[1][1], q.o1);
}
struct WinKV { u32x4 k[6], v[6]; };
__device__ __forceinline__ void win_kv_addr(const Frame& F, int unit, int it, int tid, size_t& off) {
    const int b = unit >> 6, i = (unit >> 1) & 31, kvh = unit & 1; const int idx = tid + 512 * it, j = idx >> 3, ch = idx & 7;
    int kpos = 128 * i - 128 + j; kpos = min(max(kpos, 0), SEQ - 1); off = (size_t)(b * SEQ + kpos) * 128 + kvh * 64 + ch * 8;
}
__device__ __forceinline__ void win_k_load(const Frame& F, int unit, WinKV& P) {
#pragma unroll
    for (int it = 0; it < 6; ++it) { size_t off; win_kv_addr(F, unit, it, F.tid, off); P.k[it] = *(const u32x4*)((const bf16_t*)(F.ws + WS_KA) + off); }
}
__device__ __forceinline__ void win_v_load(const Frame& F, int unit, WinKV& P) {
#pragma unroll
    for (int it = 0; it < 6; ++it) { size_t off; win_kv_addr(F, unit, it, F.tid, off); P.v[it] = *(const u32x4*)((const bf16_t*)(F.ws + WS_VA) + off); }
}
__device__ __forceinline__ void winattn_unit(Frame& F, int l, int unit, bool dry, const WinKV& cur, bool has_next, int next_unit, WinKV& nxt) {
    const int b = unit >> 6, i = (unit >> 1) & 31, kvh = unit & 1;
    const int tid = opaque_v(F.tid), lane = tid & 63, r32 = lane & 31, hi = lane >> 5, w = F.wave;
    const bf16_t* KA = (const bf16_t*)(F.ws + WS_KA); const bf16_t* VA = (const bf16_t*)(F.ws + WS_VA); bf16_t* QA = (bf16_t*)(F.ws + WS_QA);
    LAS unsigned char* Kt = F.lds; LAS unsigned char* Vt = F.lds + 49152; LAS float* bias = (LAS float*)(F.lds + 98304);
    LAS float* wsf = (LAS float*)(F.lds + WSF_OFF) + w * 128;
    const int start = 128 * i;
    T_BEGIN();
    const int g = w >> 1, half = w & 1, h = kvh * 4 + g, qb0 = 2 * half;
    const float sink2 = par(F, l, PAR_SINK)[h];
    WinQ A, B;
    {
        const size_t qrow = (size_t)(b * SEQ + start + 32 * qb0 + r32);
#pragma unroll
        for (int ds = 0; ds < 4; ++ds) { A.qf[ds] = *(const bf16x8*)(QA + qrow * 512 + h * 64 + 16 * ds + 8 * hi); B.qf[ds] = *(const bf16x8*)(QA + (qrow + 32) * 512 + h * 64 + 16 * ds + 8 * hi); }
    }
    {
        for (int idx = tid; idx < 4 * 321; idx += 512) { const int g_ = idx / 321, rel = idx % 321 - 160;
            bias[idx] = (rel >= -128 && rel <= 128) ? ((const float*)(F.ws + WS_BIAS))[(kvh * 4 + g_) * 257 + rel + 128] : -1e30f; }
#pragma unroll
        for (int it = 0; it < 6; ++it) { const int idx = tid + 512 * it, j = idx >> 3, ch = idx & 7;
            *(LAS u32x4*)(Kt + j * 128 + ((ch ^ ((j >> 1) & 7)) << 4)) = cur.k[it];
            *(LAS u32x4*)(Vt + ((ch >> 2) * 24 + (j >> 4)) * 1024 + (j & 15) * 64 + (ch & 3) * 16) = cur.v[it]; }
    }
    asm volatile("s_waitcnt lgkmcnt(0)\n\ts_barrier" ::: "memory");
    T_END(3);
    const LAS float* bh = bias + g * 321;
    const int vlane = ((lane >> 4) & 1) * 32 + (lane & 3) * 8 + (4 * hi + ((lane & 15) >> 2)) * 64;
    A.m = sink2; B.m = sink2; A.l = (hi == 0) ? 1.0f : 0.0f; B.l = A.l; A.o0 = f32x16{}; A.o1 = f32x16{}; B.o0 = f32x16{}; B.o1 = f32x16{};
#pragma unroll 1
    for (int kt = qb0; kt <= qb0 + 9; ++kt) {
        const int kp0 = start - 128 + 32 * kt;
        if (kp0 + 31 < 0 || kp0 >= SEQ) continue;
        bf16x8 kf[4], vf[2][2];
#pragma unroll
        for (int ds = 0; ds < 4; ++ds) { const int kr = 32 * kt + r32, ch = 2 * ds + hi; kf[ds] = *(const LAS bf16x8*)(Kt + kr * 128 + ((ch ^ ((kr >> 1) & 7)) << 4)); }
#pragma unroll
        for (int d0 = 0; d0 < 2; ++d0) { const LAS char* vb = (const LAS char*)Vt + (d0 * 24 + 2 * kt) * 1024 + vlane;
            vf[d0][0] = mk8(vtr(vb), vtr(vb + 512)); vf[d0][1] = mk8(vtr(vb + 1024), vtr(vb + 1024 + 512)); }
        if (kt <= qb0 + 8) win_step(A, kf, vf, bh + (32 * (kt - qb0) + 32 - r32 + 4 * hi), wsf, r32, hi);
        if (kt >= qb0 + 1) win_step(B, kf, vf, bh + (32 * (kt - qb0 - 1) + 32 - r32 + 4 * hi), wsf + 32, r32, hi);
    }
    { const int nu = has_next ? next_unit : unit; win_k_load(F, nu, nxt); win_v_load(F, nu, nxt); }
    LAS bf16_t* stg = (LAS bf16_t*)(F.lds + 104448) + w * 2048;
#pragma unroll
    for (int qq = 0; qq < 2; ++qq) {
        WinQ& q = qq == 0 ? A : B;
        const float lt = swapsum(q.l);
        if (hi == 0) wsf[64 + r32] = __builtin_amdgcn_rcpf(lt);
        asm volatile("s_waitcnt lgkmcnt(0)" ::: "memory");
#pragma unroll
        for (int r = 0; r < 16; ++r) { const float rl = wsf[64 + crow(r, hi)]; const int orow = crow(r, hi);
            stg[orow * 64 + r32] = (bf16_t)(cvtpk(q.o0[r] * rl, 0.f) & 0xffffu); stg[orow * 64 + 32 + r32] = (bf16_t)(cvtpk(q.o1[r] * rl, 0.f) & 0xffffu); }
        asm volatile("s_waitcnt lgkmcnt(0)" ::: "memory");
        bf16_t* Ob = QA + (size_t)(b * SEQ + start + 32 * (qb0 + qq)) * 512 + h * 64;
#pragma unroll
        for (int k = 0; k < 4; ++k) { const int row = k * 8 + (lane >> 3), ch = lane & 7; const u32x4 v = *(const LAS u32x4*)(stg + row * 64 + ch * 8); if (!dry) *(u32x4*)(Ob + (size_t)row * 512 + ch * 8) = v; }
        asm volatile("s_waitcnt lgkmcnt(0)" ::: "memory");
    }
    asm volatile("s_waitcnt lgkmcnt(0)\n\ts_barrier" ::: "memory");
}

__device__ __forceinline__ void memattn_unit(Frame& F, int l, int unit, bool dry) {
    const int b = unit >> 5, h = (unit >> 3) & 3, rb = unit & 7;
    const int tid = opaque_v(F.tid), lane = tid & 63, r32 = lane & 31, hi = lane >> 5, w = F.wave;
    const bf16_t* KV = (const bf16_t*)(F.ws + WS_KVM) + (size_t)l * TMEM * 1024; bf16_t* QM = (bf16_t*)(F.ws + WS_QM);
    LAS unsigned char* Kt = F.lds; LAS unsigned char* Vt = F.lds + 65536;
    LAS float* wsf = (LAS float*)(F.lds + WSF_OFF) + w * 128;
    const float* gkm = par(F, l, PAR_GKM);
    T_BEGIN();
    bf16x8 qfr[2][8];
#pragma unroll
    for (int qq = 0; qq < 2; ++qq)
#pragma unroll
        for (int ds = 0; ds < 8; ++ds) qfr[qq][ds] = *(const bf16x8*)(QM + ((size_t)b * SEQ + rb * 512 + w * 64 + qq * 32 + r32) * 512 + h * 128 + 16 * ds + 8 * hi);
    {
        u32x4 kvr[8], vvr[8];
#pragma unroll
        for (int it = 0; it < 8; ++it) { const int idx = tid + 512 * it, j = idx >> 4, ch = idx & 15;
            const bf16_t* rp = KV + (size_t)(b * NMEM + j) * 1024 + h * 128 + ch * 8; kvr[it] = *(const u32x4*)rp; vvr[it] = *(const u32x4*)(rp + 512); }
#pragma unroll
        for (int it = 0; it < 8; ++it) { const int idx = tid + 512 * it, j = idx >> 4, ch = idx & 15;
            const u32x4 kv = kvr[it];
            float f[8] = {bflo(kv.x), bfhi(kv.x), bflo(kv.y), bfhi(kv.y), bflo(kv.z), bfhi(kv.z), bflo(kv.w), bfhi(kv.w)};
            float s = 0.f;
#pragma unroll
            for (int e = 0; e < 8; ++e) s += f[e] * f[e];
            s += __shfl_xor(s, 1); s += __shfl_xor(s, 2); s += __shfl_xor(s, 4); s += __shfl_xor(s, 8);
            const float rs = __builtin_amdgcn_rsqf(s * (1.0f / 128.0f) + EPS);
#pragma unroll
            for (int e = 0; e < 8; ++e) f[e] *= rs * gkm[ch * 8 + e];
            u32x4 ko; ko.x = cvtpk(f[0], f[1]); ko.y = cvtpk(f[2], f[3]); ko.z = cvtpk(f[4], f[5]); ko.w = cvtpk(f[6], f[7]);
            *(LAS u32x4*)(Kt + j * 256 + ((ch ^ (j & 15)) << 4)) = ko;
            *(LAS u32x4*)(Vt + ((ch >> 2) * 16 + (j >> 4)) * 1024 + (j & 15) * 64 + (ch & 3) * 16) = vvr[it]; }
    }
    asm volatile("s_waitcnt lgkmcnt(0)\n\ts_barrier" ::: "memory");
    T_END(10);
    const int vlane = ((lane >> 4) & 1) * 32 + (lane & 3) * 8 + (4 * hi + ((lane & 15) >> 2)) * 64;
    unsigned opk[2][4][8];
#pragma unroll
    for (int qq = 0; qq < 2; ++qq) {
        float qs = 0.f;
#pragma unroll
        for (int ds = 0; ds < 8; ++ds) { const u32x4 qv = __builtin_bit_cast(u32x4, qfr[qq][ds]);
            const float a0 = bflo(qv.x), a1 = bfhi(qv.x), a2 = bflo(qv.y), a3 = bfhi(qv.y), a4 = bflo(qv.z), a5 = bfhi(qv.z), a6 = bflo(qv.w), a7 = bfhi(qv.w);
            qs += (a0 * a0 + a1 * a1) + (a2 * a2 + a3 * a3) + (a4 * a4 + a5 * a5) + (a6 * a6 + a7 * a7); }
        qs = swapsum(qs);
        const float rq = __builtin_amdgcn_rsqf(qs * (1.0f / 128.0f) + EPS);
        bf16x8 qn[8];
#pragma unroll
        for (int ds = 0; ds < 8; ++ds) { const u32x4 qv = __builtin_bit_cast(u32x4, qfr[qq][ds]); u32x4 o4;
            o4.x = cvtpk(bflo(qv.x) * rq, bfhi(qv.x) * rq); o4.y = cvtpk(bflo(qv.y) * rq, bfhi(qv.y) * rq); o4.z = cvtpk(bflo(qv.z) * rq, bfhi(qv.z) * rq); o4.w = cvtpk(bflo(qv.w) * rq, bfhi(qv.w) * rq);
            qn[ds] = __builtin_bit_cast(bf16x8, o4); }
        float m = -1e30f, lsum = 0.f;
        f32x16 o[4]; o[0] = f32x16{}; o[1] = f32x16{}; o[2] = f32x16{}; o[3] = f32x16{};
#pragma unroll 1
        for (int kt = 0; kt < 8; ++kt) {
            f32x16 s = f32x16{};
#pragma unroll
            for (int ds = 0; ds < 8; ++ds) {
                const int kr = 32 * kt + r32, ch = 2 * ds + hi;
                const bf16x8 kf = *(const LAS bf16x8*)(Kt + kr * 256 + ((ch ^ (kr & 15)) << 4));
                s = MFMA32(kf, qn[ds], s);
            }
            float rm = max3f_(max3f_(s[0], s[1], s[2]), max3f_(s[3], s[4], s[5]), max3f_(s[6], s[7], s[8]));
            rm = max3f_(rm, max3f_(s[9], s[10], s[11]), max3f_(s[12], s[13], max3f_(s[14], s[15], -1e30f)));
            rm = swapmax(rm);
            if (__any(rm > m + 8.0f)) {
                const float mn = fmaxf(m, rm), alpha = ex2(m - mn); m = mn; lsum *= alpha;
                if (hi == 0) wsf[r32] = alpha;
                asm volatile("s_waitcnt lgkmcnt(0)" ::: "memory");
#pragma unroll
                for (int r = 0; r < 16; ++r) { const float a = wsf[crow(r, hi)]; o[0][r] *= a; o[1][r] *= a; o[2][r] *= a; o[3][r] *= a; }
            }
            float ps = 0.f;
#pragma unroll
            for (int r = 0; r < 16; ++r) { const float p = ex2(s[r] - m); s[r] = p; ps += p; }
            lsum += ps;
            const bf16x8 p0 = pack8(s, 0), p1 = pack8(s, 1);
#pragma unroll
            for (int d0 = 0; d0 < 4; ++d0) {
                const LAS char* vb = (const LAS char*)Vt + (d0 * 16 + 2 * kt) * 1024 + vlane;
                const bf16x8 v0 = mk8(vtr(vb), vtr(vb + 512)), v1 = mk8(vtr(vb + 1024), vtr(vb + 1024 + 512));
                o[d0] = MFMA32(p0, v0, o[d0]); o[d0] = MFMA32(p1, v1, o[d0]);
            }
        }
        lsum = swapsum(lsum);
        if (hi == 0) wsf[32 + r32] = __builtin_amdgcn_rcpf(lsum);
        asm volatile("s_waitcnt lgkmcnt(0)" ::: "memory");
#pragma unroll
        for (int i = 0; i < 8; ++i) { const float r0 = wsf[32 + crow(2 * i, hi)], r1 = wsf[32 + crow(2 * i + 1, hi)];
#pragma unroll
            for (int d0 = 0; d0 < 4; ++d0) opk[qq][d0][i] = cvtpk(o[d0][2 * i] * r0, o[d0][2 * i + 1] * r1); }
    }
    asm volatile("s_waitcnt lgkmcnt(0)\n\ts_barrier" ::: "memory");
    T_END(11);
    LAS bf16_t* stg = (LAS bf16_t*)(F.lds + w * 16384);
#pragma unroll
    for (int qq = 0; qq < 2; ++qq)
#pragma unroll
        for (int i = 0; i < 8; ++i)
#pragma unroll
            for (int d0 = 0; d0 < 4; ++d0) { const unsigned v = opk[qq][d0][i];
                stg[qq * 4096 + crow(2 * i, hi) * 128 + 32 * d0 + r32] = (bf16_t)(v & 0xffffu); stg[qq * 4096 + crow(2 * i + 1, hi) * 128 + 32 * d0 + r32] = (bf16_t)(v >> 16); }
    asm volatile("s_waitcnt lgkmcnt(0)" ::: "memory");
#pragma unroll
    for (int qq = 0; qq < 2; ++qq) {
        bf16_t* Ob = QM + ((size_t)b * SEQ + rb * 512 + w * 64 + qq * 32) * 512 + h * 128;
#pragma unroll
        for (int k = 0; k < 8; ++k) { const int c = k * 64 + lane, row = c >> 4, ch = c & 15; const u32x4 v = *(const LAS u32x4*)(stg + qq * 4096 + row * 128 + ch * 8); if (!dry) *(u32x4*)(Ob + (size_t)row * 512 + ch * 8) = v; }
    }
    asm volatile("s_waitcnt lgkmcnt(0)\n\ts_barrier" ::: "memory");
}

__device__ __forceinline__ void st_tile(unsigned* p, const f32x16& x, int lane) {
    u32x4 a, b; a.x = cvtpk(x[0], x[1]); a.y = cvtpk(x[2], x[3]); a.z = cvtpk(x[4], x[5]); a.w = cvtpk(x[6], x[7]);
    b.x = cvtpk(x[8], x[9]); b.y = cvtpk(x[10], x[11]); b.z = cvtpk(x[12], x[13]); b.w = cvtpk(x[14], x[15]);
    *(u32x4*)(p + lane * 4) = a; *(u32x4*)(p + 256 + lane * 4) = b;
}
__device__ __forceinline__ void st_nat(bf16_t* p, const f32x16& x, int r32, int hi) {
#pragma unroll
    for (int r = 0; r < 16; ++r) p[(size_t)crow(r, hi) * 512 + r32] = (bf16_t)(cvtpk(x[r], 0.f) & 0xffffu);
}
__device__ __forceinline__ void ld_tile_add(const unsigned* p, f32x16& x, int lane) {
#pragma unroll
    for (int i = 0; i < 8; ++i) { const unsigned w = p[i * 64 + lane]; x[2 * i] += bflo(w); x[2 * i + 1] += bfhi(w); }
}
__device__ __forceinline__ float dpp_f(float v, const int ctrl_sel) {
    const int iv = __builtin_bit_cast(int, v); int r;
    switch (ctrl_sel) { case 1: r = __builtin_amdgcn_update_dpp(0, iv, 0x111, 0xf, 0xf, true); break; case 2: r = __builtin_amdgcn_update_dpp(0, iv, 0x112, 0xf, 0xf, true); break;
                        case 4: r = __builtin_amdgcn_update_dpp(0, iv, 0x114, 0xf, 0xf, true); break; case 8: r = __builtin_amdgcn_update_dpp(0, iv, 0x118, 0xf, 0xf, true); break;
                        case 15: r = __builtin_amdgcn_update_dpp(0, iv, 0x142, 0xa, 0xf, false); break; default: r = __builtin_amdgcn_update_dpp(0, iv, 0x143, 0xc, 0xf, false); break; }
    return __builtin_bit_cast(float, r);
}
__device__ __forceinline__ float wave_prefix(float v, int lane) {
    (void)lane;
    v += dpp_f(v, 1); v += dpp_f(v, 2); v += dpp_f(v, 4); v += dpp_f(v, 8); v += dpp_f(v, 15); v += dpp_f(v, 31);
    return v;
}
struct IntraPre { u32x4 lr[4]; u32x4 q8, k8, v0, v1; };
__device__ __forceinline__ void gla_intra_load(const Frame& F, int unit, IntraPre& P) {
    const int b = unit >> 8, n = (unit >> 2) & 63, h = unit & 3, c = F.lane, w = F.wave;
    const size_t m0 = (size_t)b * SEQ + 64 * n;
    const u32x4* lp = (const u32x4*)((const bf16_t*)(F.ws + WS_LR) + (m0 + c) * 32);
#pragma unroll
    for (int q = 0; q < 4; ++q) P.lr[q] = lp[q];
    P.q8 = *(const u32x4*)((const bf16_t*)(F.ws + WS_QB) + (m0 + c) * 256 + h * 64 + 8 * w);
    P.k8 = *(const u32x4*)((const bf16_t*)(F.ws + WS_KB) + (m0 + c) * 256 + h * 64 + 8 * w);
    const bf16_t* VB = (const bf16_t*)(F.ws + WS_VB);
    { const int idx = F.tid, j = idx >> 4, ch = idx & 15; P.v0 = *(const u32x4*)(VB + (m0 + j) * 512 + h * 128 + ch * 8); }
    { const int idx = F.tid + 512, j = idx >> 4, ch = idx & 15; P.v1 = *(const u32x4*)(VB + (m0 + j) * 512 + h * 128 + ch * 8); }
}
__device__ __forceinline__ void gla_intra_unit(Frame& F, int l, int unit, const IntraPre& P) {
    const int b = unit >> 8, n = (unit >> 2) & 63, h = unit & 3;
    const int tid = F.tid, lane = F.lane, r32 = lane & 31, hi = lane >> 5, w = F.wave;
    const size_t m0 = (size_t)b * SEQ + 64 * n;
    bf16_t* QD = (bf16_t*)(F.ws + WS_QD);
    LAS unsigned char* L = F.lds;
    T_BEGIN();
    { const int idx = tid, j = idx >> 4, ch = idx & 15; *(LAS u32x4*)(L + 49152 + ((ch >> 2) * 4 + (j >> 4)) * 1024 + (j & 15) * 64 + (ch & 3) * 16) = P.v0; }
    { const int idx = tid + 512, j = idx >> 4, ch = idx & 15; *(LAS u32x4*)(L + 49152 + ((ch >> 2) * 4 + (j >> 4)) * 1024 + (j & 15) * 64 + (ch & 3) * 16) = P.v1; }
    {
        const int c = lane;
        float lrf[32];
#pragma unroll
        for (int q = 0; q < 4; ++q) { const u32x4 x = P.lr[q]; lrf[8 * q + 0] = bflo(x.x); lrf[8 * q + 1] = bfhi(x.x); lrf[8 * q + 2] = bflo(x.y); lrf[8 * q + 3] = bfhi(x.y); lrf[8 * q + 4] = bflo(x.z); lrf[8 * q + 5] = bfhi(x.z); lrf[8 * q + 6] = bflo(x.w); lrf[8 * q + 7] = bfhi(x.w); }
        const u32x4 q8 = P.q8, k8 = P.k8;
        const float qv[8] = {bflo(q8.x), bfhi(q8.x), bflo(q8.y), bfhi(q8.y), bflo(q8.z), bfhi(q8.z), bflo(q8.w), bfhi(q8.w)};
        const float kv[8] = {bflo(k8.x), bfhi(k8.x), bflo(k8.y), bfhi(k8.y), bflo(k8.z), bfhi(k8.z), bflo(k8.w), bfhi(k8.w)};
        const LAS float* WUl = (const LAS float*)(L + 65536) + 8 * w; const LAS float* BDl = (const LAS float*)(L + 73728) + 8 * w;
        float* DEC = (float*)(F.ws + WS_DEC) + (size_t)unit * 128;
#pragma unroll
        for (int dir = 0; dir < 2; ++dir) {
            float lg[8];
            { const f32x4 b0 = *(const LAS f32x4*)(BDl + dir * 64), b1 = *(const LAS f32x4*)(BDl + dir * 64 + 4);
              f32x2 l01 = {b0.x, b0.y}, l23 = {b0.z, b0.w}, l45 = {b1.x, b1.y}, l67 = {b1.z, b1.w};
#pragma unroll
              for (int r = 0; r < 16; ++r) {
                const f32x4 w0 = *(const LAS f32x4*)(WUl + (dir * 16 + r) * 64), w1 = *(const LAS f32x4*)(WUl + (dir * 16 + r) * 64 + 4);
                const float x = lrf[dir * 16 + r]; const f32x2 xx = {x, x};
                l01 = xx * (f32x2){w0.x, w0.y} + l01; l23 = xx * (f32x2){w0.z, w0.w} + l23; l45 = xx * (f32x2){w1.x, w1.y} + l45; l67 = xx * (f32x2){w1.z, w1.w} + l67;
              }
              lg[0] = l01.x; lg[1] = l01.y; lg[2] = l23.x; lg[3] = l23.y; lg[4] = l45.x; lg[5] = l45.y; lg[6] = l67.x; lg[7] = l67.y; }
            float qd[8], kd[8], ke[8], dc[8];
#pragma unroll
            for (int d = 0; d < 8; ++d) {
                const float tt = ex2(-fabsf(lg[d]) * LOG2E);
                const float la2 = (fminf(lg[d], 0.f) * LOG2E - __builtin_amdgcn_logf(1.0f + tt)) * (1.0f / 16.0f);
                const float pre = wave_prefix(la2, lane);
                const float tot = __builtin_bit_cast(float, __builtin_amdgcn_readlane(__builtin_bit_cast(int, pre), 63));
                const float bb = dir == 0 ? pre : (tot - pre + la2);
                const float e1 = ex2(bb), e2 = ex2(-bb), dct = ex2(tot);
                qd[d] = qv[d] * e1; kd[d] = kv[d] * e2; ke[d] = kd[d] * dct; dc[d] = dct;
            }
            if (lane == 0) { *(f32x4*)(DEC + dir * 64 + 8 * w) = (f32x4){dc[0], dc[1], dc[2], dc[3]}; *(f32x4*)(DEC + dir * 64 + 8 * w + 4) = (f32x4){dc[4], dc[5], dc[6], dc[7]}; }
            u32x4 a, bq, cq;
            a.x = cvtpk(qd[0], qd[1]); a.y = cvtpk(qd[2], qd[3]); a.z = cvtpk(qd[4], qd[5]); a.w = cvtpk(qd[6], qd[7]);
            bq.x = cvtpk(kd[0], kd[1]); bq.y = cvtpk(kd[2], kd[3]); bq.z = cvtpk(kd[4], kd[5]); bq.w = cvtpk(kd[6], kd[7]);
            cq.x = cvtpk(ke[0], ke[1]); cq.y = cvtpk(ke[2], ke[3]); cq.z = cvtpk(ke[4], ke[5]); cq.w = cvtpk(ke[6], ke[7]);
            { bf16_t* qp = QD + ((size_t)dir * T + m0 + c) * 256 + h * 64 + 16 * (w >> 1) + 4 * (w & 1);
              *(u32x2*)qp = (u32x2){a.x, a.y}; *(u32x2*)(qp + 8) = (u32x2){a.z, a.w}; }
            const int kso = c * 128 + ((w ^ ((c >> 1) & 7)) << 4);
            *(LAS u32x4*)(L + dir * 16384 + kso) = a;
            *(LAS u32x4*)(L + dir * 16384 + 8192 + kso) = bq;
            *(LAS u32x4*)(L + 32768 + dir * 8192 + ((w >> 2) * 4 + (c >> 4)) * 1024 + (c & 15) * 64 + (w & 3) * 16) = cq;
        }
    }
    asm volatile("s_waitcnt lgkmcnt(0)\n\ts_barrier" ::: "memory");
    T_END(12);
    const int vperm = ((lane >> 4) & 1) * 32 + (lane & 3) * 8 + (4 * hi + ((lane & 15) >> 2)) * 64;
    const int vnat = ((lane >> 4) & 1) * 32 + (lane & 3) * 8 + (8 * hi + ((lane & 15) >> 2)) * 64;
    {
        const int ct = w & 1, dvt = w >> 1;
        f32x16 o = f32x16{};
#pragma unroll
        for (int dir = 0; dir < 2; ++dir)
#pragma unroll
            for (int st = 0; st < 2; ++st) {
                if ((dir == 0 && st > ct) || (dir == 1 && st < ct)) continue;
                f32x16 x = f32x16{};
#pragma unroll
                for (int ds = 0; ds < 4; ++ds) {
                    const int sr = 32 * st + r32, cr = 32 * ct + r32, ch = 2 * ds + hi;
                    const bf16x8 kf = *(const LAS bf16x8*)(L + dir * 16384 + 8192 + sr * 128 + ((ch ^ ((sr >> 1) & 7)) << 4));
                    const bf16x8 qf = *(const LAS bf16x8*)(L + dir * 16384 + cr * 128 + ((ch ^ ((cr >> 1) & 7)) << 4));
                    x = MFMA32(kf, qf, x);
                }
                if (st == ct) {
#pragma unroll
                    for (int r = 0; r < 16; ++r) { const int s_ = crow(r, hi), c_ = r32; const bool keepv = dir == 0 ? (s_ <= c_) : (s_ > c_); if (!keepv) x[r] = 0.f; }
                }
                const bf16x8 p0 = pack8(x, 0), p1 = pack8(x, 1);
                const LAS char* vb = (const LAS char*)L + 49152 + (dvt * 4 + 2 * st) * 1024 + vperm;
                const bf16x8 v0 = mk8(vtr(vb), vtr(vb + 512)), v1 = mk8(vtr(vb + 1024), vtr(vb + 1024 + 512));
                o = MFMA32(p0, v0, o); o = MFMA32(p1, v1, o);
            }
        st_nat((bf16_t*)(F.ws + WS_OI) + (m0 + 32 * ct) * 512 + h * 128 + 32 * dvt, o, r32, hi);
    }
    {
        const int dkt = w & 1, dvt = w >> 1;
#pragma unroll
        for (int dir = 0; dir < 2; ++dir) {
            f32x16 u = f32x16{};
#pragma unroll
            for (int t = 0; t < 4; ++t) {
                const LAS char* ka = (const LAS char*)L + 32768 + dir * 8192 + (dkt * 4 + t) * 1024 + vnat;
                const LAS char* vb = (const LAS char*)L + 49152 + (dvt * 4 + t) * 1024 + vnat;
                const bf16x8 af = mk8(vtr(ka), vtr(ka + 256)), bfr = mk8(vtr(vb), vtr(vb + 256));
                u = MFMA32(af, bfr, u);
            }
            st_tile((unsigned*)(F.ws + WS_U) + (((size_t)unit * 2 + dir) * 8 + dkt * 4 + dvt) * 512, u, lane);
        }
    }
    asm volatile("s_waitcnt lgkmcnt(0)\n\ts_barrier" ::: "memory");
}
__device__ __forceinline__ void gla_intra_phase(Frame& F, int l) {
    int u = F.bid; if (u >= 2048) return;
    IntraPre cur, nxt; int hs = -1;
    gla_intra_load(F, u, cur);
#pragma unroll 1
    for (; u < 2048; u += F.G) {
        const int un = u + F.G; const bool hn = un < 2048;
        if (hn) gla_intra_load(F, un, nxt);
        const int h = u & 3;
        if (h != hs) {
            const float* wu = par(F, l, PAR_WDU); const float* bd = par(F, l, PAR_BDEC);
            for (int i = F.tid; i < 2048; i += 512) ((LAS float*)(F.lds + 65536))[i] = wu[(i >> 6) * 256 + h * 64 + (i & 63)];
            if (F.tid < 128) ((LAS float*)(F.lds + 73728))[F.tid] = bd[(F.tid >> 6) * 256 + h * 64 + (F.tid & 63)];
            hs = h;
            asm volatile("s_waitcnt lgkmcnt(0)\n\ts_barrier" ::: "memory");
        }
        { T_BEGIN(); gla_intra_unit(F, l, u, cur); T_END(2); }
        cur = nxt;
    }
}
constexpr int SC_NC = 2;
constexpr int SC_SLOT = 8192 + SC_NC * 4096, SC_NSLOT = 6, SC_DEPTH = 5, SC_DEC = SC_SLOT * SC_NSLOT, SC_STG = SC_DEC + 16384, SC_SPIN = 1 << 22, SC_NWG = 256 / SC_NC;
static_assert(SC_STG + SC_NC * 4096 <= MISC_OFF && 8 * (SC_DEPTH - 1) <= 63 && 4 * SC_NC * (SC_DEPTH - 1) <= 63, "scan LDS map / vmcnt range");
__device__ __forceinline__ unsigned lds_addr(const volatile LAS void* p) { return (unsigned)(size_t)p; }
__device__ __forceinline__ void lds_st_u32(unsigned addr, unsigned v) { asm volatile("ds_write_b32 %0, %1" : : "v"(addr), "v"(v) : "memory"); }
__device__ __forceinline__ unsigned lds_ld_u32(unsigned addr) { unsigned v; asm volatile("ds_read_b32 %0, %1\n\ts_waitcnt lgkmcnt(0)" : "=&v"(v) : "v"(addr) : "memory"); return v; }
__device__ __forceinline__ void glds16_asm(const void* gsrc, unsigned lds_dst) {
    unsigned keep;
    asm volatile("s_mov_b32 %0, m0\n\ts_mov_b32 m0, %2\n\ts_nop 0\n\tglobal_load_lds_dwordx4 %1, off\n\ts_mov_b32 m0, %0" : "=&s"(keep) : "v"(gsrc), "s"(lds_dst) : "memory");
}
__device__ __forceinline__ void wait_vm_dyn(int n) {
    switch (n) { case 32: asm volatile("s_waitcnt vmcnt(32)" ::: "memory"); break; case 24: asm volatile("s_waitcnt vmcnt(24)" ::: "memory"); break; case 16: asm volatile("s_waitcnt vmcnt(16)" ::: "memory"); break;
                 case 8: asm volatile("s_waitcnt vmcnt(8)" ::: "memory"); break; default: asm volatile("s_waitcnt vmcnt(0)" ::: "memory"); break; }
}
__device__ __forceinline__ void gla_scan_chain(Frame& F, int item) {
    const int chain = item / (4 / SC_NC), dv0 = (item % (4 / SC_NC)) * SC_NC;
    const int b = chain >> 3, h = (chain >> 1) & 3, dir = chain & 1;
    const int tid = F.tid, lane = F.lane, r32 = lane & 31, hi = lane >> 5, w = F.wave;
    volatile LAS unsigned* MISC = (volatile LAS unsigned*)(F.lds + MISC_OFF);
    const unsigned ldsb = lds_addr(F.lds);
    for (int i = tid; i < 4096; i += 512) { const int st = i >> 6, n = dir == 0 ? st : 63 - st;
        ((LAS float*)(F.lds + SC_DEC))[i] = ((const float*)(F.ws + WS_DEC))[(size_t)((b * 64 + n) * 4 + h) * 128 + dir * 64 + (i & 63)]; }
    if (tid < 8) MISC[16 + tid] = 0u;
    __syncthreads();
    if (w == 4 || w == 5) {
        const bool isq = (w == 4);
        const unsigned rdy = lds_addr(MISC + (isq ? 16 : 17)), dn = lds_addr(MISC + 18);
#pragma unroll 1
        for (int s = 0; s < 64 + SC_DEPTH - 1; ++s) {
            if (s < 64) {
                if (s >= SC_NSLOT) { int sp = 0;
                    for (;;) { int dmin = 1 << 30;
#pragma unroll
                        for (int k = 0; k < SC_NC; ++k) dmin = min(dmin, (int)__builtin_amdgcn_readfirstlane(lds_ld_u32(dn + 4 * k)));
                        if (dmin >= s - SC_NSLOT + 1 || ++sp >= SC_SPIN) break; __builtin_amdgcn_s_sleep(2); } }
                const int n = dir == 0 ? s : 63 - s;
                const size_t m0 = (size_t)b * SEQ + 64 * n;
                const unsigned slot = (unsigned)__builtin_amdgcn_readfirstlane(ldsb + (s % SC_NSLOT) * SC_SLOT);
                if (isq) {
                    const bf16_t* QD = (const bf16_t*)(F.ws + WS_QD) + ((size_t)dir * T + m0) * 256 + h * 64;
#pragma unroll
                    for (int p = 0; p < 8; ++p) { const int row = 8 * p + (lane >> 3), g = (lane & 7) ^ ((row >> 1) & 7);
                        glds16_asm(QD + (size_t)row * 256 + 8 * g, slot + p * 1024); }
                } else {
                    const unsigned* up = (const unsigned*)(F.ws + WS_U) + (((size_t)((b * 64 + n) * 4 + h) * 2 + dir) * 8 + dv0) * 512;
#pragma unroll
                    for (int p = 0; p < 4 * SC_NC; ++p) { const int k = p >> 2, q = p & 3; glds16_asm(up + (size_t)k * 512 + (q >> 1) * 2048 + (q & 1) * 256 + lane * 4, slot + 8192 + p * 1024); }
                }
            }
            const int pgrp = s - (SC_DEPTH - 1);
            if (pgrp >= 0) {
                const int younger = (s < 64 ? s : 63) - pgrp;
                wait_vm_dyn(younger * (isq ? 8 : 4 * SC_NC));
                if (lane == 0) lds_st_u32(rdy, (unsigned)(pgrp + 1));
            }
        }
    } else if (w < SC_NC) {
        const int dvt = dv0 + w;
        f32x16 S0 = f32x16{}, S1 = f32x16{};
        LAS bf16_t* stg = (LAS bf16_t*)(F.lds + SC_STG + w * 4096);
#pragma unroll 1
        for (int s = 0; s < 64; ++s) {
            { const unsigned long long tp0_ = (TSEC == 14) ? __builtin_amdgcn_s_memrealtime() : 0ull;
              int sp = 0; while (((int)MISC[16] <= s || (int)MISC[17] <= s) && ++sp < SC_SPIN) __builtin_amdgcn_s_sleep(1);
              if (TSEC == 14 && F.bid == 0 && tid == 0) { unsigned* p_ = (unsigned*)(F.ws + WS_CTL) + 8192; *p_ += (unsigned)(__builtin_amdgcn_s_memrealtime() - tp0_); } }
            asm volatile("" ::: "memory");
            const LAS unsigned char* slot = F.lds + (s % SC_NSLOT) * SC_SLOT;
            bf16x8 qa[2][4];
#pragma unroll
            for (int ct = 0; ct < 2; ++ct)
#pragma unroll
                for (int t = 0; t < 4; ++t) {
                    const int c = 32 * ct + r32, sw = (c >> 1) & 7;
                    qa[ct][t] = *(const LAS bf16x8*)(slot + c * 128 + (((2 * t + hi) ^ sw) << 4));
                }
            unsigned u0[8], u1[8];
            const LAS unsigned char* us = slot + 8192 + w * 4096;
            { const u32x4 a0 = *(const LAS u32x4*)(us + lane * 16), a1 = *(const LAS u32x4*)(us + 1024 + lane * 16), b0 = *(const LAS u32x4*)(us + 2048 + lane * 16), b1 = *(const LAS u32x4*)(us + 3072 + lane * 16);
              u0[0] = a0.x; u0[1] = a0.y; u0[2] = a0.z; u0[3] = a0.w; u0[4] = a1.x; u0[5] = a1.y; u0[6] = a1.z; u0[7] = a1.w;
              u1[0] = b0.x; u1[1] = b0.y; u1[2] = b0.z; u1[3] = b0.w; u1[4] = b1.x; u1[5] = b1.y; u1[6] = b1.z; u1[7] = b1.w; }
            const LAS float* dp = (const LAS float*)(F.lds + SC_DEC) + s * 64;
            f32x4 d0[4], d1[4];
#pragma unroll
            for (int q = 0; q < 4; ++q) { d0[q] = *(const LAS f32x4*)(dp + 8 * q + 4 * hi); d1[q] = *(const LAS f32x4*)(dp + 32 + 8 * q + 4 * hi); }
            const bf16x8 sb0 = pack8(S0, 0), sb1 = pack8(S0, 1), sb2 = pack8(S1, 0), sb3 = pack8(S1, 1);
            f32x16 oi[2];
#pragma unroll
            for (int ct = 0; ct < 2; ++ct) { f32x16 a = f32x16{}; a = MFMA32(qa[ct][0], sb0, a); a = MFMA32(qa[ct][1], sb1, a); a = MFMA32(qa[ct][2], sb2, a); a = MFMA32(qa[ct][3], sb3, a); oi[ct] = a; }
#pragma unroll
            for (int i = 0; i < 8; ++i) {
                S0[2 * i] = S0[2 * i] * d0[(2 * i) >> 2][(2 * i) & 3] + bflo(u0[i]); S0[2 * i + 1] = S0[2 * i + 1] * d0[(2 * i + 1) >> 2][(2 * i + 1) & 3] + bfhi(u0[i]);
                S1[2 * i] = S1[2 * i] * d1[(2 * i) >> 2][(2 * i) & 3] + bflo(u1[i]); S1[2 * i + 1] = S1[2 * i + 1] * d1[(2 * i + 1) >> 2][(2 * i + 1) & 3] + bfhi(u1[i]);
            }
            asm volatile("s_waitcnt lgkmcnt(0)" ::: "memory");
            if (lane == 0) MISC[18 + w] = (unsigned)(s + 1);
            const int n = dir == 0 ? s : 63 - s;
            bf16_t* op = (bf16_t*)(F.ws + WS_OT) + ((size_t)dir * T + (size_t)b * SEQ + 64 * n) * 512 + h * 128 + 32 * dvt;
#pragma unroll
            for (int ct = 0; ct < 2; ++ct)
#pragma unroll
                for (int r = 0; r < 16; ++r) stg[(32 * ct + crow(r, hi)) * 32 + r32] = (bf16_t)(cvtpk(oi[ct][r], 0.f) & 0xffffu);
            asm volatile("s_waitcnt lgkmcnt(0)" ::: "memory");
#pragma unroll
            for (int k = 0; k < 4; ++k) { const int cc = k * 64 + lane, row = cc >> 2, ch = cc & 3; const u32x4 v = *(const LAS u32x4*)(stg + row * 32 + ch * 8); *(u32x4*)(op + (size_t)row * 512 + ch * 8) = v; }
            asm volatile("s_waitcnt lgkmcnt(0)" ::: "memory");
        }
    }
    __syncthreads();
}
__device__ __forceinline__ void gla_final_stream(Frame& F, int l) {
    const u32x4* OI = (const u32x4*)(F.ws + WS_OI); const u32x4* OF = (const u32x4*)(F.ws + WS_OT); const u32x4* OBk = OF + (size_t)T * 512 / 8;
    const u32x4* OG = (const u32x4*)(F.ws + WS_OG); u32x4* OUT = (u32x4*)(F.ws + WS_OB);
    const float* gn = par(F, l, PAR_GLAG) + (F.tid & 15) * 8;
    const f32x4 g0 = *(const f32x4*)gn, g1 = *(const f32x4*)(gn + 4);
    const float gg[8] = {g0.x, g0.y, g0.z, g0.w, g1.x, g1.y, g1.z, g1.w};
    const int n16 = T * 512 / 8, stride = F.G * 512;
#pragma unroll 2
    for (int idx = F.bid * 512 + F.tid; idx < n16; idx += stride) {
        const u32x4 a = OI[idx], b = OF[idx], c = OBk[idx], g = OG[idx];
        float v[8] = {bflo(a.x) + bflo(b.x) + bflo(c.x), bfhi(a.x) + bfhi(b.x) + bfhi(c.x), bflo(a.y) + bflo(b.y) + bflo(c.y), bfhi(a.y) + bfhi(b.y) + bfhi(c.y),
                      bflo(a.z) + bflo(b.z) + bflo(c.z), bfhi(a.z) + bfhi(b.z) + bfhi(c.z), bflo(a.w) + bflo(b.w) + bflo(c.w), bfhi(a.w) + bfhi(b.w) + bfhi(c.w)};
        const float og[8] = {bflo(g.x), bfhi(g.x), bflo(g.y), bfhi(g.y), bflo(g.z), bfhi(g.z), bflo(g.w), bfhi(g.w)};
        float s = 0.f;
#pragma unroll
        for (int e = 0; e < 8; ++e) s += v[e] * v[e];
        s += __shfl_xor(s, 1); s += __shfl_xor(s, 2); s += __shfl_xor(s, 4); s += __shfl_xor(s, 8);
        const float rs = __builtin_amdgcn_rsqf(s * (1.0f / 128.0f) + EPS);
#pragma unroll
        for (int e = 0; e < 8; ++e) v[e] = v[e] * rs * gg[e] * og[e];
        u32x4 o; o.x = cvtpk(v[0], v[1]); o.y = cvtpk(v[2], v[3]); o.z = cvtpk(v[4], v[5]); o.w = cvtpk(v[6], v[7]);
        st16_wt(OUT + idx, o);
    }
}

__global__ void __launch_bounds__(512, 2) fwd_kernel(Args args) {
    extern __shared__ __attribute__((aligned(16))) unsigned char lds_raw[];
    Frame F;
    F.lds = (LAS unsigned char*)lds_raw; F.ws = args.ws; F.tid = threadIdx.x; F.lane = F.tid & 63; F.wave = __builtin_amdgcn_readfirstlane(F.tid >> 6);
    F.G = gridDim.x; F.bid = blockIdx.x; F.out = args.out;
    volatile LAS unsigned* MISC = (volatile LAS unsigned*)(F.lds + MISC_OFF);
    if (F.tid < 32) MISC[F.tid] = 0u;
    __syncthreads();
    const int lo = args.ph_lo, hi_ = args.ph_hi;
    XcdBarrier bar; bar.bar = (unsigned*)(F.ws + WS_CTL) + CW_BAR; bar.x = 0; bar.st = nullptr;
    if (hi_ - lo > 1) bar = xcd_barrier_post((unsigned*)(F.ws + WS_CTL) + CW_BAR, MISC + 8);
#ifndef PH_MASK
#define PH_MASK 0x1ff
#endif
#define IN(k) (lo <= (k) && (k) < hi_)
#define PM(j) ((PH_MASK >> (j)) & 1)
#define FRESH() do { F.tid = opaque_v(threadIdx.x); F.lane = F.tid & 63; F.wave = __builtin_amdgcn_readfirstlane(F.tid >> 6); } while (0)
#define SEAM(k) do { if (IN(k) && IN((k) + 1)) { const unsigned long long tb0_ = (TSEC == 30 || TSEC == 31) ? __builtin_amdgcn_s_memrealtime() : 0ull; xcd_barrier(bar); if ((TSEC == 30 && F.bid == 0 || TSEC == 31 && F.bid == 128) && threadIdx.x == 0) { unsigned* p_ = (unsigned*)(F.ws + WS_CTL) + 8192; __hip_atomic_fetch_add(p_, (unsigned)(__builtin_amdgcn_s_memrealtime() - tb0_), __ATOMIC_RELAXED, __HIP_MEMORY_SCOPE_AGENT); } } if (TSEC >= 20 && TSEC == 20 + ((k) == 0 ? 0 : (((k) - 1) & 7) + 1) && F.bid == 0 && threadIdx.x == 0) { unsigned* p_ = (unsigned*)(F.ws + WS_CTL) + 8192; *p_ += (unsigned)(__builtin_amdgcn_s_memrealtime() - tph0_); } } while (0)
    float* SSb = (float*)(F.ws + WS_SS);
    unsigned long long tph0_ = 0ull; (void)tph0_;
    unsigned* const TP = (unsigned*)(F.ws + WS_CTL) + 8192; (void)TP;

#define REPS(j) (((j) == PROBE_PHASE && hi_ - lo > 1) ? 1 + PROBE_REPS : 1)
#define PHASE_BEGIN(j) tph0_ = (TSEC == 20 + (j)) ? __builtin_amdgcn_s_memrealtime() : tph0_; for (int rep = 0; rep < REPS(j); ++rep) { const bool dry = rep + 1 < REPS(j); (void)dry; FRESH();
#define PHASE_END() if (dry) xcd_barrier(bar); }
    if (PM(0) && IN(0)) { PHASE_BEGIN(0) p0_prologue(F, args); PHASE_END() }
    SEAM(0);
#pragma unroll 1
    for (int l = 0; l < 2; ++l) {
        const int pb = 1 + 8 * l;
        unsigned char* wl = F.ws + WS_W + (size_t)l * W_LAYER;
        if (PM(1) && IN(pb + 0)) { PHASE_BEGIN(1)
            {
                pg8::Gemm g{(const bf16_t*)(F.ws + WS_XB), (const bf16_t*)(wl + W_INA), DM, DM, DM, TPH == 1 ? TP : nullptr};
                pg8::Sched S; S.init(T, 3072, 1, F.G, F.bid, 256 * DM * 2, 0, 256 * DM * 2, 0);
                EpiQKV E{F.ws, SSb + (size_t)(2 * l) * T, par(F, l, PAR_GKA)};
                pg8::gemm_phase<EpiQKV, true, true>(F.lds, g, S, E);
            }
            if (l == 0) {
                pg8::Gemm g{(const bf16_t*)(F.ws + WS_MB), (const bf16_t*)(F.ws + WS_W + W_MKV), DM, DM, DM, nullptr};
                pg8::Sched S; S.init(TMEM, 1024, 2, F.G, F.bid, 256 * DM * 2, 0, 256 * DM * 2, (unsigned)W_LAYER); S.subFast = false;
                EpiRowScale<0> E{(bf16_t*)(F.ws + WS_KVM), 1024, (size_t)TMEM * 1024, (const float*)(F.ws + WS_MSS)};
                pg8::gemm_phase<EpiRowScale<0>, true, true>(F.lds, g, S, E);
            }
        PHASE_END() }
        SEAM(pb + 0);
        if (PM(2) && IN(pb + 1)) { PHASE_BEGIN(2) gla_intra_phase(F, l);
            for (int u = F.bid; u < 256; u += F.G) { T_BEGIN(); memattn_unit(F, l, u, dry); T_END(1); }
        PHASE_END() }
        SEAM(pb + 1);
        if (PM(3) && IN(pb + 2)) { PHASE_BEGIN(3)
            if (F.G > SC_NWG + 8) {
                if (F.bid < SC_NWG) { T_BEGIN(); gla_scan_chain(F, F.bid); T_END(4); }
                else { const int nb = F.G - SC_NWG; int u = F.bid - SC_NWG;
                    if (u < 512) { WinKV cur, nxt; win_k_load(F, u, cur); win_v_load(F, u, cur);
#pragma unroll 1
                        for (; u < 512; u += nb) { const bool hn = u + nb < 512; winattn_unit(F, l, u, dry, cur, hn, u + nb, nxt); cur = nxt; } } }
            } else {
                for (int c = F.bid; c < SC_NWG; c += F.G) gla_scan_chain(F, c);
                for (int u = F.bid; u < 512; u += F.G) { WinKV cur, nxt; win_k_load(F, u, cur); win_v_load(F, u, cur); winattn_unit(F, l, u, dry, cur, false, u, nxt); }
            }
        PHASE_END() }
        SEAM(pb + 2);
        if (PM(4) && IN(pb + 3)) { PHASE_BEGIN(4)
            { T_BEGIN(); gla_final_stream(F, l); T_END(7); }
            asm volatile("s_waitcnt vmcnt(0)" ::: "memory"); __syncthreads();
            if (F.tid == 0) __hip_atomic_fetch_add((unsigned*)(F.ws + WS_CTL) + 8256 + 64 * l, 1u, __ATOMIC_RELAXED, __HIP_MEMORY_SCOPE_AGENT);
            pg8::Gemm g{(const bf16_t*)(F.ws + WS_XB), (const bf16_t*)(wl + W_ING), DM, DM, DM, TPH == 4 ? TP : nullptr};
            pg8::Sched S; S.init(T, 1024, 3, F.G, F.bid, 256 * DM * 2, 0, 256 * DM * 2, 1024 * DM * 2);
            EpiGate E{(u32x4*)(F.ws + WS_G), SSb + (size_t)(2 * l) * T, (unsigned*)(F.ws + WS_CTL) + 8256 + 64 * l, (hi_ - lo > 1) ? (unsigned)F.G : 0u, false};
            pg8::gemm_phase<EpiGate, true, true>(F.lds, g, S, E);
        PHASE_END() }
        SEAM(pb + 3);
        if (PM(5) && IN(pb + 4)) { PHASE_BEGIN(5)
            pg8::Gemm g{(const bf16_t*)(F.ws + WS_QA), (const bf16_t*)(wl + W_BR), 512, 1536, 512, TPH == 5 ? TP : nullptr};
            pg8::Sched S; S.init(T, 1024, 3, F.G, F.bid, 256 * 512 * 2, 32 * MiB, 256 * 1536 * 2, 512 * 2);
            EpiMerge E{(const u32x4*)(F.ws + WS_G), (bf16_t*)(F.ws + WS_MG)};
            pg8::gemm_phase<EpiMerge, true, true>(F.lds, g, S, E);
        PHASE_END() }
        SEAM(pb + 4);
        if (PM(6) && IN(pb + 5)) { PHASE_BEGIN(6)
            pg8::Gemm g{(const bf16_t*)(F.ws + WS_MG), (const bf16_t*)(wl + W_OUT), DM, DM, DM, TPH == 6 ? TP : nullptr};
            pg8::Sched S; S.init(T, 1024, 1, F.G, F.bid, 256 * DM * 2, 0, 256 * DM * 2, 0);
            EpiRes E{(bf16_t*)(F.ws + WS_XB), nullptr, SSb + (size_t)(2 * l + 1) * T, dry};
            pg8::gemm_phase<EpiRes, true, true>(F.lds, g, S, E);
        PHASE_END() }
        SEAM(pb + 5);
        if (PM(7) && IN(pb + 6)) { PHASE_BEGIN(7)
            pg8::Gemm g{(const bf16_t*)(F.ws + WS_XB), (const bf16_t*)(wl + W_FI), DM, DM, DM, TPH == 7 ? TP : nullptr};
            pg8::Sched S; S.init(T, 2 * DFF, 1, F.G, F.bid, 256 * DM * 2, 0, 256 * DM * 2, 0);
            EpiFFN E{(bf16_t*)(F.ws + WS_H), SSb + (size_t)(2 * l + 1) * T};
            pg8::gemm_phase<EpiFFN, true, true>(F.lds, g, S, E);
        PHASE_END() }
        SEAM(pb + 6);
        if (PM(8) && IN(pb + 7)) { PHASE_BEGIN(8)
            pg8::Gemm g{(const bf16_t*)(F.ws + WS_H), (const bf16_t*)(wl + W_FO), DFF, DFF, DFF, TPH == 8 ? TP : nullptr};
            pg8::Sched S; S.init(T, 1024, 1, F.G, F.bid, 256 * DFF * 2, 0, 256 * DFF * 2, 0);
            EpiRes E{(bf16_t*)(F.ws + WS_XB), l == 0 ? nullptr : F.out, SSb + (size_t)(2 * l + 2) * T, dry};
            pg8::gemm_phase<EpiRes, true, true>(F.lds, g, S, E);
        PHASE_END() }
        SEAM(pb + 7);
    }
    if (TSEC >= 0 && hi_ == NPH && F.bid == 0 && threadIdx.x == 0) {
        asm volatile("s_waitcnt vmcnt(0)" ::: "memory");
        const unsigned long long ticks = (unsigned long long)__hip_atomic_load((unsigned*)(F.ws + WS_CTL) + 8192, __ATOMIC_RELAXED, __HIP_MEMORY_SCOPE_AGENT) * TGAIN;
        const unsigned long long t0 = __builtin_amdgcn_s_memrealtime();
        while (__builtin_amdgcn_s_memrealtime() - t0 < ticks) __builtin_amdgcn_s_sleep(8);
    }
#undef IN
#undef SEAM
}

extern "C" void kernel_launch(void* const* d_in, const int* in_sizes, int n_in, void* d_out, int out_size, void* d_ws, size_t ws_size, hipStream_t stream) {
    static int grid = 0;
    if (grid == 0) {
        if (n_in != 20 || ws_size < WS_END) { fprintf(stderr, "kernel_launch: unexpected n_in %d / ws %zu\n", n_in, ws_size); grid = -1; return; }
        int dev = 0, cus = 0, per_cu = 0;
        if (hipGetDevice(&dev) != hipSuccess || hipDeviceGetAttribute(&cus, hipDeviceAttributeMultiprocessorCount, dev) != hipSuccess) { grid = -1; return; }
        if (hipFuncSetAttribute((const void*)fwd_kernel, hipFuncAttributeMaxDynamicSharedMemorySize, LDS_BYTES) != hipSuccess) { fprintf(stderr, "kernel_launch: hipFuncSetAttribute failed\n"); grid = -1; return; }
        if (hipOccupancyMaxActiveBlocksPerMultiprocessor(&per_cu, (const void*)fwd_kernel, 512, LDS_BYTES) != hipSuccess || per_cu < 1) { fprintf(stderr, "kernel_launch: occupancy query says %d blocks/CU\n", per_cu); per_cu = 1; }
        (void)hipGetLastError();
        grid = cus;
    }
    if (grid < 0) return;
    (void)hipMemsetAsync((char*)d_ws + WS_CTL, 0, 1 * MiB, stream);
    Args a{};
    for (int i = 0; i < 20; ++i) a.in[i] = (const float*)d_in[i];
    a.out = (float*)d_out; a.ws = (unsigned char*)d_ws;
#if MK_N_LAUNCHES == 1
    a.ph_lo = 0; a.ph_hi = NPH;
    hipLaunchKernelGGL(fwd_kernel, dim3(grid), dim3(512), LDS_BYTES, stream, a);
#else
    for (int p = 0; p < NPH; ++p) { a.ph_lo = p; a.ph_hi = p + 1; hipLaunchKernelGGL(fwd_kernel, dim3(grid), dim3(512), LDS_BYTES, stream, a); }
#endif
}
```

```cpp
#include <hip/hip_runtime.h>
#include <cstdio>
#include <cstdint>

#ifndef MK_N_LAUNCHES
#define MK_N_LAUNCHES 1
#endif

#ifndef PROBE_PHASE
#define PROBE_PHASE -1
#define PROBE_REPS 0
#endif
#ifndef TSEC
#define TSEC -1
#define TGAIN 4
#endif
#ifndef TPH
#define TPH -1
#endif
#define LAS __attribute__((address_space(3)))
#define GAS __attribute__((address_space(1)))
typedef unsigned short bf16_t;
typedef short bf16x8 __attribute__((ext_vector_type(8)));
typedef short s16x4 __attribute__((ext_vector_type(4)));
typedef short v4i16_t __attribute__((ext_vector_type(4)));
typedef float f32x2 __attribute__((ext_vector_type(2)));
typedef float f32x4 __attribute__((ext_vector_type(4)));
typedef float f32x16 __attribute__((ext_vector_type(16)));
typedef unsigned u32x2 __attribute__((ext_vector_type(2)));
typedef unsigned u32x4 __attribute__((ext_vector_type(4)));
typedef __bf16 bf16x2_t __attribute__((ext_vector_type(2)));

constexpr int DM = 1024, BATCH = 8, SEQ = 4096, T = BATCH * SEQ, NMEM = 256, TMEM = BATCH * NMEM;
constexpr int DFF = 2816, DIN = 5920;
constexpr float EPS = 1e-6f, LOG2E = 1.4426950408889634f;
constexpr int NPH = 17;

constexpr size_t MiB = 1u << 20;
constexpr size_t WS_CTL = 0;
constexpr size_t WS_SS = 512 * 1024;
constexpr size_t WS_MSS = 1 * MiB;
constexpr size_t WS_BIAS = 1 * MiB + 64 * 1024;
constexpr size_t WS_PAR = 1 * MiB + 128 * 1024;
constexpr int PAR_GKA = 0, PAR_SINK = 64, PAR_GKM = 128, PAR_GLAG = 256, PAR_BDEC = 384, PAR_WDU = 896, PAR_LAYER = 896 + 8192;
constexpr size_t WS_DEC = 2 * MiB;
constexpr size_t WS_KVM = 3 * MiB;
constexpr size_t WS_MB = 11 * MiB;
constexpr size_t WS_W = 16 * MiB;
constexpr size_t W_INA = 0, W_ING = 6 * MiB, W_MKV = 12 * MiB, W_BR = 14 * MiB, W_OUT = 17 * MiB, W_FI = 19 * MiB, W_FO = 30 * MiB, W_LAYER = 35 * MiB + 512 * 1024;
constexpr size_t WS_XB = 88 * MiB;
constexpr size_t WS_QA = 152 * MiB;
constexpr size_t WS_OB = 184 * MiB;
constexpr size_t WS_QM = 216 * MiB;
constexpr size_t WS_KA = 248 * MiB, WS_VA = 256 * MiB;
constexpr size_t WS_QB = 264 * MiB, WS_KB = 280 * MiB;
constexpr size_t WS_VB = 296 * MiB, WS_OG = 328 * MiB;
constexpr size_t WS_LR = 360 * MiB;
constexpr size_t WS_QD = 362 * MiB;
constexpr size_t WS_U = 394 * MiB;
constexpr size_t WS_OI = 458 * MiB;
constexpr size_t WS_OT = 264 * MiB;
constexpr size_t WS_G = 248 * MiB;
constexpr size_t WS_MG = 440 * MiB;
constexpr size_t WS_H = 248 * MiB;
constexpr size_t WS_END = 512 * MiB;
static_assert(WS_OI + 32 * MiB <= WS_END && WS_MG + 64 * MiB <= WS_END && WS_W + 2 * W_LAYER <= WS_XB && WS_G + 192 * MiB <= WS_MG && WS_H + 176 * MiB <= WS_END, "ws map");

constexpr int CW_BAR = 4096;

constexpr int RING_BYTES = 131072;
constexpr int MISC_OFF = 155648;
constexpr int WSF_OFF = 156672;
constexpr int LDS_BYTES = 163840;

__device__ __forceinline__ unsigned cvtpk(float lo, float hi) { f32x2 v = {lo, hi}; bf16x2_t b = __builtin_convertvector(v, bf16x2_t); return __builtin_bit_cast(unsigned, b); }
__device__ __forceinline__ float bflo(unsigned w) { return __uint_as_float(w << 16); }
__device__ __forceinline__ float bfhi(unsigned w) { return __uint_as_float(w & 0xffff0000u); }
__device__ __forceinline__ float ex2(float x) { return __builtin_amdgcn_exp2f(x); }
__device__ __forceinline__ float sigmoidf_(float x) { return __builtin_amdgcn_rcpf(1.0f + ex2(-x * LOG2E)); }
__device__ __forceinline__ float siluf_(float x) { return x * sigmoidf_(x); }
__device__ __forceinline__ int crow(int r, int hi) { return (r & 3) + 8 * (r >> 2) + 4 * hi; }
__device__ __forceinline__ float swapmax(float v) { auto rr = __builtin_amdgcn_permlane32_swap(__float_as_uint(v), __float_as_uint(v), false, false); return fmaxf(__uint_as_float(rr[0]), __uint_as_float(rr[1])); }
__device__ __forceinline__ float swapsum(float v) { auto rr = __builtin_amdgcn_permlane32_swap(__float_as_uint(v), __float_as_uint(v), false, false); return __uint_as_float(rr[0]) + __uint_as_float(rr[1]); }
__device__ __forceinline__ s16x4 vtr(const LAS char* p) { return __builtin_bit_cast(s16x4, __builtin_amdgcn_ds_read_tr16_b64_v4i16((LAS v4i16_t*)p)); }
#define MFMA32(a, b, c) __builtin_amdgcn_mfma_f32_32x32x16_bf16((a), (b), (c), 0, 0, 0)
__device__ __forceinline__ bf16x8 pack8(const f32x16& x, int s) {
    u32x4 p; p.x = cvtpk(x[8 * s], x[8 * s + 1]); p.y = cvtpk(x[8 * s + 2], x[8 * s + 3]); p.z = cvtpk(x[8 * s + 4], x[8 * s + 5]); p.w = cvtpk(x[8 * s + 6], x[8 * s + 7]);
    return __builtin_bit_cast(bf16x8, p);
}
__device__ __forceinline__ bf16x8 mk8(s16x4 lo, s16x4 hi) { return (bf16x8){lo[0], lo[1], lo[2], lo[3], hi[0], hi[1], hi[2], hi[3]}; }

__device__ __forceinline__ int opaque_v(int v) { asm volatile("" : "+v"(v)); return v; }
namespace pg8 {
constexpr int BM = 256, BK = 64, HALF = 128, HTB = HALF * BK * 2, NXCD = 8, WGM = 4;
__host__ __device__ __forceinline__ int lds_byte(int r, int c) { const int st = (r >> 4) * 2 + (c >> 5), rr = r & 15, cc = c & 31, ob = rr * 64 + cc * 2; return st * 1024 + (ob ^ (((ob >> 9) & 1) << 5)); }
__host__ __device__ __forceinline__ void stage_rc(int b, int& R, int& C) { const int st = b / 1024, sb = b % 1024, swz = sb ^ (((sb >> 9) & 1) << 5); R = (st >> 1) * 16 + swz / 64; C = (st & 1) * 32 + (swz % 64) / 2; }
__host__ __device__ __forceinline__ int perm32(int rho) { const int n = rho >> 4, i = rho & 15; return 8 * (i >> 2) + 4 * n + (i & 3); }

struct Unit { int pm, pn, sub; unsigned aoff, boff; };
struct Gemm { const bf16_t* A; const bf16_t* Bt; int lda, ldb, K; unsigned* tp; };

struct Sched {
    int nM, nN, nSub, nwg, G, c; unsigned a_pm, a_sub, b_pn, b_sub; bool subFast;
    __device__ void init(int M, int N, int nSub_, int G_, int c_, unsigned a_pm_, unsigned a_sub_, unsigned b_pn_, unsigned b_sub_) {
        nM = M / BM; nN = N / BM; nSub = nSub_; nwg = nM * nN; G = G_; c = c_; a_pm = a_pm_; a_sub = a_sub_; b_pn = b_pn_; b_sub = b_sub_; subFast = true; }
    __device__ bool next(int i, Unit& u) const {
        int round, sub; long L;
        if (subFast) { round = i / nSub; sub = i - round * nSub; L = (long)round * G + c; if (L >= nwg) return false; }
        else { const long LL = (long)i * G + c; if (LL >= (long)nwg * nSub) return false; sub = (int)(LL / nwg); L = LL - (long)sub * nwg; }
        int wgid = (int)L; { const int q = nwg / NXCD, r = nwg % NXCD, xcd = wgid % NXCD, off = wgid / NXCD; wgid = (xcd < r ? xcd * (q + 1) : r * (q + 1) + (xcd - r) * q) + off; }
        const int nig = WGM * nN, gid = wgid / nig, fm = gid * WGM, gsz = (nM - fm) < WGM ? (nM - fm) : WGM;
        u.pm = fm + ((wgid % nig) % gsz); u.pn = (wgid % nig) / gsz; u.sub = sub;
        u.aoff = (unsigned)u.pm * a_pm + (unsigned)sub * a_sub; u.boff = (unsigned)u.pn * b_pn + (unsigned)sub * b_sub; return true;
    }
};

template <class Epi, bool ALIGN_EPI, bool SP2>
__device__ __forceinline__ void gemm_phase(LAS unsigned char* lds, const Gemm g, const Sched& S, const Epi& E) {
    const int tid = opaque_v(threadIdx.x), wid = __builtin_amdgcn_readfirstlane(tid >> 6), lane = tid & 63, wr = wid >> 2, wc = wid & 3, fr = lane & 15, fq = lane >> 4;
    const int K = g.K, nt = K / BK;
    unsigned voffA[2], voffB[2];
#pragma unroll
    for (int i = 0; i < 2; ++i) { int R, C; stage_rc(tid * 16 + i * 8192, R, C); const int Rb = (R & ~31) + perm32(R & 31);
        voffA[i] = (unsigned)(R * g.lda + C) * 2u; voffB[i] = (unsigned)(Rb * g.ldb + C) * 2u; }
    const size_t kstep = (size_t)(BK * 2);
    const size_t hstepA = (size_t)HALF * g.lda * 2, hstepB = (size_t)HALF * g.ldb * 2;
    const unsigned ldsw = (unsigned)wid * 1024u;
    const int aoff = lds_byte(wr * 64 + fr, fq * 8), boff = lds_byte(wc * 32 + fr, fq * 8);
#define PG8_SA(b, h) (((b) * 2 + (h)) * HTB)
#define PG8_SB(b, h) ((4 + (b) * 2 + (h)) * HTB)
#define PG8_STAGE(bufoff, gbase, voff) do { _Pragma("unroll") for (int _i = 0; _i < 2; ++_i) \
        __builtin_amdgcn_global_load_lds((const unsigned*)((const char*)(gbase) + (voff)[_i]), (LAS unsigned*)(lds + (bufoff) + ldsw + _i * 8192), 16, 0, 0); } while (0)
#define PG8_LDA(dst, b, h) do { _Pragma("unroll") for (int m = 0; m < 4; ++m) _Pragma("unroll") for (int k = 0; k < 2; ++k) dst[m][k] = *(const LAS bf16x8*)(lds + PG8_SA(b, h) + aoff + m * 2048 + k * 1024); } while (0)
#define PG8_LDB(dst, b, h) do { _Pragma("unroll") for (int n = 0; n < 2; ++n) _Pragma("unroll") for (int k = 0; k < 2; ++k) dst[n][k] = *(const LAS bf16x8*)(lds + PG8_SB(b, h) + boff + n * 2048 + k * 1024); } while (0)
#define PG8_MMA(ai, bj, At, Bt) do { __builtin_amdgcn_s_setprio(1); _Pragma("unroll") for (int m = 0; m < 4; ++m) _Pragma("unroll") for (int n = 0; n < 2; ++n) _Pragma("unroll") for (int k = 0; k < 2; ++k) \
        acc[ai][bj][m][n] = __builtin_amdgcn_mfma_f32_16x16x32_bf16(Bt[n][k], At[m][k], acc[ai][bj][m][n], 0, 0, 0); __builtin_amdgcn_s_setprio(0); } while (0)
#define PG8_WAIT_V(n) asm volatile("s_waitcnt vmcnt(" #n ")" ::: "memory")
#define PG8_WAIT_L(n) asm volatile("s_waitcnt lgkmcnt(" #n ")" ::: "memory")
#define PG8_BAR __builtin_amdgcn_s_barrier()
#define PG8_SCHED __builtin_amdgcn_sched_barrier(0)
    Unit cur, nxt; int ui = 0;
    if (!S.next(0, cur)) return;
    f32x4 acc[2][2][4][2];
#pragma unroll
    for (int a = 0; a < 2; ++a)
#pragma unroll
        for (int b = 0; b < 2; ++b)
#pragma unroll
            for (int m = 0; m < 4; ++m)
#pragma unroll
                for (int n = 0; n < 2; ++n) acc[a][b][m][n] = (f32x4){0.f, 0.f, 0.f, 0.f};
    bf16x8 At[4][2], B0[2][2], B1[2][2];
    const char* cA = (const char*)g.A + cur.aoff; const char* cB = (const char*)g.Bt + cur.boff;
    if constexpr (SP2) {
        PG8_STAGE(PG8_SB(0, 0), cB, voffB); PG8_STAGE(PG8_SB(0, 1), cB + hstepB, voffB); PG8_STAGE(PG8_SA(0, 0), cA, voffA); PG8_STAGE(PG8_SA(0, 1), cA + hstepA, voffA);
        if (wr == 1) PG8_BAR;
        PG8_WAIT_V(2); PG8_BAR;
        PG8_STAGE(PG8_SB(1, 0), cB + kstep, voffB); PG8_STAGE(PG8_SA(1, 0), cA + kstep, voffA); PG8_STAGE(PG8_SB(1, 1), cB + hstepB + kstep, voffB);
        PG8_WAIT_V(6); PG8_BAR;
    } else {
        PG8_STAGE(PG8_SB(0, 0), cB, voffB); PG8_STAGE(PG8_SA(0, 0), cA, voffA); PG8_STAGE(PG8_SB(0, 1), cB + hstepB, voffB); PG8_STAGE(PG8_SA(0, 1), cA + hstepA, voffA);
        if (wr == 1) PG8_BAR;
        PG8_WAIT_V(4); PG8_BAR;
        PG8_STAGE(PG8_SB(1, 0), cB + kstep, voffB); PG8_STAGE(PG8_SA(1, 0), cA + kstep, voffA); PG8_STAGE(PG8_SB(1, 1), cB + hstepB + kstep, voffB);
        PG8_WAIT_V(6); PG8_BAR;
    }
    for (;;) {
        const bool has_next = S.next(ui + 1, nxt);
        const char* nA = has_next ? (const char*)g.A + nxt.aoff : cA; const char* nB = has_next ? (const char*)g.Bt + nxt.boff : cB;
        const unsigned long long tk0_ = (TSEC == 9) ? __builtin_amdgcn_s_memrealtime() : ((TSEC == 13) ? __builtin_amdgcn_s_memtime() : 0ull);
        for (int t = 0; t < nt; t += 2) {
            const bool last = (t == nt - 2);
            const char* a1 = cA + (size_t)(t + 1) * kstep;
            const char* a2 = last ? nA : cA + (size_t)(t + 2) * kstep; const char* b2 = last ? nB : cB + (size_t)(t + 2) * kstep;
            const char* a3 = a2 + kstep; const char* b3 = b2 + kstep;
            if constexpr (SP2) {
            PG8_LDB(B0, 0, 0); PG8_LDB(B1, 0, 1); PG8_SCHED; PG8_LDA(At, 0, 0); PG8_STAGE(PG8_SA(1, 1), a1 + hstepA, voffA);
            PG8_WAIT_V(8); PG8_WAIT_L(0); PG8_BAR; PG8_MMA(0, 0, At, B0); PG8_MMA(0, 1, At, B1); PG8_BAR; PG8_SCHED;
            PG8_LDA(At, 0, 1); PG8_STAGE(PG8_SB(0, 0), b2, voffB); PG8_STAGE(PG8_SB(0, 1), b2 + hstepB, voffB); PG8_STAGE(PG8_SA(0, 0), a2, voffA);
            PG8_WAIT_V(8); PG8_WAIT_L(0); PG8_BAR; PG8_MMA(1, 0, At, B0); PG8_MMA(1, 1, At, B1); PG8_BAR; PG8_SCHED;
            PG8_LDB(B0, 1, 0); PG8_LDB(B1, 1, 1); PG8_SCHED; PG8_LDA(At, 1, 0); PG8_STAGE(PG8_SA(0, 1), a2 + hstepA, voffA);
            PG8_WAIT_V(8); PG8_WAIT_L(0); PG8_BAR; PG8_MMA(0, 0, At, B0); PG8_MMA(0, 1, At, B1); PG8_BAR; PG8_SCHED;
            PG8_LDA(At, 1, 1); PG8_STAGE(PG8_SB(1, 0), b3, voffB); PG8_STAGE(PG8_SB(1, 1), b3 + hstepB, voffB); PG8_STAGE(PG8_SA(1, 0), a3, voffA);
            PG8_WAIT_V(8); PG8_WAIT_L(0); PG8_BAR; PG8_MMA(1, 0, At, B0); PG8_MMA(1, 1, At, B1); PG8_BAR; PG8_SCHED;
            } else {
            PG8_LDB(B0, 0, 0); PG8_SCHED; PG8_LDA(At, 0, 0); PG8_STAGE(PG8_SA(1, 1), a1 + hstepA, voffA);
            PG8_WAIT_L(8); PG8_BAR; PG8_WAIT_L(0); PG8_MMA(0, 0, At, B0); PG8_BAR; PG8_SCHED;
            PG8_LDB(B1, 0, 1); PG8_STAGE(PG8_SB(0, 0), b2, voffB);
            PG8_BAR; PG8_WAIT_L(0); PG8_MMA(0, 1, At, B1); PG8_BAR;
            PG8_LDA(At, 0, 1); PG8_STAGE(PG8_SA(0, 0), a2, voffA);
            PG8_BAR; PG8_WAIT_L(0); PG8_MMA(1, 0, At, B0); PG8_BAR; PG8_SCHED;
            PG8_STAGE(PG8_SB(0, 1), b2 + hstepB, voffB);
            PG8_WAIT_V(6); PG8_BAR; PG8_MMA(1, 1, At, B1); PG8_BAR;
            PG8_LDB(B0, 1, 0); PG8_SCHED; PG8_LDA(At, 1, 0); PG8_STAGE(PG8_SA(0, 1), a2 + hstepA, voffA);
            PG8_WAIT_L(8); PG8_BAR; PG8_WAIT_L(0); PG8_MMA(0, 0, At, B0); PG8_BAR; PG8_SCHED;
            PG8_LDB(B1, 1, 1); PG8_STAGE(PG8_SB(1, 0), b3, voffB);
            PG8_BAR; PG8_WAIT_L(0); PG8_MMA(0, 1, At, B1); PG8_BAR;
            PG8_LDA(At, 1, 1); PG8_STAGE(PG8_SA(1, 0), a3, voffA);
            PG8_BAR; PG8_WAIT_L(0); PG8_MMA(1, 0, At, B0); PG8_BAR; PG8_SCHED;
            PG8_STAGE(PG8_SB(1, 1), b3 + hstepB, voffB);
            PG8_WAIT_V(6); PG8_BAR; PG8_MMA(1, 1, At, B1); PG8_BAR;
            }
        }
        if ((TSEC == 9 || TSEC == 13) && g.tp && tid == 0 && blockIdx.x == 0) { const unsigned long long d_ = ((TSEC == 9) ? __builtin_amdgcn_s_memrealtime() : __builtin_amdgcn_s_memtime()) - tk0_; *g.tp += (unsigned)((TSEC == 9) ? d_ : (d_ >> 5)); }
        if constexpr (ALIGN_EPI) { if (wr == 0) PG8_BAR; }
        const unsigned long long te0_ = (TSEC == 8) ? __builtin_amdgcn_s_memrealtime() : 0ull;
        const bool keep = E(acc, cur, wr, wc, fr, fq);
        if (TSEC == 8 && g.tp && tid == 0 && blockIdx.x == 0) { asm volatile("s_waitcnt vmcnt(0)" ::: "memory"); *g.tp += (unsigned)(__builtin_amdgcn_s_memrealtime() - te0_); }
        if (!has_next) break;
        if (!keep) {
#pragma unroll
        for (int a = 0; a < 2; ++a)
#pragma unroll
            for (int b = 0; b < 2; ++b)
#pragma unroll
                for (int m = 0; m < 4; ++m)
#pragma unroll
                    for (int n = 0; n < 2; ++n) acc[a][b][m][n] = (f32x4){0.f, 0.f, 0.f, 0.f};
        }
        cur = nxt; cA = nA; cB = nB; ++ui;
        if constexpr (ALIGN_EPI) { if (wr == 1) PG8_BAR; }
    }
    PG8_WAIT_V(0);
    if constexpr (!ALIGN_EPI) { if (wr == 0) PG8_BAR; }
    PG8_BAR;
#undef PG8_SA
#undef PG8_SB
#undef PG8_STAGE
#undef PG8_LDA
#undef PG8_LDB
#undef PG8_MMA
#undef PG8_WAIT_V
#undef PG8_WAIT_L
#undef PG8_BAR
#undef PG8_SCHED
}
}
typedef f32x4 Acc[2][2][4][2];
using pg8::Unit;

__device__ __forceinline__ void st16_wt(void* p, const u32x4 w) { asm volatile("global_store_dwordx4 %0, %1, off sc1\n\ts_nop 1" : : "v"(p), "v"(w) : "memory"); }
__device__ __forceinline__ void st8(bf16_t* p, const f32x4 a, const f32x4 b) { u32x4 w; w.x = cvtpk(a[0], a[1]); w.y = cvtpk(a[2], a[3]); w.z = cvtpk(b[0], b[1]); w.w = cvtpk(b[2], b[3]); st16_wt(p, w); }

struct EpiQKV {
    unsigned char* ws; const float* ss; const float* gka;
    __device__ __forceinline__ bool operator()(Acc& acc, const Unit& u, int wr, int wc, int fr, int fq) const {
        const int G = 4 * u.pn + wc;
        if (G >= 45) return false;
        unsigned dmib; int ld, g0, op;
        if (G < 8) { dmib = WS_QA / MiB; ld = 512; g0 = 0; op = 1; }
        else if (G < 10) { dmib = WS_KA / MiB; ld = 128; g0 = 8; op = 2; }
        else if (G < 12) { dmib = WS_VA / MiB; ld = 128; g0 = 10; op = 0; }
        else if (G < 16) { dmib = WS_QB / MiB; ld = 256; g0 = 12; op = 3; }
        else if (G < 20) { dmib = WS_KB / MiB; ld = 256; g0 = 16; op = 0; }
        else if (G < 28) { dmib = WS_VB / MiB; ld = 512; g0 = 20; op = 0; }
        else if (G < 36) { dmib = WS_OG / MiB; ld = 512; g0 = 28; op = 4; }
        else if (G < 44) { dmib = WS_QM / MiB; ld = 512; g0 = 36; op = 0; }
        else { dmib = WS_LR / MiB; ld = 32; g0 = 44; op = 5; }
        bf16_t* base = (bf16_t*)(ws + (size_t)dmib * MiB); const int col = 64 * (G - g0);
        f32x4 gk[2][2];
#pragma unroll
        for (int bj = 0; bj < 2; ++bj)
#pragma unroll
            for (int n = 0; n < 2; ++n) {
                gk[bj][n] = (f32x4){1.f, 1.f, 1.f, 1.f};
                if (op == 2) { const int d = 32 * bj + 8 * fq + 4 * n; gk[bj][n] = *(const f32x4*)(gka + d); }
            }
        const int row0 = u.pm * 256 + wr * 64 + fr;
        float rsv[2][4];
#pragma unroll
        for (int ai = 0; ai < 2; ++ai)
#pragma unroll
            for (int m = 0; m < 4; ++m) rsv[ai][m] = ss[row0 + ai * 128 + m * 16];
#pragma unroll
        for (int ai = 0; ai < 2; ++ai)
#pragma unroll
            for (int m = 0; m < 4; ++m) {
                const int row = row0 + ai * 128 + m * 16;
                const float rs = __builtin_amdgcn_rsqf(rsv[ai][m] * (1.0f / DM) + EPS);
                f32x4 v[2][2];
#pragma unroll
                for (int bj = 0; bj < 2; ++bj)
#pragma unroll
                    for (int n = 0; n < 2; ++n) v[bj][n] = acc[ai][bj][m][n] * rs;
                if (op == 1 || op == 2) {
                    float s = 0.f;
#pragma unroll
                    for (int bj = 0; bj < 2; ++bj)
#pragma unroll
                        for (int n = 0; n < 2; ++n) { const f32x4 x = v[bj][n]; s += (x[0] * x[0] + x[1] * x[1]) + (x[2] * x[2] + x[3] * x[3]); }
                    s += __shfl_xor(s, 16); s += __shfl_xor(s, 32);
                    const float r2 = __builtin_amdgcn_rsqf(s * (1.0f / 64.0f) + EPS);
#pragma unroll
                    for (int bj = 0; bj < 2; ++bj)
#pragma unroll
                        for (int n = 0; n < 2; ++n) v[bj][n] = v[bj][n] * r2 * gk[bj][n];
                } else if (op == 3) {
#pragma unroll
                    for (int bj = 0; bj < 2; ++bj)
#pragma unroll
                        for (int n = 0; n < 2; ++n) v[bj][n] = v[bj][n] * 0.125f;
                } else if (op == 4) {
#pragma unroll
                    for (int bj = 0; bj < 2; ++bj)
#pragma unroll
                        for (int n = 0; n < 2; ++n)
#pragma unroll
                            for (int e = 0; e < 4; ++e) v[bj][n][e] = siluf_(v[bj][n][e]);
                }
                bf16_t* rp = base + (size_t)row * ld + col + 8 * fq;
                st8(rp, v[0][0], v[0][1]);
                if (op != 5) st8(rp + 32, v[1][0], v[1][1]);
            }
        return false;
    }
};
template <int ACT> struct EpiRowScale {
    bf16_t* O; int ldc; size_t sub_stride; const float* ss;
    __device__ __forceinline__ bool operator()(Acc& acc, const Unit& u, int wr, int wc, int fr, int fq) const {
        const int row0 = u.pm * 256 + wr * 64 + fr, col0 = u.pn * 256 + wc * 32 + 8 * fq;
        bf16_t* base = O + (size_t)u.sub * sub_stride;
#pragma unroll
        for (int ai = 0; ai < 2; ++ai)
#pragma unroll
            for (int m = 0; m < 4; ++m) {
                const int row = row0 + ai * 128 + m * 16;
                const float rs = __builtin_amdgcn_rsqf(ss[row] * (1.0f / DM) + EPS);
#pragma unroll
                for (int bj = 0; bj < 2; ++bj) {
                    f32x4 a = acc[ai][bj][m][0] * rs, b = acc[ai][bj][m][1] * rs;
                    if (ACT == 1) {
#pragma unroll
                        for (int e = 0; e < 4; ++e) { a[e] = sigmoidf_(a[e]); b[e] = sigmoidf_(b[e]); }
                    }
                    st8(base + (size_t)row * ldc + col0 + bj * 128, a, b);
                }
            }
        return false;
    }
};
struct EpiGate {
    u32x4* GT; const float* ss; unsigned* fin_cnt; unsigned fin_need; mutable bool fin_ok;
    __device__ __forceinline__ bool operator()(Acc& acc, const Unit& u, int wr, int wc, int fr, int fq) const {
        if (!fin_ok) { fin_ok = true; unsigned sp = 0; while (__hip_atomic_load(fin_cnt, __ATOMIC_RELAXED, __HIP_MEMORY_SCOPE_AGENT) < fin_need && ++sp < (1u << 22)) __builtin_amdgcn_s_sleep(2); }
        const int row0 = u.pm * 256 + wr * 64 + fr, lane = fq * 16 + fr, j = u.sub;
        const size_t gstride = (size_t)128 * 4 * 8 * 16 * 64;
        u32x4* gp = GT + (size_t)j * gstride + ((((size_t)u.pm * 4 + u.pn) * 8 + (wr * 4 + wc)) * 16) * 64 + lane;
        float rs[2][4];
#pragma unroll
        for (int ai = 0; ai < 2; ++ai)
#pragma unroll
            for (int m = 0; m < 4; ++m) rs[ai][m] = ss[row0 + ai * 128 + m * 16];
#pragma unroll
        for (int ai = 0; ai < 2; ++ai) {
            u32x4 pv[4][2];
            if (j > 0) {
#pragma unroll
                for (int m = 0; m < 4; ++m)
#pragma unroll
                    for (int bj = 0; bj < 2; ++bj) pv[m][bj] = *(const u32x4*)(gp - gstride + ((ai * 4 + m) * 2 + bj) * 64);
            }
#pragma unroll
            for (int m = 0; m < 4; ++m) {
                const float r = __builtin_amdgcn_rsqf(rs[ai][m] * (1.0f / DM) + EPS);
#pragma unroll
                for (int bj = 0; bj < 2; ++bj) {
                    const f32x4 a = acc[ai][bj][m][0] * (-r * LOG2E), b = acc[ai][bj][m][1] * (-r * LOG2E);
                    float t[8] = {1.0f + ex2(a[0]), 1.0f + ex2(a[1]), 1.0f + ex2(a[2]), 1.0f + ex2(a[3]), 1.0f + ex2(b[0]), 1.0f + ex2(b[1]), 1.0f + ex2(b[2]), 1.0f + ex2(b[3])};
#pragma unroll
                    for (int e = 0; e < 8; ++e) t[e] = fminf(t[e], 1e30f);
                    u32x4* cp = gp + ((ai * 4 + m) * 2 + bj) * 64;
                    if (j < 2) { u32x4 w; w.x = cvtpk(t[0], t[1]); w.y = cvtpk(t[2], t[3]); w.z = cvtpk(t[4], t[5]); w.w = cvtpk(t[6], t[7]); *cp = w; }
                    else { u32x4 w; w.x = cvtpk(__builtin_amdgcn_rcpf(t[0]), __builtin_amdgcn_rcpf(t[1])); w.y = cvtpk(__builtin_amdgcn_rcpf(t[2]), __builtin_amdgcn_rcpf(t[3]));
                           w.z = cvtpk(__builtin_amdgcn_rcpf(t[4]), __builtin_amdgcn_rcpf(t[5])); w.w = cvtpk(__builtin_amdgcn_rcpf(t[6]), __builtin_amdgcn_rcpf(t[7])); st16_wt(cp, w); }
                    if (j > 0) {
                        const u32x4 p = pv[m][bj];
                        const float n_[8] = {bflo(p.x), bfhi(p.x), bflo(p.y), bfhi(p.y), bflo(p.z), bfhi(p.z), bflo(p.w), bfhi(p.w)};
                        float q[8];
#pragma unroll
                        for (int e = 0; e < 8; ++e) q[e] = t[e] * __builtin_amdgcn_rcpf(n_[e]);
                        u32x4 rr; rr.x = cvtpk(q[0], q[1]); rr.y = cvtpk(q[2], q[3]); rr.z = cvtpk(q[4], q[5]); rr.w = cvtpk(q[6], q[7]);
                        st16_wt(cp - gstride, rr);
                    }
                }
            }
        }
        return false;
    }
};
struct EpiMerge {
    const u32x4* GT; bf16_t* O;
    __device__ __forceinline__ bool operator()(Acc& acc, const Unit& u, int wr, int wc, int fr, int fq) const {
        const int row0 = u.pm * 256 + wr * 64 + fr, col0 = u.pn * 256 + wc * 32 + 8 * fq, lane = fq * 16 + fr;
        const int sub = u.sub;
        const size_t gstride = (size_t)128 * 4 * 8 * 16 * 64;
        const u32x4* gp = GT + (size_t)sub * gstride + ((((size_t)u.pm * 4 + u.pn) * 8 + (wr * 4 + wc)) * 16) * 64 + lane;
        u32x4 ga[2][4][2];
#pragma unroll
        for (int ai = 0; ai < 2; ++ai)
#pragma unroll
            for (int m = 0; m < 4; ++m)
#pragma unroll
                for (int bj = 0; bj < 2; ++bj) ga[ai][m][bj] = gp[((ai * 4 + m) * 2 + bj) * 64];
#pragma unroll
        for (int ai = 0; ai < 2; ++ai)
#pragma unroll
            for (int m = 0; m < 4; ++m) {
                const int row = row0 + ai * 128 + m * 16;
#pragma unroll
                for (int bj = 0; bj < 2; ++bj) {
                    const u32x4 x = ga[ai][m][bj];
                    const float f[8] = {bflo(x.x), bfhi(x.x), bflo(x.y), bfhi(x.y), bflo(x.z), bfhi(x.z), bflo(x.w), bfhi(x.w)};
                    f32x4 a = acc[ai][bj][m][0], b = acc[ai][bj][m][1];
#pragma unroll
                    for (int e = 0; e < 4; ++e) { a[e] *= f[e]; b[e] *= f[4 + e]; }
                    acc[ai][bj][m][0] = a; acc[ai][bj][m][1] = b;
                    if (sub == 2) st8(O + (size_t)row * DM + col0 + bj * 128, a, b);
                }
            }
        return sub < 2;
    }
};
struct EpiRes {
    bf16_t* XB; float* xout; float* ss; bool dry;
    __device__ __forceinline__ bool operator()(Acc& acc, const Unit& u, int wr, int wc, int fr, int fq) const {
        const int row0 = u.pm * 256 + wr * 64 + fr, col0 = u.pn * 256 + wc * 32 + 8 * fq;
#pragma unroll
        for (int ai = 0; ai < 2; ++ai) {
            u32x4 xr[4][2];
#pragma unroll
            for (int m = 0; m < 4; ++m)
#pragma unroll
                for (int bj = 0; bj < 2; ++bj) xr[m][bj] = *(const u32x4*)(XB + (size_t)(row0 + ai * 128 + m * 16) * DM + col0 + bj * 128);
            asm volatile("" ::: "memory");
#pragma unroll
            for (int m = 0; m < 4; ++m) {
                const int row = row0 + ai * 128 + m * 16; float s = 0.f;
#pragma unroll
                for (int bj = 0; bj < 2; ++bj) {
                    const size_t off = (size_t)row * DM + col0 + bj * 128; const u32x4 x = xr[m][bj];
                    const f32x4 a = (f32x4){bflo(x.x), bfhi(x.x), bflo(x.y), bfhi(x.y)} + acc[ai][bj][m][0], b = (f32x4){bflo(x.z), bfhi(x.z), bflo(x.w), bfhi(x.w)} + acc[ai][bj][m][1];
                    if (xout) { if (!dry) { *(f32x4*)(xout + off) = a; *(f32x4*)(xout + off + 4) = b; } }
                    else if (!dry) { st8(XB + off, a, b); s += (a[0] * a[0] + a[1] * a[1]) + (a[2] * a[2] + a[3] * a[3]) + (b[0] * b[0] + b[1] * b[1]) + (b[2] * b[2] + b[3] * b[3]); }
                }
                if (!xout && !dry) { s += __shfl_xor(s, 16); s += __shfl_xor(s, 32); if (fq == 0) atomicAdd(ss + row, s); }
            }
            asm volatile("" ::: "memory");
        }
        return false;
    }
};
struct EpiFFN {
    bf16_t* H; const float* ss;
    __device__ __forceinline__ bool operator()(Acc& acc, const Unit& u, int wr, int wc, int fr, int fq) const {
        const int row0 = u.pm * 256 + wr * 64 + fr, col0 = u.pn * 128 + wc * 32 + 8 * fq;
        float rsv[2][4];
#pragma unroll
        for (int ai = 0; ai < 2; ++ai)
#pragma unroll
            for (int m = 0; m < 4; ++m) rsv[ai][m] = ss[row0 + ai * 128 + m * 16];
#pragma unroll
        for (int ai = 0; ai < 2; ++ai)
#pragma unroll
            for (int m = 0; m < 4; ++m) {
                const int row = row0 + ai * 128 + m * 16;
                const float rs = __builtin_amdgcn_rsqf(rsv[ai][m] * (1.0f / DM) + EPS);
                f32x4 h[2];
#pragma unroll
                for (int n = 0; n < 2; ++n)
#pragma unroll
                    for (int e = 0; e < 4; ++e) { const float gt = acc[ai][0][m][n][e] * rs, up = acc[ai][1][m][n][e] * rs; h[n][e] = siluf_(gt) * up; }
                st8(H + (size_t)row * DFF + col0, h[0], h[1]);
            }
        return false;
    }
};

typedef GAS unsigned gu32;
#define XB_TMO      128
#define XB_XCNT(j)  (256  + 64 * (j))
#define XB_XSUB(j)  (1280 + 64 * (j))
#define XB_XGEN(j)  (2304 + 64 * (j))
#define XB_TOP      3328
#define XB_TOPGEN   3392
#define XCD_BAR_WORDS 3456
#define XB_SPIN_CAP (1u << 22)
__device__ __forceinline__ unsigned xb_ld(unsigned* p)              { return __hip_atomic_load(p, __ATOMIC_RELAXED, __HIP_MEMORY_SCOPE_AGENT); }
__device__ __forceinline__ unsigned xb_add(unsigned* p, unsigned v) { return __hip_atomic_fetch_add(p, v, __ATOMIC_RELAXED, __HIP_MEMORY_SCOPE_AGENT); }
__device__ __forceinline__ unsigned xb_xcc_id() { return (unsigned)__builtin_amdgcn_s_getreg((3 << 11) | 20) & 0xFu; }
#define XB_SPIN(cond, bar) do { unsigned _sp = 0; while (cond) { __builtin_amdgcn_s_sleep(1); \
    if ((++_sp & 255u) == 0u) { if (xb_ld(&(bar)[XB_TMO])) break; if (_sp > XB_SPIN_CAP) { atomicAdd(&(bar)[XB_TMO], 1u); break; } } } } while (0)
struct XcdBarrier { unsigned* bar; unsigned x; volatile LAS unsigned* st; };
__device__ __forceinline__ XcdBarrier xcd_barrier_post(unsigned* bar, volatile LAS unsigned* st) {
    XcdBarrier b; b.bar = bar; b.x = xb_xcc_id(); b.st = st;
    if (threadIdx.x == 0) (void)xb_add(&bar[XB_XCNT(b.x)], 1u);
    return b;
}
__device__ __forceinline__ void xcd_barrier_complete(unsigned* bar, unsigned x, unsigned& nloc, unsigned& nx) {
    const unsigned G = gridDim.x * gridDim.y * gridDim.z;
    unsigned sum, cnt, mine, sp = 0u;
    for (;;) {
        sum = 0u; cnt = 0u; mine = 0u;
#pragma unroll
        for (unsigned j = 0; j < 16; ++j) { const unsigned c = xb_ld(&bar[XB_XCNT(j)]); sum += c; cnt += (c > 0u) ? 1u : 0u; mine = (j == x) ? c : mine; }
        if (sum == G) break;
        __builtin_amdgcn_s_sleep(1);
        if ((++sp & 255u) == 0u) { if (xb_ld(&bar[XB_TMO])) break; if (sp > XB_SPIN_CAP) { atomicAdd(&bar[XB_TMO], 1u); break; } }
    }
    nloc = mine > 0u ? mine : 1u; nx = cnt > 0u ? cnt : 1u;
}
__device__ __forceinline__ void xcd_barrier(const XcdBarrier& b) {
    asm volatile("s_waitcnt vmcnt(0)" ::: "memory");
    __syncthreads();
    if (threadIdx.x == 0) {
        unsigned* bar = b.bar;
        __builtin_amdgcn_s_waitcnt(0);
        unsigned nloc = b.st[0], nx = b.st[1];
        if (nloc == 0u) { xcd_barrier_complete(bar, b.x, nloc, nx); b.st[0] = nloc; b.st[1] = nx; }
        const unsigned old = xb_add(&bar[XB_XSUB(b.x)], 1u);
        const unsigned gen = old / nloc;
        if (old + 1u == (gen + 1u) * nloc) {
            __builtin_amdgcn_fence(__ATOMIC_RELEASE, "agent");
            asm volatile("s_waitcnt vmcnt(0)" ::: "memory");
            const unsigned og = xb_add(&bar[XB_TOP], 1u);
            const unsigned tg = og / nx;
            if (og + 1u == (tg + 1u) * nx) xb_add(&bar[XB_TOPGEN], 1u);
            else XB_SPIN(xb_ld(&bar[XB_TOPGEN]) == tg, bar);
            __builtin_amdgcn_fence(__ATOMIC_ACQUIRE, "agent");
            xb_add(&bar[XB_XGEN(b.x)], 1u);
            asm volatile("s_waitcnt vmcnt(0)" ::: "memory");
        } else {
            XB_SPIN(xb_ld(&bar[XB_XGEN(b.x)]) == gen, bar);
            __builtin_amdgcn_fence(__ATOMIC_ACQUIRE, "agent");
            asm volatile("s_waitcnt vmcnt(0)" ::: "memory");
        }
    }
    __syncthreads();
}

struct Args { const float* in[20]; float* out; unsigned char* ws; int ph_lo, ph_hi; };
struct Frame {
    LAS unsigned char* lds; unsigned char* ws; int tid, lane, wave, G, bid;
    float* out;
};
__device__ __forceinline__ const float* par(const Frame& F, int l, int off) { return (const float*)(F.ws + WS_PAR) + l * PAR_LAYER + off; }
enum { I_X = 0, I_MEM, I_RELB, I_NMIX, I_NFFN, I_NMEM, I_WIN, I_QNA, I_KNA, I_SINK, I_WDU, I_BDEC, I_GLAG, I_WMKV, I_QNM, I_KNM, I_WBR, I_WOUT, I_WFI, I_WFO };

__device__ __forceinline__ float wave_sum(float v) {
#pragma unroll
    for (int o = 1; o < 64; o <<= 1) v += __shfl_xor(v, o);
    return v;
}

#define T_BEGIN() const unsigned long long t_begin_ = (TSEC >= 0) ? __builtin_amdgcn_s_memrealtime() : 0ull
#define T_END(id) do { if (TSEC == (id) && F.bid == 0 && F.tid == 0) { unsigned* p_ = (unsigned*)(F.ws + WS_CTL) + 8192; *p_ += (unsigned)(__builtin_amdgcn_s_memrealtime() - t_begin_); } } while (0)
__device__ __forceinline__ int ina_src(int n0);
__device__ __forceinline__ int src32(int kind, int pn, int jb) {
    if (kind == 1) return ina_src(256 * pn + 32 * jb);
    if (kind == 2) return 2848 + 256 * pn + 32 * jb;
    if (kind == 3) return 2816 * (jb >> 2) + 128 * pn + 32 * (jb & 3);
    return 256 * pn + 32 * jb;
}
struct TrItem { const float* W; int ldw, kind, pn, k0; bf16_t* Bt; int ldb, kd0; const float* gain; };
__device__ __forceinline__ void tr_load(const Frame& F, const TrItem& I, f32x4 (&v)[8]) {
    const int lane = F.lane, w = F.wave;
    const int sc = src32(I.kind, I.pn, lane >> 3);
#pragma unroll
    for (int i = 0; i < 8; ++i) { const int k = w + 8 * i; v[i] = (f32x4){0.f, 0.f, 0.f, 0.f}; if (sc >= 0) v[i] = *(const f32x4*)(I.W + (size_t)(I.k0 + k) * I.ldw + sc + 4 * (lane & 7)); }
}
__device__ __forceinline__ void tr_process(Frame& F, const TrItem& I, const f32x4 (&v)[8]) {
    LAS float* Tl = (LAS float*)F.lds;
    const int lane = F.lane, w = F.wave, tid = F.tid;
#pragma unroll
    for (int i = 0; i < 8; ++i) { const int k = w + 8 * i; f32x4 x = v[i]; if (I.gain) x = x * I.gain[I.k0 + k]; *(LAS f32x4*)(Tl + k * 260 + 4 * lane) = x; }
    asm volatile("s_waitcnt lgkmcnt(0)\n\ts_barrier" ::: "memory");
    const int n = tid & 255, kh = tid >> 8;
#pragma unroll
    for (int c = 0; c < 4; ++c) { const int k8 = 32 * kh + 8 * c; const LAS float* sp = Tl + k8 * 260 + n;
        u32x4 o; o.x = cvtpk(sp[0], sp[260]); o.y = cvtpk(sp[2 * 260], sp[3 * 260]); o.z = cvtpk(sp[4 * 260], sp[5 * 260]); o.w = cvtpk(sp[6 * 260], sp[7 * 260]);
        *(u32x4*)(I.Bt + (size_t)(256 * I.pn + n) * I.ldb + I.kd0 + I.k0 + k8) = o; }
    asm volatile("s_waitcnt lgkmcnt(0)\n\ts_barrier" ::: "memory");
}
__device__ __forceinline__ int ina_src(int n0) {
    const int pn = n0 >> 8, c = n0 & 255, bj = c >> 7, wc = (c >> 5) & 3;
    const int x = 64 * (4 * pn + wc) + 32 * bj;
    if (x < 2304) return x;
    if (x < 2816) return x + 32;
    if (x < 2848) return 2304 + (x - 2816);
    return -1;
}
__device__ __forceinline__ void p0_prologue(Frame& F, const Args& A) {
    const int gw = F.bid * 8 + F.wave, NGW = F.G * 8;
    constexpr int I_A = 12 * 16, I_G = 12 * 16, I_M = 4 * 16, I_B = 3 * 4 * 8, I_O = 4 * 16, I_FI = 22 * 16, I_FO = 4 * 44;
    constexpr int I_LAYER = I_A + I_G + I_M + I_B + I_O + I_FI + I_FO;
    T_BEGIN();
    auto decode = [&](int it, TrItem& I) {
        const int l = it / I_LAYER; int r = it - l * I_LAYER;
        unsigned char* wl = F.ws + WS_W + (size_t)l * W_LAYER;
        if (r < I_A) { I = TrItem{A.in[I_WIN] + (size_t)l * DM * DIN, DIN, 1, r % 12, 64 * (r / 12), (bf16_t*)(wl + W_INA), DM, 0, A.in[I_NMIX] + l * DM}; return; } r -= I_A;
        if (r < I_G) { I = TrItem{A.in[I_WIN] + (size_t)l * DM * DIN, DIN, 2, r % 12, 64 * (r / 12), (bf16_t*)(wl + W_ING), DM, 0, A.in[I_NMIX] + l * DM}; return; } r -= I_G;
        if (r < I_M) { I = TrItem{A.in[I_WMKV] + (size_t)l * DM * 1024, 1024, 0, r & 3, 64 * (r >> 2), (bf16_t*)(wl + W_MKV), DM, 0, A.in[I_NMEM] + l * DM}; return; } r -= I_M;
        if (r < I_B) { const int j = r / 32, q = r % 32; I = TrItem{A.in[I_WBR] + ((size_t)l * 3 + j) * 512 * DM, DM, 0, q & 3, 64 * (q >> 2), (bf16_t*)(wl + W_BR), 1536, 512 * j, nullptr}; return; } r -= I_B;
        if (r < I_O) { I = TrItem{A.in[I_WOUT] + (size_t)l * DM * DM, DM, 0, r & 3, 64 * (r >> 2), (bf16_t*)(wl + W_OUT), DM, 0, nullptr}; return; } r -= I_O;
        if (r < I_FI) { I = TrItem{A.in[I_WFI] + (size_t)l * DM * 2 * DFF, 2 * DFF, 3, r % 22, 64 * (r / 22), (bf16_t*)(wl + W_FI), DM, 0, A.in[I_NFFN] + l * DM}; return; } r -= I_FI;
        I = TrItem{A.in[I_WFO] + (size_t)l * DFF * DM, DM, 0, r & 3, 64 * (r >> 2), (bf16_t*)(wl + W_FO), DFF, 0, nullptr};
    };
    if (F.bid < 2 * I_LAYER) {
        TrItem cur, nxt; f32x4 vc[8], vn[8];
        decode(F.bid, cur); tr_load(F, cur, vc);
#pragma unroll 1
        for (int it = F.bid; it < 2 * I_LAYER; it += F.G) {
            const int itn = it + F.G < 2 * I_LAYER ? it + F.G : it;
            decode(itn, nxt); tr_load(F, nxt, vn);
            tr_process(F, cur, vc);
            cur = nxt;
#pragma unroll
            for (int i = 0; i < 8; ++i) vc[i] = vn[i];
        }
    }
    T_END(5);
    const unsigned long long t_x0_ = (TSEC >= 0) ? __builtin_amdgcn_s_memrealtime() : 0ull;
    for (int m = gw; m < T + TMEM; m += 2 * NGW) {
        const int m2 = m + NGW; const bool has2 = m2 < T + TMEM;
        const bool ism = m >= T, ism2 = m2 >= T; const int r = ism ? m - T : m, r2 = ism2 ? m2 - T : m2;
        const f32x4* xr = (const f32x4*)((ism ? A.in[I_MEM] : A.in[I_X]) + (size_t)r * DM) + F.lane;
        const f32x4* xr2 = (const f32x4*)((ism2 ? A.in[I_MEM] : A.in[I_X]) + (size_t)r2 * DM) + F.lane;
        f32x4 v[4], v2[4];
#pragma unroll
        for (int j = 0; j < 4; ++j) v[j] = xr[64 * j];
        if (has2) {
#pragma unroll
            for (int j = 0; j < 4; ++j) v2[j] = xr2[64 * j];
        }
        {
            bf16_t* orow = (bf16_t*)(F.ws + (ism ? WS_MB : WS_XB)) + (size_t)r * DM; float s = 0.f;
#pragma unroll
            for (int j = 0; j < 4; ++j) { s += (v[j].x * v[j].x + v[j].y * v[j].y) + (v[j].z * v[j].z + v[j].w * v[j].w); u32x2 w; w.x = cvtpk(v[j].x, v[j].y); w.y = cvtpk(v[j].z, v[j].w); *(u32x2*)(orow + 256 * j + 4 * F.lane) = w; }
            s = wave_sum(s);
            if (F.lane == 0) ((float*)(F.ws + (ism ? WS_MSS : WS_SS)))[r] = s;
        }
        if (has2) {
            bf16_t* orow = (bf16_t*)(F.ws + (ism2 ? WS_MB : WS_XB)) + (size_t)r2 * DM; float s = 0.f;
#pragma unroll
            for (int j = 0; j < 4; ++j) { s += (v2[j].x * v2[j].x + v2[j].y * v2[j].y) + (v2[j].z * v2[j].z + v2[j].w * v2[j].w); u32x2 w; w.x = cvtpk(v2[j].x, v2[j].y); w.y = cvtpk(v2[j].z, v2[j].w); *(u32x2*)(orow + 256 * j + 4 * F.lane) = w; }
            s = wave_sum(s);
            if (F.lane == 0) ((float*)(F.ws + (ism2 ? WS_MSS : WS_SS)))[r2] = s;
        }
    }
    if (TSEC == 6 && F.bid == 0 && F.tid == 0) { unsigned* p_ = (unsigned*)(F.ws + WS_CTL) + 8192; *p_ += (unsigned)(__builtin_amdgcn_s_memrealtime() - t_x0_); }
    {
        for (int i = F.bid * 512 + F.tid; i < 2 * PAR_LAYER; i += F.G * 512) {
            const int l = i / PAR_LAYER, o = i % PAR_LAYER; float v = 0.f;
            if (o < 64) v = A.in[I_QNA][l * 64 + o] * A.in[I_KNA][l * 64 + o] * (0.125f * LOG2E);
            else if (o < 72) v = A.in[I_SINK][l * 8 + (o - 64)] * LOG2E;
            else if (o < 128) v = 0.f;
            else if (o < 256) v = A.in[I_QNM][l * 128 + (o - 128)] * A.in[I_KNM][l * 128 + (o - 128)] * (0.08838834764831845f * LOG2E);
            else if (o < 384) v = A.in[I_GLAG][l * 128 + (o - 256)];
            else if (o < 896) v = A.in[I_BDEC][l * 512 + (o - 384)];
            else v = A.in[I_WDU][l * 8192 + (o - 896)];
            ((float*)(F.ws + WS_PAR))[i] = v;
        }
    }
    {
        for (int i = F.bid * 512 + F.tid; i < 8 * 257; i += F.G * 512) {
            const int h = i / 257, rel = i % 257 - 128, n = rel < 0 ? -rel : rel;
            int bk = n < 8 ? n : (2 + (31 - __builtin_clz((unsigned)(n * n)))); if (bk > 15) bk = 15;
            if (rel > 0) bk += 16;
            ((float*)(F.ws + WS_BIAS))[i] = A.in[I_RELB][bk * 8 + h] * LOG2E;
        }
    }
}

struct WinQ { bf16x8 qf[4]; float m, l; f32x16 o0, o1; };
__device__ __forceinline__ float max3f_(float a, float b, float c) { return fmaxf(fmaxf(a, b), c); }
__device__ __forceinline__ void win_step(WinQ& q, const bf16x8 (&kf)[4], const bf16x8 (&vf)[2][2], const LAS float* bt, LAS float* wsf, int r32, int hi) {
    f32x16 s;
#pragma unroll
    for (int r = 0; r < 16; ++r) s[r] = bt[(r & 3) + 8 * (r >> 2)];
#pragma unroll
    for (int ds = 0; ds < 4; ++ds) s = MFMA32(kf[ds], q.qf[ds], s);
    float rm = max3f_(max3f_(s[0], s[1], s[2]), max3f_(s[3], s[4], s[5]), max3f_(s[6], s[7], s[8]));
    rm = max3f_(rm, max3f_(s[9], s[10], s[11]), max3f_(s[12], s[13], max3f_(s[14], s[15], -1e30f)));
    rm = swapmax(rm);
    if (__any(rm > q.m + 8.0f)) {
        const float mn = fmaxf(q.m, rm), alpha = ex2(q.m - mn); q.m = mn; q.l *= alpha;
        if (hi == 0) wsf[r32] = alpha;
        asm volatile("s_waitcnt lgkmcnt(0)" ::: "memory");
#pragma unroll
        for (int r = 0; r < 16; ++r) { const float a = wsf[crow(r, hi)]; q.o0[r] *= a; q.o1[r] *= a; }
    }
    float ps = 0.f;
#pragma unroll
    for (int r = 0; r < 16; ++r) { const float p = ex2(s[r] - q.m); s[r] = p; ps += p; }
    q.l += ps;
    const bf16x8 p0 = pack8(s, 0), p1 = pack8(s, 1);
    q.o0 = MFMA32(p0, vf[0][0], q.o0); q.o0 = MFMA32(p1, vf[0][1], q.o0);
    q.o1 = MFMA32(p0, vf[1][0], q.o1); q.o1 = MFMA32(p1, vf[1][1], q.o1);
}
struct WinKV { u32x4 k[6], v[6]; };
__device__ __forceinline__ void win_kv_addr(const Frame& F, int unit, int it, int tid, size_t& off) {
    const int b = unit >> 6, i = (unit >> 1) & 31, kvh = unit & 1; const int idx = tid + 512 * it, j = idx >> 3, ch = idx & 7;
    int kpos = 128 * i - 128 + j; kpos = min(max(kpos, 0), SEQ - 1); off = (size_t)(b * SEQ + kpos) * 128 + kvh * 64 + ch * 8;
}
__device__ __forceinline__ void win_k_load(const Frame& F, int unit, WinKV& P) {
#pragma unroll
    for (int it = 0; it < 6; ++it) { size_t off; win_kv_addr(F, unit, it, F.tid, off); P.k[it] = *(const u32x4*)((const bf16_t*)(F.ws + WS_KA) + off); }
}
__device__ __forceinline__ void win_v_load(const Frame& F, int unit, WinKV& P) {
#pragma unroll
    for (int it = 0; it < 6; ++it) { size_t off; win_kv_addr(F, unit, it, F.tid, off); P.v[it] = *(const u32x4*)((const bf16_t*)(F.ws + WS_VA) + off); }
}
__device__ __forceinline__ void winattn_unit(Frame& F, int l, int unit, bool dry, const WinKV& cur, bool has_next, int next_unit, WinKV& nxt) {
    const int b = unit >> 6, i = (unit >> 1) & 31, kvh = unit & 1;
    const int tid = opaque_v(F.tid), lane = tid & 63, r32 = lane & 31, hi = lane >> 5, w = F.wave;
    const bf16_t* KA = (const bf16_t*)(F.ws + WS_KA); const bf16_t* VA = (const bf16_t*)(F.ws + WS_VA); bf16_t* QA = (bf16_t*)(F.ws + WS_QA);
    LAS unsigned char* Kt = F.lds; LAS unsigned char* Vt = F.lds + 49152; LAS float* bias = (LAS float*)(F.lds + 98304);
    LAS float* wsf = (LAS float*)(F.lds + WSF_OFF) + w * 128;
    const int start = 128 * i;
    T_BEGIN();
    const int g = w >> 1, half = w & 1, h = kvh * 4 + g, qb0 = 2 * half;
    const float sink2 = par(F, l, PAR_SINK)[h];
    WinQ A, B;
    {
        const size_t qrow = (size_t)(b * SEQ + start + 32 * qb0 + r32);
#pragma unroll
        for (int ds = 0; ds < 4; ++ds) { A.qf[ds] = *(const bf16x8*)(QA + qrow * 512 + h * 64 + 16 * ds + 8 * hi); B.qf[ds] = *(const bf16x8*)(QA + (qrow + 32) * 512 + h * 64 + 16 * ds + 8 * hi); }
    }
    {
        for (int idx = tid; idx < 4 * 321; idx += 512) { const int g_ = idx / 321, rel = idx % 321 - 160;
            bias[idx] = (rel >= -128 && rel <= 128) ? ((const float*)(F.ws + WS_BIAS))[(kvh * 4 + g_) * 257 + rel + 128] : -1e30f; }
#pragma unroll
        for (int it = 0; it < 6; ++it) { const int idx = tid + 512 * it, j = idx >> 3, ch = idx & 7;
            *(LAS u32x4*)(Kt + j * 128 + ((ch ^ ((j >> 1) & 7)) << 4)) = cur.k[it];
            *(LAS u32x4*)(Vt + ((ch >> 2) * 24 + (j >> 4)) * 1024 + (j & 15) * 64 + (ch & 3) * 16) = cur.v[it]; }
    }
    asm volatile("s_waitcnt lgkmcnt(0)\n\ts_barrier" ::: "memory");
    T_END(3);
    const LAS float* bh = bias + g * 321;
    const int vlane = ((lane >> 4) & 1) * 32 + (lane & 3) * 8 + (4 * hi + ((lane & 15) >> 2)) * 64;
    A.m = sink2; B.m = sink2; A.l = (hi == 0) ? 1.0f : 0.0f; B.l = A.l; A.o0 = f32x16{}; A.o1 = f32x16{}; B.o0 = f32x16{}; B.o1 = f32x16{};
#pragma unroll 1
    for (int kt = qb0; kt <= qb0 + 9; ++kt) {
        const int kp0 = start - 128 + 32 * kt;
        if (kp0 + 31 < 0 || kp0 >= SEQ) continue;
        bf16x8 kf[4], vf[2][2];
#pragma unroll
        for (int ds = 0; ds < 4; ++ds) { const int kr = 32 * kt + r32, ch = 2 * ds + hi; kf[ds] = *(const LAS bf16x8*)(Kt + kr * 128 + ((ch ^ ((kr >> 1) & 7)) << 4)); }
#pragma unroll
        for (int d0 = 0; d0 < 2; ++d0) { const LAS char* vb = (const LAS char*)Vt + (d0 * 24 + 2 * kt) * 1024 + vlane;
            vf[d0][0] = mk8(vtr(vb), vtr(vb + 512)); vf[d0][1] = mk8(vtr(vb + 1024), vtr(vb + 1024 + 512)); }
        if (kt <= qb0 + 8) win_step(A, kf, vf, bh + (32 * (kt - qb0) + 32 - r32 + 4 * hi), wsf, r32, hi);
        if (kt >= qb0 + 1) win_step(B, kf, vf, bh + (32 * (kt - qb0 - 1) + 32 - r32 + 4 * hi), wsf + 32, r32, hi);
    }
    { const int nu = has_next ? next_unit : unit; win_k_load(F, nu, nxt); win_v_load(F, nu, nxt); }
    LAS bf16_t* stg = (LAS bf16_t*)(F.lds + 104448) + w * 2048;
#pragma unroll
    for (int qq = 0; qq < 2; ++qq) {
        WinQ& q = qq == 0 ? A : B;
        const float lt = swapsum(q.l);
        if (hi == 0) wsf[64 + r32] = __builtin_amdgcn_rcpf(lt);
        asm volatile("s_waitcnt lgkmcnt(0)" ::: "memory");
#pragma unroll
        for (int r = 0; r < 16; ++r) { const float rl = wsf[64 + crow(r, hi)]; const int orow = crow(r, hi);
            stg[orow * 64 + r32] = (bf16_t)(cvtpk(q.o0[r] * rl, 0.f) & 0xffffu); stg[orow * 64 + 32 + r32] = (bf16_t)(cvtpk(q.o1[r] * rl, 0.f) & 0xffffu); }
        asm volatile("s_waitcnt lgkmcnt(0)" ::: "memory");
        bf16_t* Ob = QA + (size_t)(b * SEQ + start + 32 * (qb0 + qq)) * 512 + h * 64;
#pragma unroll
        for (int k = 0; k < 4; ++k) { const int row = k * 8 + (lane >> 3), ch = lane & 7; const u32x4 v = *(const LAS u32x4*)(stg + row * 64 + ch * 8); if (!dry) *(u32x4*)(Ob + (size_t)row * 512 + ch * 8) = v; }
        asm volatile("s_waitcnt lgkmcnt(0)" ::: "memory");
    }
    asm volatile("s_waitcnt lgkmcnt(0)\n\ts_barrier" ::: "memory");
}

__device__ __forceinline__ void memattn_unit(Frame& F, int l, int unit, bool dry) {
    const int b = unit >> 5, h = (unit >> 3) & 3, rb = unit & 7;
    const int tid = opaque_v(F.tid), lane = tid & 63, r32 = lane & 31, hi = lane >> 5, w = F.wave;
    const bf16_t* KV = (const bf16_t*)(F.ws + WS_KVM) + (size_t)l * TMEM * 1024; bf16_t* QM = (bf16_t*)(F.ws + WS_QM);
    LAS unsigned char* Kt = F.lds; LAS unsigned char* Vt = F.lds + 65536;
    LAS float* wsf = (LAS float*)(F.lds + WSF_OFF) + w * 128;
    const float* gkm = par(F, l, PAR_GKM);
    T_BEGIN();
    bf16x8 qfr[2][8];
#pragma unroll
    for (int qq = 0; qq < 2; ++qq)
#pragma unroll
        for (int ds = 0; ds < 8; ++ds) qfr[qq][ds] = *(const bf16x8*)(QM + ((size_t)b * SEQ + rb * 512 + w * 64 + qq * 32 + r32) * 512 + h * 128 + 16 * ds + 8 * hi);
    {
        u32x4 kvr[8], vvr[8];
#pragma unroll
        for (int it = 0; it < 8; ++it) { const int idx = tid + 512 * it, j = idx >> 4, ch = idx & 15;
            const bf16_t* rp = KV + (size_t)(b * NMEM + j) * 1024 + h * 128 + ch * 8; kvr[it] = *(const u32x4*)rp; vvr[it] = *(const u32x4*)(rp + 512); }
#pragma unroll
        for (int it = 0; it < 8; ++it) { const int idx = tid + 512 * it, j = idx >> 4, ch = idx & 15;
            const u32x4 kv = kvr[it];
            float f[8] = {bflo(kv.x), bfhi(kv.x), bflo(kv.y), bfhi(kv.y), bflo(kv.z), bfhi(kv.z), bflo(kv.w), bfhi(kv.w)};
            float s = 0.f;
#pragma unroll
            for (int e = 0; e < 8; ++e) s += f[e] * f[e];
            s += __shfl_xor(s, 1); s += __shfl_xor(s, 2); s += __shfl_xor(s, 4); s += __shfl_xor(s, 8);
            const float rs = __builtin_amdgcn_rsqf(s * (1.0f / 128.0f) + EPS);
#pragma unroll
            for (int e = 0; e < 8; ++e) f[e] *= rs * gkm[ch * 8 + e];
            u32x4 ko; ko.x = cvtpk(f[0], f[1]); ko.y = cvtpk(f[2], f[3]); ko.z = cvtpk(f[4], f[5]); ko.w = cvtpk(f[6], f[7]);
            *(LAS u32x4*)(Kt + j * 256 + ((ch ^ (j & 15)) << 4)) = ko;
            *(LAS u32x4*)(Vt + ((ch >> 2) * 16 + (j >> 4)) * 1024 + (j & 15) * 64 + (ch & 3) * 16) = vvr[it]; }
    }
    asm volatile("s_waitcnt lgkmcnt(0)\n\ts_barrier" ::: "memory");
    T_END(10);
    const int vlane = ((lane >> 4) & 1) * 32 + (lane & 3) * 8 + (4 * hi + ((lane & 15) >> 2)) * 64;
    unsigned opk[2][4][8];
#pragma unroll
    for (int qq = 0; qq < 2; ++qq) {
        float qs = 0.f;
#pragma unroll
        for (int ds = 0; ds < 8; ++ds) { const u32x4 qv = __builtin_bit_cast(u32x4, qfr[qq][ds]);
            const float a0 = bflo(qv.x), a1 = bfhi(qv.x), a2 = bflo(qv.y), a3 = bfhi(qv.y), a4 = bflo(qv.z), a5 = bfhi(qv.z), a6 = bflo(qv.w), a7 = bfhi(qv.w);
            qs += (a0 * a0 + a1 * a1) + (a2 * a2 + a3 * a3) + (a4 * a4 + a5 * a5) + (a6 * a6 + a7 * a7); }
        qs = swapsum(qs);
        const float rq = __builtin_amdgcn_rsqf(qs * (1.0f / 128.0f) + EPS);
        bf16x8 qn[8];
#pragma unroll
        for (int ds = 0; ds < 8; ++ds) { const u32x4 qv = __builtin_bit_cast(u32x4, qfr[qq][ds]); u32x4 o4;
            o4.x = cvtpk(bflo(qv.x) * rq, bfhi(qv.x) * rq); o4.y = cvtpk(bflo(qv.y) * rq, bfhi(qv.y) * rq); o4.z = cvtpk(bflo(qv.z) * rq, bfhi(qv.z) * rq); o4.w = cvtpk(bflo(qv.w) * rq, bfhi(qv.w) * rq);
            qn[ds] = __builtin_bit_cast(bf16x8, o4); }
        float m = -1e30f, lsum = 0.f;
        f32x16 o[4]; o[0] = f32x16{}; o[1] = f32x16{}; o[2] = f32x16{}; o[3] = f32x16{};
#pragma unroll 1
        for (int kt = 0; kt < 8; ++kt) {
            f32x16 s = f32x16{};
#pragma unroll
            for (int ds = 0; ds < 8; ++ds) {
                const int kr = 32 * kt + r32, ch = 2 * ds + hi;
                const bf16x8 kf = *(const LAS bf16x8*)(Kt + kr * 256 + ((ch ^ (kr & 15)) << 4));
                s = MFMA32(kf, qn[ds], s);
            }
            float rm = max3f_(max3f_(s[0], s[1], s[2]), max3f_(s[3], s[4], s[5]), max3f_(s[6], s[7], s[8]));
            rm = max3f_(rm, max3f_(s[9], s[10], s[11]), max3f_(s[12], s[13], max3f_(s[14], s[15], -1e30f)));
            rm = swapmax(rm);
            if (__any(rm > m + 8.0f)) {
                const float mn = fmaxf(m, rm), alpha = ex2(m - mn); m = mn; lsum *= alpha;
                if (hi == 0) wsf[r32] = alpha;
                asm volatile("s_waitcnt lgkmcnt(0)" ::: "memory");
#pragma unroll
                for (int r = 0; r < 16; ++r) { const float a = wsf[crow(r, hi)]; o[0][r] *= a; o[1][r] *= a; o[2][r] *= a; o[3][r] *= a; }
            }
            float ps = 0.f;
#pragma unroll
            for (int r = 0; r < 16; ++r) { const float p = ex2(s[r] - m); s[r] = p; ps += p; }
            lsum += ps;
            const bf16x8 p0 = pack8(s, 0), p1 = pack8(s, 1);
#pragma unroll
            for (int d0 = 0; d0 < 4; ++d0) {
                const LAS char* vb = (const LAS char*)Vt + (d0 * 16 + 2 * kt) * 1024 + vlane;
                const bf16x8 v0 = mk8(vtr(vb), vtr(vb + 512)), v1 = mk8(vtr(vb + 1024), vtr(vb + 1024 + 512));
                o[d0] = MFMA32(p0, v0, o[d0]); o[d0] = MFMA32(p1, v1, o[d0]);
            }
        }
        lsum = swapsum(lsum);
        if (hi == 0) wsf[32 + r32] = __builtin_amdgcn_rcpf(lsum);
        asm volatile("s_waitcnt lgkmcnt(0)" ::: "memory");
#pragma unroll
        for (int i = 0; i < 8; ++i) { const float r0 = wsf[32 + crow(2 * i, hi)], r1 = wsf[32 + crow(2 * i + 1, hi)];
#pragma unroll
            for (int d0 = 0; d0 < 4; ++d0) opk[qq][d0][i] = cvtpk(o[d0][2 * i] * r0, o[d0][2 * i + 1] * r1); }
    }
    asm volatile("s_waitcnt lgkmcnt(0)\n\ts_barrier" ::: "memory");
    T_END(11);
    LAS bf16_t* stg = (LAS bf16_t*)(F.lds + w * 16384);
#pragma unroll
    for (int qq = 0; qq < 2; ++qq)
#pragma unroll
        for (int i = 0; i < 8; ++i)
#pragma unroll
            for (int d0 = 0; d0 < 4; ++d0) { const unsigned v = opk[qq][d0][i];
                stg[qq * 4096 + crow(2 * i, hi) * 128 + 32 * d0 + r32] = (bf16_t)(v & 0xffffu); stg[qq * 4096 + crow(2 * i + 1, hi) * 128 + 32 * d0 + r32] = (bf16_t)(v >> 16); }
    asm volatile("s_waitcnt lgkmcnt(0)" ::: "memory");
#pragma unroll
    for (int qq = 0; qq < 2; ++qq) {
        bf16_t* Ob = QM + ((size_t)b * SEQ + rb * 512 + w * 64 + qq * 32) * 512 + h * 128;
#pragma unroll
        for (int k = 0; k < 8; ++k) { const int c = k * 64 + lane, row = c >> 4, ch = c & 15; const u32x4 v = *(const LAS u32x4*)(stg + qq * 4096 + row * 128 + ch * 8); if (!dry) *(u32x4*)(Ob + (size_t)row * 512 + ch * 8) = v; }
    }
    asm volatile("s_waitcnt lgkmcnt(0)\n\ts_barrier" ::: "memory");
}

__device__ __forceinline__ void st_tile(unsigned* p, const f32x16& x, int lane) {
    u32x4 a, b; a.x = cvtpk(x[0], x[1]); a.y = cvtpk(x[2], x[3]); a.z = cvtpk(x[4], x[5]); a.w = cvtpk(x[6], x[7]);
    b.x = cvtpk(x[8], x[9]); b.y = cvtpk(x[10], x[11]); b.z = cvtpk(x[12], x[13]); b.w = cvtpk(x[14], x[15]);
    *(u32x4*)(p + lane * 4) = a; *(u32x4*)(p + 256 + lane * 4) = b;
}
__device__ __forceinline__ void st_nat(bf16_t* p, const f32x16& x, int r32, int hi) {
#pragma unroll
    for (int r = 0; r < 16; ++r) p[(size_t)crow(r, hi) * 512 + r32] = (bf16_t)(cvtpk(x[r], 0.f) & 0xffffu);
}
__device__ __forceinline__ void ld_tile_add(const unsigned* p, f32x16& x, int lane) {
#pragma unroll
    for (int i = 0; i < 8; ++i) { const unsigned w = p[i * 64 + lane]; x[2 * i] += bflo(w); x[2 * i + 1] += bfhi(w); }
}
__device__ __forceinline__ float dpp_f(float v, const int ctrl_sel) {
    const int iv = __builtin_bit_cast(int, v); int r;
    switch (ctrl_sel) { case 1: r = __builtin_amdgcn_update_dpp(0, iv, 0x111, 0xf, 0xf, true); break; case 2: r = __builtin_amdgcn_update_dpp(0, iv, 0x112, 0xf, 0xf, true); break;
                        case 4: r = __builtin_amdgcn_update_dpp(0, iv, 0x114, 0xf, 0xf, true); break; case 8: r = __builtin_amdgcn_update_dpp(0, iv, 0x118, 0xf, 0xf, true); break;
                        case 15: r = __builtin_amdgcn_update_dpp(0, iv, 0x142, 0xa, 0xf, false); break; default: r = __builtin_amdgcn_update_dpp(0, iv, 0x143, 0xc, 0xf, false); break; }
    return __builtin_bit_cast(float, r);
}
__device__ __forceinline__ float wave_prefix(float v, int lane) {
    (void)lane;
    v += dpp_f(v, 1); v += dpp_f(v, 2); v += dpp_f(v, 4); v += dpp_f(v, 8); v += dpp_f(v, 15); v += dpp_f(v, 31);
    return v;
}
struct IntraPre { u32x4 lr[4]; u32x4 q8, k8, v0, v1; };
__device__ __forceinline__ void gla_intra_load(const Frame& F, int unit, IntraPre& P) {
    const int b = unit >> 8, n = (unit >> 2) & 63, h = unit & 3, c = F.lane, w = F.wave;
    const size_t m0 = (size_t)b * SEQ + 64 * n;
    const u32x4* lp = (const u32x4*)((const bf16_t*)(F.ws + WS_LR) + (m0 + c) * 32);
#pragma unroll
    for (int q = 0; q < 4; ++q) P.lr[q] = lp[q];
    P.q8 = *(const u32x4*)((const bf16_t*)(F.ws + WS_QB) + (m0 + c) * 256 + h * 64 + 8 * w);
    P.k8 = *(const u32x4*)((const bf16_t*)(F.ws + WS_KB) + (m0 + c) * 256 + h * 64 + 8 * w);
    const bf16_t* VB = (const bf16_t*)(F.ws + WS_VB);
    { const int idx = F.tid, j = idx >> 4, ch = idx & 15; P.v0 = *(const u32x4*)(VB + (m0 + j) * 512 + h * 128 + ch * 8); }
    { const int idx = F.tid + 512, j = idx >> 4, ch = idx & 15; P.v1 = *(const u32x4*)(VB + (m0 + j) * 512 + h * 128 + ch * 8); }
}
__device__ __forceinline__ void gla_intra_unit(Frame& F, int l, int unit, const IntraPre& P) {
    const int b = unit >> 8, n = (unit >> 2) & 63, h = unit & 3;
    const int tid = F.tid, lane = F.lane, r32 = lane & 31, hi = lane >> 5, w = F.wave;
    const size_t m0 = (size_t)b * SEQ + 64 * n;
    bf16_t* QD = (bf16_t*)(F.ws + WS_QD);
    LAS unsigned char* L = F.lds;
    T_BEGIN();
    { const int idx = tid, j = idx >> 4, ch = idx & 15; *(LAS u32x4*)(L + 49152 + ((ch >> 2) * 4 + (j >> 4)) * 1024 + (j & 15) * 64 + (ch & 3) * 16) = P.v0; }
    { const int idx = tid + 512, j = idx >> 4, ch = idx & 15; *(LAS u32x4*)(L + 49152 + ((ch >> 2) * 4 + (j >> 4)) * 1024 + (j & 15) * 64 + (ch & 3) * 16) = P.v1; }
    {
        const int c = lane;
        float lrf[32];
#pragma unroll
        for (int q = 0; q < 4; ++q) { const u32x4 x = P.lr[q]; lrf[8 * q + 0] = bflo(x.x); lrf[8 * q + 1] = bfhi(x.x); lrf[8 * q + 2] = bflo(x.y); lrf[8 * q + 3] = bfhi(x.y); lrf[8 * q + 4] = bflo(x.z); lrf[8 * q + 5] = bfhi(x.z); lrf[8 * q + 6] = bflo(x.w); lrf[8 * q + 7] = bfhi(x.w); }
        const u32x4 q8 = P.q8, k8 = P.k8;
        const float qv[8] = {bflo(q8.x), bfhi(q8.x), bflo(q8.y), bfhi(q8.y), bflo(q8.z), bfhi(q8.z), bflo(q8.w), bfhi(q8.w)};
        const float kv[8] = {bflo(k8.x), bfhi(k8.x), bflo(k8.y), bfhi(k8.y), bflo(k8.z), bfhi(k8.z), bflo(k8.w), bfhi(k8.w)};
        const LAS float* WUl = (const LAS float*)(L + 65536) + 8 * w; const LAS float* BDl = (const LAS float*)(L + 73728) + 8 * w;
        float* DEC = (float*)(F.ws + WS_DEC) + (size_t)unit * 128;
#pragma unroll
        for (int dir = 0; dir < 2; ++dir) {
            float lg[8];
            { const f32x4 b0 = *(const LAS f32x4*)(BDl + dir * 64), b1 = *(const LAS f32x4*)(BDl + dir * 64 + 4);
              f32x2 l01 = {b0.x, b0.y}, l23 = {b0.z, b0.w}, l45 = {b1.x, b1.y}, l67 = {b1.z, b1.w};
#pragma unroll
              for (int r = 0; r < 16; ++r) {
                const f32x4 w0 = *(const LAS f32x4*)(WUl + (dir * 16 + r) * 64), w1 = *(const LAS f32x4*)(WUl + (dir * 16 + r) * 64 + 4);
                const float x = lrf[dir * 16 + r]; const f32x2 xx = {x, x};
                l01 = xx * (f32x2){w0.x, w0.y} + l01; l23 = xx * (f32x2){w0.z, w0.w} + l23; l45 = xx * (f32x2){w1.x, w1.y} + l45; l67 = xx * (f32x2){w1.z, w1.w} + l67;
              }
              lg[0] = l01.x; lg[1] = l01.y; lg[2] = l23.x; lg[3] = l23.y; lg[4] = l45.x; lg[5] = l45.y; lg[6] = l67.x; lg[7] = l67.y; }
            float qd[8], kd[8], ke[8], dc[8];
#pragma unroll
            for (int d = 0; d < 8; ++d) {
                const float tt = ex2(-fabsf(lg[d]) * LOG2E);
                const float la2 = (fminf(lg[d], 0.f) * LOG2E - __builtin_amdgcn_logf(1.0f + tt)) * (1.0f / 16.0f);
                const float pre = wave_prefix(la2, lane);
                const float tot = __builtin_bit_cast(float, __builtin_amdgcn_readlane(__builtin_bit_cast(int, pre), 63));
                const float bb = dir == 0 ? pre : (tot - pre + la2);
                const float e1 = ex2(bb), e2 = ex2(-bb), dct = ex2(tot);
                qd[d] = qv[d] * e1; kd[d] = kv[d] * e2; ke[d] = kd[d] * dct; dc[d] = dct;
            }
            if (lane == 0) { *(f32x4*)(DEC + dir * 64 + 8 * w) = (f32x4){dc[0], dc[1], dc[2], dc[3]}; *(f32x4*)(DEC + dir * 64 + 8 * w + 4) = (f32x4){dc[4], dc[5], dc[6], dc[7]}; }
            u32x4 a, bq, cq;
            a.x = cvtpk(qd[0], qd[1]); a.y = cvtpk(qd[2], qd[3]); a.z = cvtpk(qd[4], qd[5]); a.w = cvtpk(qd[6], qd[7]);
            bq.x = cvtpk(kd[0], kd[1]); bq.y = cvtpk(kd[2], kd[3]); bq.z = cvtpk(kd[4], kd[5]); bq.w = cvtpk(kd[6], kd[7]);
            cq.x = cvtpk(ke[0], ke[1]); cq.y = cvtpk(ke[2], ke[3]); cq.z = cvtpk(ke[4], ke[5]); cq.w = cvtpk(ke[6], ke[7]);
            { bf16_t* qp = QD + ((size_t)dir * T + m0 + c) * 256 + h * 64 + 16 * (w >> 1) + 4 * (w & 1);
              *(u32x2*)qp = (u32x2){a.x, a.y}; *(u32x2*)(qp + 8) = (u32x2){a.z, a.w}; }
            const int kso = c * 128 + ((w ^ ((c >> 1) & 7)) << 4);
            *(LAS u32x4*)(L + dir * 16384 + kso) = a;
            *(LAS u32x4*)(L + dir * 16384 + 8192 + kso) = bq;
            *(LAS u32x4*)(L + 32768 + dir * 8192 + ((w >> 2) * 4 + (c >> 4)) * 1024 + (c & 15) * 64 + (w & 3) * 16) = cq;
        }
    }
    asm volatile("s_waitcnt lgkmcnt(0)\n\ts_barrier" ::: "memory");
    T_END(12);
    const int vperm = ((lane >> 4) & 1) * 32 + (lane & 3) * 8 + (4 * hi + ((lane & 15) >> 2)) * 64;
    const int vnat = ((lane >> 4) & 1) * 32 + (lane & 3) * 8 + (8 * hi + ((lane & 15) >> 2)) * 64;
    {
        const int ct = w & 1, dvt = w >> 1;
        f32x16 o = f32x16{};
#pragma unroll
        for (int dir = 0; dir < 2; ++dir)
#pragma unroll
            for (int st = 0; st < 2; ++st) {
                if ((dir == 0 && st > ct) || (dir == 1 && st < ct)) continue;
                f32x16 x = f32x16{};
#pragma unroll
                for (int ds = 0; ds < 4; ++ds) {
                    const int sr = 32 * st + r32, cr = 32 * ct + r32, ch = 2 * ds + hi;
                    const bf16x8 kf = *(const LAS bf16x8*)(L + dir * 16384 + 8192 + sr * 128 + ((ch ^ ((sr >> 1) & 7)) << 4));
                    const bf16x8 qf = *(const LAS bf16x8*)(L + dir * 16384 + cr * 128 + ((ch ^ ((cr >> 1) & 7)) << 4));
                    x = MFMA32(kf, qf, x);
                }
                if (st == ct) {
#pragma unroll
                    for (int r = 0; r < 16; ++r) { const int s_ = crow(r, hi), c_ = r32; const bool keepv = dir == 0 ? (s_ <= c_) : (s_ > c_); if (!keepv) x[r] = 0.f; }
                }
                const bf16x8 p0 = pack8(x, 0), p1 = pack8(x, 1);
                const LAS char* vb = (const LAS char*)L + 49152 + (dvt * 4 + 2 * st) * 1024 + vperm;
                const bf16x8 v0 = mk8(vtr(vb), vtr(vb + 512)), v1 = mk8(vtr(vb + 1024), vtr(vb + 1024 + 512));
                o = MFMA32(p0, v0, o); o = MFMA32(p1, v1, o);
            }
        st_nat((bf16_t*)(F.ws + WS_OI) + (m0 + 32 * ct) * 512 + h * 128 + 32 * dvt, o, r32, hi);
    }
    {
        const int dkt = w & 1, dvt = w >> 1;
#pragma unroll
        for (int dir = 0; dir < 2; ++dir) {
            f32x16 u = f32x16{};
#pragma unroll
            for (int t = 0; t < 4; ++t) {
                const LAS char* ka = (const LAS char*)L + 32768 + dir * 8192 + (dkt * 4 + t) * 1024 + vnat;
                const LAS char* vb = (const LAS char*)L + 49152 + (dvt * 4 + t) * 1024 + vnat;
                const bf16x8 af = mk8(vtr(ka), vtr(ka + 256)), bfr = mk8(vtr(vb), vtr(vb + 256));
                u = MFMA32(af, bfr, u);
            }
            st_tile((unsigned*)(F.ws + WS_U) + (((size_t)unit * 2 + dir) * 8 + dkt * 4 + dvt) * 512, u, lane);
        }
    }
    asm volatile("s_waitcnt lgkmcnt(0)\n\ts_barrier" ::: "memory");
}
__device__ __forceinline__ void gla_intra_phase(Frame& F, int l) {
    int u = F.bid; if (u >= 2048) return;
    IntraPre cur, nxt; int hs = -1;
    gla_intra_load(F, u, cur);
#pragma unroll 1
    for (; u < 2048; u += F.G) {
        const int un = u + F.G; const bool hn = un < 2048;
        if (hn) gla_intra_load(F, un, nxt);
        const int h = u & 3;
        if (h != hs) {
            const float* wu = par(F, l, PAR_WDU); const float* bd = par(F, l, PAR_BDEC);
            for (int i = F.tid; i < 2048; i += 512) ((LAS float*)(F.lds + 65536))[i] = wu[(i >> 6) * 256 + h * 64 + (i & 63)];
            if (F.tid < 128) ((LAS float*)(F.lds + 73728))[F.tid] = bd[(F.tid >> 6) * 256 + h * 64 + (F.tid & 63)];
            hs = h;
            asm volatile("s_waitcnt lgkmcnt(0)\n\ts_barrier" ::: "memory");
        }
        { T_BEGIN(); gla_intra_unit(F, l, u, cur); T_END(2); }
        cur = nxt;
    }
}
constexpr int SC_NC = 2;
constexpr int SC_SLOT = 8192 + SC_NC * 4096, SC_NSLOT = 6, SC_DEPTH = 5, SC_DEC = SC_SLOT * SC_NSLOT, SC_STG = SC_DEC + 16384, SC_SPIN = 1 << 22, SC_NWG = 256 / SC_NC;
static_assert(SC_STG + SC_NC * 4096 <= MISC_OFF && 8 * (SC_DEPTH - 1) <= 63 && 4 * SC_NC * (SC_DEPTH - 1) <= 63, "scan LDS map / vmcnt range");
__device__ __forceinline__ unsigned lds_addr(const volatile LAS void* p) { return (unsigned)(size_t)p; }
__device__ __forceinline__ void lds_st_u32(unsigned addr, unsigned v) { asm volatile("ds_write_b32 %0, %1" : : "v"(addr), "v"(v) : "memory"); }
__device__ __forceinline__ unsigned lds_ld_u32(unsigned addr) { unsigned v; asm volatile("ds_read_b32 %0, %1\n\ts_waitcnt lgkmcnt(0)" : "=&v"(v) : "v"(addr) : "memory"); return v; }
__device__ __forceinline__ void glds16_asm(const void* gsrc, unsigned lds_dst) {
    unsigned keep;
    asm volatile("s_mov_b32 %0, m0\n\ts_mov_b32 m0, %2\n\ts_nop 0\n\tglobal_load_lds_dwordx4 %1, off\n\ts_mov_b32 m0, %0" : "=&s"(keep) : "v"(gsrc), "s"(lds_dst) : "memory");
}
__device__ __forceinline__ void wait_vm_dyn(int n) {
    switch (n) { case 32: asm volatile("s_waitcnt vmcnt(32)" ::: "memory"); break; case 24: asm volatile("s_waitcnt vmcnt(24)" ::: "memory"); break; case 16: asm volatile("s_waitcnt vmcnt(16)" ::: "memory"); break;
                 case 8: asm volatile("s_waitcnt vmcnt(8)" ::: "memory"); break; default: asm volatile("s_waitcnt vmcnt(0)" ::: "memory"); break; }
}
__device__ __forceinline__ void gla_scan_chain(Frame& F, int item) {
    const int chain = item / (4 / SC_NC), dv0 = (item % (4 / SC_NC)) * SC_NC;
    const int b = chain >> 3, h = (chain >> 1) & 3, dir = chain & 1;
    const int tid = F.tid, lane = F.lane, r32 = lane & 31, hi = lane >> 5, w = F.wave;
    volatile LAS unsigned* MISC = (volatile LAS unsigned*)(F.lds + MISC_OFF);
    const unsigned ldsb = lds_addr(F.lds);
    for (int i = tid; i < 4096; i += 512) { const int st = i >> 6, n = dir == 0 ? st : 63 - st;
        ((LAS float*)(F.lds + SC_DEC))[i] = ((const float*)(F.ws + WS_DEC))[(size_t)((b * 64 + n) * 4 + h) * 128 + dir * 64 + (i & 63)]; }
    if (tid < 8) MISC[16 + tid] = 0u;
    __syncthreads();
    if (w == 4 || w == 5) {
        const bool isq = (w == 4);
        const unsigned rdy = lds_addr(MISC + (isq ? 16 : 17)), dn = lds_addr(MISC + 18);
#pragma unroll 1
        for (int s = 0; s < 64 + SC_DEPTH - 1; ++s) {
            if (s < 64) {
                if (s >= SC_NSLOT) { int sp = 0;
                    for (;;) { int dmin = 1 << 30;
#pragma unroll
                        for (int k = 0; k < SC_NC; ++k) dmin = min(dmin, (int)__builtin_amdgcn_readfirstlane(lds_ld_u32(dn + 4 * k)));
                        if (dmin >= s - SC_NSLOT + 1 || ++sp >= SC_SPIN) break; __builtin_amdgcn_s_sleep(2); } }
                const int n = dir == 0 ? s : 63 - s;
                const size_t m0 = (size_t)b * SEQ + 64 * n;
                const unsigned slot = (unsigned)__builtin_amdgcn_readfirstlane(ldsb + (s % SC_NSLOT) * SC_SLOT);
                if (isq) {
                    const bf16_t* QD = (const bf16_t*)(F.ws + WS_QD) + ((size_t)dir * T + m0) * 256 + h * 64;
#pragma unroll
                    for (int p = 0; p < 8; ++p) { const int row = 8 * p + (lane >> 3), g = (lane & 7) ^ ((row >> 1) & 7);
                        glds16_asm(QD + (size_t)row * 256 + 8 * g, slot + p * 1024); }
                } else {
                    const unsigned* up = (const unsigned*)(F.ws + WS_U) + (((size_t)((b * 64 + n) * 4 + h) * 2 + dir) * 8 + dv0) * 512;
#pragma unroll
                    for (int p = 0; p < 4 * SC_NC; ++p) { const int k = p >> 2, q = p & 3; glds16_asm(up + (size_t)k * 512 + (q >> 1) * 2048 + (q & 1) * 256 + lane * 4, slot + 8192 + p * 1024); }
                }
            }
            const int pgrp = s - (SC_DEPTH - 1);
            if (pgrp >= 0) {
                const int younger = (s < 64 ? s : 63) - pgrp;
                wait_vm_dyn(younger * (isq ? 8 : 4 * SC_NC));
                if (lane == 0) lds_st_u32(rdy, (unsigned)(pgrp + 1));
            }
        }
    } else if (w < SC_NC) {
        const int dvt = dv0 + w;
        f32x16 S0 = f32x16{}, S1 = f32x16{};
        LAS bf16_t* stg = (LAS bf16_t*)(F.lds + SC_STG + w * 4096);
#pragma unroll 1
        for (int s = 0; s < 64; ++s) {
            { const unsigned long long tp0_ = (TSEC == 14) ? __builtin_amdgcn_s_memrealtime() : 0ull;
              int sp = 0; while (((int)MISC[16] <= s || (int)MISC[17] <= s) && ++sp < SC_SPIN) __builtin_amdgcn_s_sleep(1);
              if (TSEC == 14 && F.bid == 0 && tid == 0) { unsigned* p_ = (unsigned*)(F.ws + WS_CTL) + 8192; *p_ += (unsigned)(__builtin_amdgcn_s_memrealtime() - tp0_); } }
            asm volatile("" ::: "memory");
            const LAS unsigned char* slot = F.lds + (s % SC_NSLOT) * SC_SLOT;
            bf16x8 qa[2][4];
#pragma unroll
            for (int ct = 0; ct < 2; ++ct)
#pragma unroll
                for (int t = 0; t < 4; ++t) {
                    const int c = 32 * ct + r32, sw = (c >> 1) & 7;
                    qa[ct][t] = *(const LAS bf16x8*)(slot + c * 128 + (((2 * t + hi) ^ sw) << 4));
                }
            unsigned u0[8], u1[8];
            const LAS unsigned char* us = slot + 8192 + w * 4096;
            { const u32x4 a0 = *(const LAS u32x4*)(us + lane * 16), a1 = *(const LAS u32x4*)(us + 1024 + lane * 16), b0 = *(const LAS u32x4*)(us + 2048 + lane * 16), b1 = *(const LAS u32x4*)(us + 3072 + lane * 16);
              u0[0] = a0.x; u0[1] = a0.y; u0[2] = a0.z; u0[3] = a0.w; u0[4] = a1.x; u0[5] = a1.y; u0[6] = a1.z; u0[7] = a1.w;
              u1[0] = b0.x; u1[1] = b0.y; u1[2] = b0.z; u1[3] = b0.w; u1[4] = b1.x; u1[5] = b1.y; u1[6] = b1.z; u1[7] = b1.w; }
            const LAS float* dp = (const LAS float*)(F.lds + SC_DEC) + s * 64;
            f32x4 d0[4], d1[4];
#pragma unroll
            for (int q = 0; q < 4; ++q) { d0[q] = *(const LAS f32x4*)(dp + 8 * q + 4 * hi); d1[q] = *(const LAS f32x4*)(dp + 32 + 8 * q + 4 * hi); }
            const bf16x8 sb0 = pack8(S0, 0), sb1 = pack8(S0, 1), sb2 = pack8(S1, 0), sb3 = pack8(S1, 1);
            f32x16 oi[2];
#pragma unroll
            for (int ct = 0; ct < 2; ++ct) { f32x16 a = f32x16{}; a = MFMA32(qa[ct][0], sb0, a); a = MFMA32(qa[ct][1], sb1, a); a = MFMA32(qa[ct][2], sb2, a); a = MFMA32(qa[ct][3], sb3, a); oi[ct] = a; }
#pragma unroll
            for (int i = 0; i < 8; ++i) {
                S0[2 * i] = S0[2 * i] * d0[(2 * i) >> 2][(2 * i) & 3] + bflo(u0[i]); S0[2 * i + 1] = S0[2 * i + 1] * d0[(2 * i + 1) >> 2][(2 * i + 1) & 3] + bfhi(u0[i]);
                S1[2 * i] = S1[2 * i] * d1[(2 * i) >> 2][(2 * i) & 3] + bflo(u1[i]); S1[2 * i + 1] = S1[2 * i + 1] * d1[(2 * i + 1) >> 2][(2 * i + 1) & 3] + bfhi(u1[i]);
            }
            asm volatile("s_waitcnt lgkmcnt(0)" ::: "memory");
            if (lane == 0) MISC[18 + w] = (unsigned)(s + 1);
            const int n = dir == 0 ? s : 63 - s;
            bf16_t* op = (bf16_t*)(F.ws + WS_OT) + ((size_t)dir * T + (size_t)b * SEQ + 64 * n) * 512 + h * 128 + 32 * dvt;
#pragma unroll
            for (int ct = 0; ct < 2; ++ct)
#pragma unroll
                for (int r = 0; r < 16; ++r) stg[(32 * ct + crow(r, hi)) * 32 + r32] = (bf16_t)(cvtpk(oi[ct][r], 0.f) & 0xffffu);
            asm volatile("s_waitcnt lgkmcnt(0)" ::: "memory");
#pragma unroll
            for (int k = 0; k < 4; ++k) { const int cc = k * 64 + lane, row = cc >> 2, ch = cc & 3; const u32x4 v = *(const LAS u32x4*)(stg + row * 32 + ch * 8); *(u32x4*)(op + (size_t)row * 512 + ch * 8) = v; }
            asm volatile("s_waitcnt lgkmcnt(0)" ::: "memory");
        }
    }
    __syncthreads();
}
__device__ __forceinline__ void gla_final_stream(Frame& F, int l) {
    const u32x4* OI = (const u32x4*)(F.ws + WS_OI); const u32x4* OF = (const u32x4*)(F.ws + WS_OT); const u32x4* OBk = OF + (size_t)T * 512 / 8;
    const u32x4* OG = (const u32x4*)(F.ws + WS_OG); u32x4* OUT = (u32x4*)(F.ws + WS_OB);
    const float* gn = par(F, l, PAR_GLAG) + (F.tid & 15) * 8;
    const f32x4 g0 = *(const f32x4*)gn, g1 = *(const f32x4*)(gn + 4);
    const float gg[8] = {g0.x, g0.y, g0.z, g0.w, g1.x, g1.y, g1.z, g1.w};
    const int n16 = T * 512 / 8, stride = F.G * 512;
#pragma unroll 2
    for (int idx = F.bid * 512 + F.tid; idx < n16; idx += stride) {
        const u32x4 a = OI[idx], b = OF[idx], c = OBk[idx], g = OG[idx];
        float v[8] = {bflo(a.x) + bflo(b.x) + bflo(c.x), bfhi(a.x) + bfhi(b.x) + bfhi(c.x), bflo(a.y) + bflo(b.y) + bflo(c.y), bfhi(a.y) + bfhi(b.y) + bfhi(c.y),
                      bflo(a.z) + bflo(b.z) + bflo(c.z), bfhi(a.z) + bfhi(b.z) + bfhi(c.z), bflo(a.w) + bflo(b.w) + bflo(c.w), bfhi(a.w) + bfhi(b.w) + bfhi(c.w)};
        const float og[8] = {bflo(g.x), bfhi(g.x), bflo(g.y), bfhi(g.y), bflo(g.z), bfhi(g.z), bflo(g.w), bfhi(g.w)};
        float s = 0.f;
#pragma unroll
        for (int e = 0; e < 8; ++e) s += v[e] * v[e];
        s += __shfl_xor(s, 1); s += __shfl_xor(s, 2); s += __shfl_xor(s, 4); s += __shfl_xor(s, 8);
        const float rs = __builtin_amdgcn_rsqf(s * (1.0f / 128.0f) + EPS);
#pragma unroll
        for (int e = 0; e < 8; ++e) v[e] = v[e] * rs * gg[e] * og[e];
        u32x4 o; o.x = cvtpk(v[0], v[1]); o.y = cvtpk(v[2], v[3]); o.z = cvtpk(v[4], v[5]); o.w = cvtpk(v[6], v[7]);
        st16_wt(OUT + idx, o);
    }
}

__global__ void __launch_bounds__(512, 2) fwd_kernel(Args args) {
    extern __shared__ __attribute__((aligned(16))) unsigned char lds_raw[];
    Frame F;
    F.lds = (LAS unsigned char*)lds_raw; F.ws = args.ws; F.tid = threadIdx.x; F.lane = F.tid & 63; F.wave = __builtin_amdgcn_readfirstlane(F.tid >> 6);
    F.G = gridDim.x; F.bid = blockIdx.x; F.out = args.out;
    volatile LAS unsigned* MISC = (volatile LAS unsigned*)(F.lds + MISC_OFF);
    if (F.tid < 32) MISC[F.tid] = 0u;
    __syncthreads();
    const int lo = args.ph_lo, hi_ = args.ph_hi;
    XcdBarrier bar; bar.bar = (unsigned*)(F.ws + WS_CTL) + CW_BAR; bar.x = 0; bar.st = nullptr;
    if (hi_ - lo > 1) bar = xcd_barrier_post((unsigned*)(F.ws + WS_CTL) + CW_BAR, MISC + 8);
#ifndef PH_MASK
#define PH_MASK 0x1ff
#endif
#define IN(k) (lo <= (k) && (k) < hi_)
#define PM(j) ((PH_MASK >> (j)) & 1)
#define FRESH() do { F.tid = opaque_v(threadIdx.x); F.lane = F.tid & 63; F.wave = __builtin_amdgcn_readfirstlane(F.tid >> 6); } while (0)
#define SEAM(k) do { if (IN(k) && IN((k) + 1)) { const unsigned long long tb0_ = (TSEC >= 30 && TSEC <= 32) ? __builtin_amdgcn_s_memrealtime() : 0ull; xcd_barrier(bar); if ((TSEC == 30 && F.bid == 0 || TSEC == 31 && F.bid == 128 || TSEC == 32 && F.bid == 0 && ((k) == 0 ? 0 : (((k) - 1) & 7) + 1) == TPH) && threadIdx.x == 0) { unsigned* p_ = (unsigned*)(F.ws + WS_CTL) + 8192; __hip_atomic_fetch_add(p_, (unsigned)(__builtin_amdgcn_s_memrealtime() - tb0_), __ATOMIC_RELAXED, __HIP_MEMORY_SCOPE_AGENT); } } if (TSEC >= 20 && TSEC == 20 + ((k) == 0 ? 0 : (((k) - 1) & 7) + 1) && F.bid == 0 && threadIdx.x == 0) { unsigned* p_ = (unsigned*)(F.ws + WS_CTL) + 8192; *p_ += (unsigned)(__builtin_amdgcn_s_memrealtime() - tph0_); } } while (0)
    float* SSb = (float*)(F.ws + WS_SS);
    unsigned long long tph0_ = 0ull; (void)tph0_;
    unsigned* const TP = (unsigned*)(F.ws + WS_CTL) + 8192; (void)TP;

#define REPS(j) (((j) == PROBE_PHASE && hi_ - lo > 1) ? 1 + PROBE_REPS : 1)
#define PHASE_BEGIN(j) tph0_ = (TSEC == 20 + (j)) ? __builtin_amdgcn_s_memrealtime() : tph0_; for (int rep = 0; rep < REPS(j); ++rep) { const bool dry = rep + 1 < REPS(j); (void)dry; FRESH();
#define PHASE_END() if (dry) xcd_barrier(bar); }
    if (PM(0) && IN(0)) { PHASE_BEGIN(0) p0_prologue(F, args); PHASE_END() }
    SEAM(0);
#pragma unroll 1
    for (int l = 0; l < 2; ++l) {
        const int pb = 1 + 8 * l;
        unsigned char* wl = F.ws + WS_W + (size_t)l * W_LAYER;
        if (PM(1) && IN(pb + 0)) { PHASE_BEGIN(1)
            {
                pg8::Gemm g{(const bf16_t*)(F.ws + WS_XB), (const bf16_t*)(wl + W_INA), DM, DM, DM, TPH == 1 ? TP : nullptr};
                pg8::Sched S; S.init(T, 3072, 1, F.G, F.bid, 256 * DM * 2, 0, 256 * DM * 2, 0);
                EpiQKV E{F.ws, SSb + (size_t)(2 * l) * T, par(F, l, PAR_GKA)};
                pg8::gemm_phase<EpiQKV, true, true>(F.lds, g, S, E);
            }
            if (l == 0) {
                pg8::Gemm g{(const bf16_t*)(F.ws + WS_MB), (const bf16_t*)(F.ws + WS_W + W_MKV), DM, DM, DM, nullptr};
                pg8::Sched S; S.init(TMEM, 1024, 2, F.G, F.bid, 256 * DM * 2, 0, 256 * DM * 2, (unsigned)W_LAYER); S.subFast = false;
                EpiRowScale<0> E{(bf16_t*)(F.ws + WS_KVM), 1024, (size_t)TMEM * 1024, (const float*)(F.ws + WS_MSS)};
                pg8::gemm_phase<EpiRowScale<0>, true, true>(F.lds, g, S, E);
            }
        PHASE_END() }
        SEAM(pb + 0);
        if (PM(2) && IN(pb + 1)) { PHASE_BEGIN(2) gla_intra_phase(F, l);
            for (int u = F.bid; u < 256; u += F.G) { T_BEGIN(); memattn_unit(F, l, u, dry); T_END(1); }
        PHASE_END() }
        SEAM(pb + 1);
        if (PM(3) && IN(pb + 2)) { PHASE_BEGIN(3)
            if (F.G > SC_NWG + 8) {
                if (F.bid < SC_NWG) { T_BEGIN(); gla_scan_chain(F, F.bid); T_END(4); }
                else { const int nb = F.G - SC_NWG; int u = F.bid - SC_NWG;
                    if (u < 512) { WinKV cur, nxt; win_k_load(F, u, cur); win_v_load(F, u, cur);
#pragma unroll 1
                        for (; u < 512; u += nb) { const bool hn = u + nb < 512; winattn_unit(F, l, u, dry, cur, hn, u + nb, nxt); cur = nxt; } } }
            } else {
                for (int c = F.bid; c < SC_NWG; c += F.G) gla_scan_chain(F, c);
                for (int u = F.bid; u < 512; u += F.G) { WinKV cur, nxt; win_k_load(F, u, cur); win_v_load(F, u, cur); winattn_unit(F, l, u, dry, cur, false, u, nxt); }
            }
        PHASE_END() }
        SEAM(pb + 2);
        if (PM(4) && IN(pb + 3)) { PHASE_BEGIN(4)
            { T_BEGIN(); gla_final_stream(F, l); T_END(7); }
            asm volatile("s_waitcnt vmcnt(0)" ::: "memory"); __syncthreads();
            if (F.tid == 0) __hip_atomic_fetch_add((unsigned*)(F.ws + WS_CTL) + 8256 + 64 * l, 1u, __ATOMIC_RELAXED, __HIP_MEMORY_SCOPE_AGENT);
            pg8::Gemm g{(const bf16_t*)(F.ws + WS_XB), (const bf16_t*)(wl + W_ING), DM, DM, DM, TPH == 4 ? TP : nullptr};
            pg8::Sched S; S.init(T, 1024, 3, F.G, F.bid, 256 * DM * 2, 0, 256 * DM * 2, 1024 * DM * 2);
            EpiGate E{(u32x4*)(F.ws + WS_G), SSb + (size_t)(2 * l) * T, (unsigned*)(F.ws + WS_CTL) + 8256 + 64 * l, (hi_ - lo > 1) ? (unsigned)F.G : 0u, false};
            pg8::gemm_phase<EpiGate, true, true>(F.lds, g, S, E);
        PHASE_END() }
        SEAM(pb + 3);
        if (PM(5) && IN(pb + 4)) { PHASE_BEGIN(5)
            pg8::Gemm g{(const bf16_t*)(F.ws + WS_QA), (const bf16_t*)(wl + W_BR), 512, 1536, 512, TPH == 5 ? TP : nullptr};
            pg8::Sched S; S.init(T, 1024, 3, F.G, F.bid, 256 * 512 * 2, 32 * MiB, 256 * 1536 * 2, 512 * 2);
            EpiMerge E{(const u32x4*)(F.ws + WS_G), (bf16_t*)(F.ws + WS_MG)};
            pg8::gemm_phase<EpiMerge, true, true>(F.lds, g, S, E);
        PHASE_END() }
        SEAM(pb + 4);
        if (PM(6) && IN(pb + 5)) { PHASE_BEGIN(6)
            pg8::Gemm g{(const bf16_t*)(F.ws + WS_MG), (const bf16_t*)(wl + W_OUT), DM, DM, DM, TPH == 6 ? TP : nullptr};
            pg8::Sched S; S.init(T, 1024, 1, F.G, F.bid, 256 * DM * 2, 0, 256 * DM * 2, 0);
            EpiRes E{(bf16_t*)(F.ws + WS_XB), nullptr, SSb + (size_t)(2 * l + 1) * T, dry};
            pg8::gemm_phase<EpiRes, true, true>(F.lds, g, S, E);
        PHASE_END() }
        SEAM(pb + 5);
        if (PM(7) && IN(pb + 6)) { PHASE_BEGIN(7)
            pg8::Gemm g{(const bf16_t*)(F.ws + WS_XB), (const bf16_t*)(wl + W_FI), DM, DM, DM, TPH == 7 ? TP : nullptr};
            pg8::Sched S; S.init(T, 2 * DFF, 1, F.G, F.bid, 256 * DM * 2, 0, 256 * DM * 2, 0);
            EpiFFN E{(bf16_t*)(F.ws + WS_H), SSb + (size_t)(2 * l + 1) * T};
            pg8::gemm_phase<EpiFFN, true, true>(F.lds, g, S, E);
        PHASE_END() }
        SEAM(pb + 6);
        if (PM(8) && IN(pb + 7)) { PHASE_BEGIN(8)
            pg8::Gemm g{(const bf16_t*)(F.ws + WS_H), (const bf16_t*)(wl + W_FO), DFF, DFF, DFF, TPH == 8 ? TP : nullptr};
            pg8::Sched S; S.init(T, 1024, 1, F.G, F.bid, 256 * DFF * 2, 0, 256 * DFF * 2, 0);
            EpiRes E{(bf16_t*)(F.ws + WS_XB), l == 0 ? nullptr : F.out, SSb + (size_t)(2 * l + 2) * T, dry};
            pg8::gemm_phase<EpiRes, true, true>(F.lds, g, S, E);
        PHASE_END() }
        SEAM(pb + 7);
    }
    if (TSEC >= 0 && hi_ == NPH && F.bid == 0 && threadIdx.x == 0) {
        asm volatile("s_waitcnt vmcnt(0)" ::: "memory");
        const unsigned long long ticks = (unsigned long long)__hip_atomic_load((unsigned*)(F.ws + WS_CTL) + 8192, __ATOMIC_RELAXED, __HIP_MEMORY_SCOPE_AGENT) * TGAIN;
        const unsigned long long t0 = __builtin_amdgcn_s_memrealtime();
        while (__builtin_amdgcn_s_memrealtime() - t0 < ticks) __builtin_amdgcn_s_sleep(8);
    }
#undef IN
#undef SEAM
}

extern "C" void kernel_launch(void* const* d_in, const int* in_sizes, int n_in, void* d_out, int out_size, void* d_ws, size_t ws_size, hipStream_t stream) {
    static int grid = 0;
    if (grid == 0) {
        if (n_in != 20 || ws_size < WS_END) { fprintf(stderr, "kernel_launch: unexpected n_in %d / ws %zu\n", n_in, ws_size); grid = -1; return; }
        int dev = 0, cus = 0, per_cu = 0;
        if (hipGetDevice(&dev) != hipSuccess || hipDeviceGetAttribute(&cus, hipDeviceAttributeMultiprocessorCount, dev) != hipSuccess) { grid = -1; return; }
        if (hipFuncSetAttribute((const void*)fwd_kernel, hipFuncAttributeMaxDynamicSharedMemorySize, LDS_BYTES) != hipSuccess) { fprintf(stderr, "kernel_launch: hipFuncSetAttribute failed\n"); grid = -1; return; }
        if (hipOccupancyMaxActiveBlocksPerMultiprocessor(&per_cu, (const void*)fwd_kernel, 512, LDS_BYTES) != hipSuccess || per_cu < 1) { fprintf(stderr, "kernel_launch: occupancy query says %d blocks/CU\n", per_cu); per_cu = 1; }
        (void)hipGetLastError();
        grid = cus;
    }
    if (grid < 0) return;
    (void)hipMemsetAsync((char*)d_ws + WS_CTL, 0, 1 * MiB, stream);
    Args a{};
    for (int i = 0; i < 20; ++i) a.in[i] = (const float*)d_in[i];
    a.out = (float*)d_out; a.ws = (unsigned char*)d_ws;
#if MK_N_LAUNCHES == 1
    a.ph_lo = 0; a.ph_hi = NPH;
    hipLaunchKernelGGL(fwd_kernel, dim3(grid), dim3(512), LDS_BYTES, stream, a);
#else
    for (int p = 0; p < NPH; ++p) { a.ph_lo = p; a.ph_hi = p + 1; hipLaunchKernelGGL(fwd_kernel, dim3(grid), dim3(512), LDS_BYTES, stream, a); }
#endif
}
```

```cpp
#include <hip/hip_runtime.h>
#include <cstdio>
#include <cstdint>

#ifndef MK_N_LAUNCHES
#define MK_N_LAUNCHES 1
#endif

#ifndef PROBE_PHASE
#define PROBE_PHASE -1
#define PROBE_REPS 0
#endif
#ifndef TSEC
#define P2_STAGGER 1
#define WIN_WARM 1
#define FUSE_GATE_MERGE 1
#define TSEC -1
#define TGAIN 4
#endif
#ifndef TPH
#define TPH -1
#endif
#define LAS __attribute__((address_space(3)))
#define GAS __attribute__((address_space(1)))
typedef unsigned short bf16_t;
typedef short bf16x8 __attribute__((ext_vector_type(8)));
typedef short s16x4 __attribute__((ext_vector_type(4)));
typedef short v4i16_t __attribute__((ext_vector_type(4)));
typedef float f32x2 __attribute__((ext_vector_type(2)));
typedef float f32x4 __attribute__((ext_vector_type(4)));
typedef float f32x16 __attribute__((ext_vector_type(16)));
typedef unsigned u32x2 __attribute__((ext_vector_type(2)));
typedef unsigned u32x4 __attribute__((ext_vector_type(4)));
typedef __bf16 bf16x2_t __attribute__((ext_vector_type(2)));

constexpr int DM = 1024, BATCH = 8, SEQ = 4096, T = BATCH * SEQ, NMEM = 256, TMEM = BATCH * NMEM;
constexpr int DFF = 2816, DIN = 5920;
constexpr float EPS = 1e-6f, LOG2E = 1.4426950408889634f;
constexpr int NPH = 17;

constexpr size_t MiB = 1u << 20;
constexpr size_t WS_CTL = 0;
constexpr size_t WS_SS = 512 * 1024;
constexpr size_t WS_MSS = 1 * MiB;
constexpr size_t WS_BIAS = 1 * MiB + 64 * 1024;
constexpr size_t WS_PAR = 1 * MiB + 128 * 1024;
constexpr int PAR_GKA = 0, PAR_SINK = 64, PAR_MREF = 72, PAR_MREFM = 80, PAR_GKM = 128, PAR_GLAG = 256, PAR_BDEC = 384, PAR_WDU = 896, PAR_LAYER = 896 + 8192;
constexpr size_t WS_DEC = 2 * MiB;
constexpr size_t WS_KVM = 3 * MiB;
constexpr size_t WS_MB = 11 * MiB;
constexpr size_t WS_W = 16 * MiB;
constexpr size_t W_INA = 0, W_ING = 6 * MiB, W_MKV = 12 * MiB, W_BR = 14 * MiB, W_OUT = 17 * MiB, W_FI = 19 * MiB, W_FO = 30 * MiB, W_LAYER = 35 * MiB + 512 * 1024;
constexpr size_t WS_XB = 88 * MiB;
constexpr size_t WS_QA = 152 * MiB;
constexpr size_t WS_OB = 184 * MiB;
constexpr size_t WS_QM = 216 * MiB;
constexpr size_t WS_KA = 248 * MiB, WS_VA = 256 * MiB;
constexpr size_t WS_QB = 264 * MiB, WS_KB = 280 * MiB;
constexpr size_t WS_VB = 296 * MiB, WS_OG = 328 * MiB;
constexpr size_t WS_LR = 360 * MiB;
constexpr size_t WS_QD = 362 * MiB;
constexpr size_t WS_U = 394 * MiB;
constexpr size_t WS_OI = 458 * MiB;
constexpr size_t WS_OT = 264 * MiB;
constexpr size_t WS_G = 248 * MiB;
constexpr size_t WS_MG = 440 * MiB;
constexpr size_t WS_H = 248 * MiB;
constexpr size_t WS_END = 512 * MiB;
static_assert(WS_OI + 32 * MiB <= WS_END && WS_MG + 64 * MiB <= WS_END && WS_W + 2 * W_LAYER <= WS_XB && WS_G + 192 * MiB <= WS_MG && WS_H + 176 * MiB <= WS_END, "ws map");

constexpr int CW_BAR = 4096;

constexpr int RING_BYTES = 131072;
constexpr int MISC_OFF = 155648;
constexpr int WSF_OFF = 156672;
constexpr int LDS_BYTES = 163840;

__device__ __forceinline__ unsigned cvtpk(float lo, float hi) { f32x2 v = {lo, hi}; bf16x2_t b = __builtin_convertvector(v, bf16x2_t); return __builtin_bit_cast(unsigned, b); }
__device__ __forceinline__ float bflo(unsigned w) { return __uint_as_float(w << 16); }
__device__ __forceinline__ float bfhi(unsigned w) { return __uint_as_float(w & 0xffff0000u); }
__device__ __forceinline__ float ex2(float x) { return __builtin_amdgcn_exp2f(x); }
__device__ __forceinline__ float sigmoidf_(float x) { return __builtin_amdgcn_rcpf(1.0f + ex2(-x * LOG2E)); }
__device__ __forceinline__ float siluf_(float x) { return x * sigmoidf_(x); }
__device__ __forceinline__ int crow(int r, int hi) { return (r & 3) + 8 * (r >> 2) + 4 * hi; }
__device__ __forceinline__ float swapmax(float v) { auto rr = __builtin_amdgcn_permlane32_swap(__float_as_uint(v), __float_as_uint(v), false, false); return fmaxf(__uint_as_float(rr[0]), __uint_as_float(rr[1])); }
__device__ __forceinline__ float swapsum(float v) { auto rr = __builtin_amdgcn_permlane32_swap(__float_as_uint(v), __float_as_uint(v), false, false); return __uint_as_float(rr[0]) + __uint_as_float(rr[1]); }
__device__ __forceinline__ float xsum16(float v) { auto rr = __builtin_amdgcn_permlane16_swap(__float_as_uint(v), __float_as_uint(v), false, false); return __uint_as_float(rr[0]) + __uint_as_float(rr[1]); }
__device__ __forceinline__ float dppx(float v, const int sel) {
    const int iv = __builtin_bit_cast(int, v); int r;
    switch (sel) { case 0: r = __builtin_amdgcn_update_dpp(0, iv, 0xB1, 0xf, 0xf, false); break;
                   case 1: r = __builtin_amdgcn_update_dpp(0, iv, 0x4E, 0xf, 0xf, false); break;
                   case 2: r = __builtin_amdgcn_update_dpp(0, iv, 0x141, 0xf, 0xf, false); break;
                   default: r = __builtin_amdgcn_update_dpp(0, iv, 0x140, 0xf, 0xf, false); break; }
    return __builtin_bit_cast(float, r);
}
__device__ __forceinline__ float rowsum16(float v) { v += dppx(v, 0); v += dppx(v, 1); v += dppx(v, 2); v += dppx(v, 3); return v; }
__device__ __forceinline__ s16x4 vtr(const LAS char* p) { return __builtin_bit_cast(s16x4, __builtin_amdgcn_ds_read_tr16_b64_v4i16((LAS v4i16_t*)p)); }
#define MFMA32(a, b, c) __builtin_amdgcn_mfma_f32_32x32x16_bf16((a), (b), (c), 0, 0, 0)
__device__ __forceinline__ bf16x8 pack8(const f32x16& x, int s) {
    u32x4 p; p.x = cvtpk(x[8 * s], x[8 * s + 1]); p.y = cvtpk(x[8 * s + 2], x[8 * s + 3]); p.z = cvtpk(x[8 * s + 4], x[8 * s + 5]); p.w = cvtpk(x[8 * s + 6], x[8 * s + 7]);
    return __builtin_bit_cast(bf16x8, p);
}
__device__ __forceinline__ bf16x8 mk8(s16x4 lo, s16x4 hi) { return (bf16x8){lo[0], lo[1], lo[2], lo[3], hi[0], hi[1], hi[2], hi[3]}; }

__device__ __forceinline__ int opaque_v(int v) { asm volatile("" : "+v"(v)); return v; }
namespace pg8 {
constexpr int BM = 256, BK = 64, HALF = 128, HTB = HALF * BK * 2, NXCD = 8, WGM = 4;
__host__ __device__ __forceinline__ int lds_byte(int r, int c) { const int st = (r >> 4) * 2 + (c >> 5), rr = r & 15, cc = c & 31, ob = rr * 64 + cc * 2; return st * 1024 + (ob ^ (((ob >> 9) & 1) << 5)); }
__host__ __device__ __forceinline__ void stage_rc(int b, int& R, int& C) { const int st = b / 1024, sb = b % 1024, swz = sb ^ (((sb >> 9) & 1) << 5); R = (st >> 1) * 16 + swz / 64; C = (st & 1) * 32 + (swz % 64) / 2; }
__host__ __device__ __forceinline__ int perm32(int rho) { const int n = rho >> 4, i = rho & 15; return 8 * (i >> 2) + 4 * n + (i & 3); }

struct Unit { int pm, pn, sub; unsigned aoff, boff; };
struct Gemm { const bf16_t* A; const bf16_t* Bt; int lda, ldb, K; unsigned* tp; };

struct Sched {
    int nM, nN, nSub, nwg, G, c; unsigned a_pm, a_sub, b_pn, b_sub; bool subFast;
    __device__ void init(int M, int N, int nSub_, int G_, int c_, unsigned a_pm_, unsigned a_sub_, unsigned b_pn_, unsigned b_sub_) {
        nM = M / BM; nN = N / BM; nSub = nSub_; nwg = nM * nN; G = G_; c = c_; a_pm = a_pm_; a_sub = a_sub_; b_pn = b_pn_; b_sub = b_sub_; subFast = true; }
    __device__ bool next(int i, Unit& u) const {
        int round, sub; long L;
        if (subFast) { round = i / nSub; sub = i - round * nSub; L = (long)round * G + c; if (L >= nwg) return false; }
        else { const long LL = (long)i * G + c; if (LL >= (long)nwg * nSub) return false; sub = (int)(LL / nwg); L = LL - (long)sub * nwg; }
        int wgid = (int)L; { const int q = nwg / NXCD, r = nwg % NXCD, xcd = wgid % NXCD, off = wgid / NXCD; wgid = (xcd < r ? xcd * (q + 1) : r * (q + 1) + (xcd - r) * q) + off; }
        const int nig = WGM * nN, gid = wgid / nig, fm = gid * WGM, gsz = (nM - fm) < WGM ? (nM - fm) : WGM;
        u.pm = fm + ((wgid % nig) % gsz); u.pn = (wgid % nig) / gsz; u.sub = sub;
        u.aoff = (unsigned)u.pm * a_pm + (unsigned)sub * a_sub; u.boff = (unsigned)u.pn * b_pn + (unsigned)sub * b_sub; return true;
    }
};

template <class Epi, bool ALIGN_EPI, bool SP2>
__device__ __forceinline__ void gemm_phase(LAS unsigned char* lds, const Gemm g, const Sched& S, const Epi& E) {
    const int tid = opaque_v(threadIdx.x), wid = __builtin_amdgcn_readfirstlane(tid >> 6), lane = tid & 63, wr = wid >> 2, wc = wid & 3, fr = lane & 15, fq = lane >> 4;
    const int K = g.K, nt = K / BK;
    unsigned voffA[2], voffB[2];
#pragma unroll
    for (int i = 0; i < 2; ++i) { int R, C; stage_rc(tid * 16 + i * 8192, R, C); const int Rb = (R & ~31) + perm32(R & 31);
        voffA[i] = (unsigned)(R * g.lda + C) * 2u; voffB[i] = (unsigned)(Rb * g.ldb + C) * 2u; }
    const size_t kstep = (size_t)(BK * 2);
    const size_t hstepA = (size_t)HALF * g.lda * 2, hstepB = (size_t)HALF * g.ldb * 2;
    const unsigned ldsw = (unsigned)wid * 1024u;
    const int aoff = lds_byte(wr * 64 + fr, fq * 8), boff = lds_byte(wc * 32 + fr, fq * 8);
#define PG8_SA(b, h) (((b) * 2 + (h)) * HTB)
#define PG8_SB(b, h) ((4 + (b) * 2 + (h)) * HTB)
#define PG8_STAGE(bufoff, gbase, voff) do { _Pragma("unroll") for (int _i = 0; _i < 2; ++_i) \
        __builtin_amdgcn_global_load_lds((const unsigned*)((const char*)(gbase) + (voff)[_i]), (LAS unsigned*)(lds + (bufoff) + ldsw + _i * 8192), 16, 0, 0); } while (0)
#define PG8_LDA(dst, b, h) do { _Pragma("unroll") for (int m = 0; m < 4; ++m) _Pragma("unroll") for (int k = 0; k < 2; ++k) dst[m][k] = *(const LAS bf16x8*)(lds + PG8_SA(b, h) + aoff + m * 2048 + k * 1024); } while (0)
#define PG8_LDB(dst, b, h) do { _Pragma("unroll") for (int n = 0; n < 2; ++n) _Pragma("unroll") for (int k = 0; k < 2; ++k) dst[n][k] = *(const LAS bf16x8*)(lds + PG8_SB(b, h) + boff + n * 2048 + k * 1024); } while (0)
#define PG8_MMA(ai, bj, At, Bt) do { __builtin_amdgcn_s_setprio(1); _Pragma("unroll") for (int m = 0; m < 4; ++m) _Pragma("unroll") for (int n = 0; n < 2; ++n) _Pragma("unroll") for (int k = 0; k < 2; ++k) \
        acc[ai][bj][m][n] = __builtin_amdgcn_mfma_f32_16x16x32_bf16(Bt[n][k], At[m][k], acc[ai][bj][m][n], 0, 0, 0); __builtin_amdgcn_s_setprio(0); } while (0)
#define PG8_WAIT_V(n) asm volatile("s_waitcnt vmcnt(" #n ")" ::: "memory")
#define PG8_WAIT_L(n) asm volatile("s_waitcnt lgkmcnt(" #n ")" ::: "memory")
#define PG8_BAR __builtin_amdgcn_s_barrier()
#define PG8_SCHED __builtin_amdgcn_sched_barrier(0)
    Unit cur, nxt; int ui = 0;
    if (!S.next(0, cur)) return;
    f32x4 acc[2][2][4][2];
#pragma unroll
    for (int a = 0; a < 2; ++a)
#pragma unroll
        for (int b = 0; b < 2; ++b)
#pragma unroll
            for (int m = 0; m < 4; ++m)
#pragma unroll
                for (int n = 0; n < 2; ++n) acc[a][b][m][n] = (f32x4){0.f, 0.f, 0.f, 0.f};
    bf16x8 At[4][2], B0[2][2], B1[2][2];
    const char* cA = (const char*)g.A + cur.aoff; const char* cB = (const char*)g.Bt + cur.boff;
    if constexpr (SP2) {
        PG8_STAGE(PG8_SB(0, 0), cB, voffB); PG8_STAGE(PG8_SB(0, 1), cB + hstepB, voffB); PG8_STAGE(PG8_SA(0, 0), cA, voffA); PG8_STAGE(PG8_SA(0, 1), cA + hstepA, voffA);
        if (wr == 1) PG8_BAR;
        PG8_WAIT_V(2); PG8_BAR;
        PG8_STAGE(PG8_SB(1, 0), cB + kstep, voffB); PG8_STAGE(PG8_SA(1, 0), cA + kstep, voffA); PG8_STAGE(PG8_SB(1, 1), cB + hstepB + kstep, voffB);
        PG8_WAIT_V(6); PG8_BAR;
    } else {
        PG8_STAGE(PG8_SB(0, 0), cB, voffB); PG8_STAGE(PG8_SA(0, 0), cA, voffA); PG8_STAGE(PG8_SB(0, 1), cB + hstepB, voffB); PG8_STAGE(PG8_SA(0, 1), cA + hstepA, voffA);
        if (wr == 1) PG8_BAR;
        PG8_WAIT_V(4); PG8_BAR;
        PG8_STAGE(PG8_SB(1, 0), cB + kstep, voffB); PG8_STAGE(PG8_SA(1, 0), cA + kstep, voffA); PG8_STAGE(PG8_SB(1, 1), cB + hstepB + kstep, voffB);
        PG8_WAIT_V(6); PG8_BAR;
    }
    for (;;) {
        const bool has_next = S.next(ui + 1, nxt);
        const char* nA = has_next ? (const char*)g.A + nxt.aoff : cA; const char* nB = has_next ? (const char*)g.Bt + nxt.boff : cB;
        const unsigned long long tk0_ = (TSEC == 9) ? __builtin_amdgcn_s_memrealtime() : ((TSEC == 13) ? __builtin_amdgcn_s_memtime() : 0ull);
        for (int t = 0; t < nt; t += 2) {
            const bool last = (t == nt - 2);
            const char* a1 = cA + (size_t)(t + 1) * kstep;
            const char* a2 = last ? nA : cA + (size_t)(t + 2) * kstep; const char* b2 = last ? nB : cB + (size_t)(t + 2) * kstep;
            const char* a3 = a2 + kstep; const char* b3 = b2 + kstep;
            if constexpr (SP2) {
            PG8_LDB(B0, 0, 0); PG8_LDB(B1, 0, 1); PG8_SCHED; PG8_LDA(At, 0, 0); PG8_STAGE(PG8_SA(1, 1), a1 + hstepA, voffA);
            PG8_WAIT_V(8); PG8_WAIT_L(0); PG8_BAR; PG8_MMA(0, 0, At, B0); PG8_MMA(0, 1, At, B1); PG8_BAR; PG8_SCHED;
            PG8_LDA(At, 0, 1); PG8_STAGE(PG8_SB(0, 0), b2, voffB); PG8_STAGE(PG8_SB(0, 1), b2 + hstepB, voffB); PG8_STAGE(PG8_SA(0, 0), a2, voffA);
            PG8_WAIT_V(8); PG8_WAIT_L(0); PG8_BAR; PG8_MMA(1, 0, At, B0); PG8_MMA(1, 1, At, B1); PG8_BAR; PG8_SCHED;
            PG8_LDB(B0, 1, 0); PG8_LDB(B1, 1, 1); PG8_SCHED; PG8_LDA(At, 1, 0); PG8_STAGE(PG8_SA(0, 1), a2 + hstepA, voffA);
            PG8_WAIT_V(8); PG8_WAIT_L(0); PG8_BAR; PG8_MMA(0, 0, At, B0); PG8_MMA(0, 1, At, B1); PG8_BAR; PG8_SCHED;
            PG8_LDA(At, 1, 1); PG8_STAGE(PG8_SB(1, 0), b3, voffB); PG8_STAGE(PG8_SB(1, 1), b3 + hstepB, voffB); PG8_STAGE(PG8_SA(1, 0), a3, voffA);
            PG8_WAIT_V(8); PG8_WAIT_L(0); PG8_BAR; PG8_MMA(1, 0, At, B0); PG8_MMA(1, 1, At, B1); PG8_BAR; PG8_SCHED;
            } else {
            PG8_LDB(B0, 0, 0); PG8_SCHED; PG8_LDA(At, 0, 0); PG8_STAGE(PG8_SA(1, 1), a1 + hstepA, voffA);
            PG8_WAIT_L(8); PG8_BAR; PG8_WAIT_L(0); PG8_MMA(0, 0, At, B0); PG8_BAR; PG8_SCHED;
            PG8_LDB(B1, 0, 1); PG8_STAGE(PG8_SB(0, 0), b2, voffB);
            PG8_BAR; PG8_WAIT_L(0); PG8_MMA(0, 1, At, B1); PG8_BAR;
            PG8_LDA(At, 0, 1); PG8_STAGE(PG8_SA(0, 0), a2, voffA);
            PG8_BAR; PG8_WAIT_L(0); PG8_MMA(1, 0, At, B0); PG8_BAR; PG8_SCHED;
            PG8_STAGE(PG8_SB(0, 1), b2 + hstepB, voffB);
            PG8_WAIT_V(6); PG8_BAR; PG8_MMA(1, 1, At, B1); PG8_BAR;
            PG8_LDB(B0, 1, 0); PG8_SCHED; PG8_LDA(At, 1, 0); PG8_STAGE(PG8_SA(0, 1), a2 + hstepA, voffA);
            PG8_WAIT_L(8); PG8_BAR; PG8_WAIT_L(0); PG8_MMA(0, 0, At, B0); PG8_BAR; PG8_SCHED;
            PG8_LDB(B1, 1, 1); PG8_STAGE(PG8_SB(1, 0), b3, voffB);
            PG8_BAR; PG8_WAIT_L(0); PG8_MMA(0, 1, At, B1); PG8_BAR;
            PG8_LDA(At, 1, 1); PG8_STAGE(PG8_SA(1, 0), a3, voffA);
            PG8_BAR; PG8_WAIT_L(0); PG8_MMA(1, 0, At, B0); PG8_BAR; PG8_SCHED;
            PG8_STAGE(PG8_SB(1, 1), b3 + hstepB, voffB);
            PG8_WAIT_V(6); PG8_BAR; PG8_MMA(1, 1, At, B1); PG8_BAR;
            }
        }
        if ((TSEC == 9 || TSEC == 13) && g.tp && tid == 0 && blockIdx.x == 0) { const unsigned long long d_ = ((TSEC == 9) ? __builtin_amdgcn_s_memrealtime() : __builtin_amdgcn_s_memtime()) - tk0_; *g.tp += (unsigned)((TSEC == 9) ? d_ : (d_ >> 5)); }
        if constexpr (ALIGN_EPI) { if (wr == 0) PG8_BAR; }
        const unsigned long long te0_ = (TSEC == 8) ? __builtin_amdgcn_s_memrealtime() : 0ull;
        const bool keep = E(acc, cur, wr, wc, fr, fq);
        if (TSEC == 8 && g.tp && tid == 0 && blockIdx.x == 0) { asm volatile("s_waitcnt vmcnt(0)" ::: "memory"); *g.tp += (unsigned)(__builtin_amdgcn_s_memrealtime() - te0_); }
        if (!has_next) break;
        if (!keep) {
#pragma unroll
        for (int a = 0; a < 2; ++a)
#pragma unroll
            for (int b = 0; b < 2; ++b)
#pragma unroll
                for (int m = 0; m < 4; ++m)
#pragma unroll
                    for (int n = 0; n < 2; ++n) acc[a][b][m][n] = (f32x4){0.f, 0.f, 0.f, 0.f};
        }
        cur = nxt; cA = nA; cB = nB; ++ui;
        if constexpr (ALIGN_EPI) { if (wr == 1) PG8_BAR; }
    }
    PG8_WAIT_V(0);
    if constexpr (!ALIGN_EPI) { if (wr == 0) PG8_BAR; }
    PG8_BAR;
#undef PG8_SA
#undef PG8_SB
#undef PG8_STAGE
#undef PG8_LDA
#undef PG8_LDB
#undef PG8_MMA
#undef PG8_WAIT_V
#undef PG8_WAIT_L
#undef PG8_BAR
#undef PG8_SCHED
}
}
typedef f32x4 Acc[2][2][4][2];
using pg8::Unit;

__device__ __forceinline__ void st16_wt(void* p, const u32x4 w) { *(u32x4*)p = w; }
__device__ __forceinline__ void st8(bf16_t* p, const f32x4 a, const f32x4 b) { u32x4 w; w.x = cvtpk(a[0], a[1]); w.y = cvtpk(a[2], a[3]); w.z = cvtpk(b[0], b[1]); w.w = cvtpk(b[2], b[3]); st16_wt(p, w); }

struct EpiQKV {
    unsigned char* ws; const float* ss; const float* gka;
    __device__ __forceinline__ bool operator()(Acc& acc, const Unit& u, int wr, int wc, int fr, int fq) const {
        const int G = 4 * u.pn + wc;
        if (G >= 45) return false;
        unsigned dmib; int ld, g0, op;
        if (G < 8) { dmib = WS_QA / MiB; ld = 512; g0 = 0; op = 1; }
        else if (G < 10) { dmib = WS_KA / MiB; ld = 128; g0 = 8; op = 2; }
        else if (G < 12) { dmib = WS_VA / MiB; ld = 128; g0 = 10; op = 0; }
        else if (G < 16) { dmib = WS_QB / MiB; ld = 256; g0 = 12; op = 3; }
        else if (G < 20) { dmib = WS_KB / MiB; ld = 256; g0 = 16; op = 0; }
        else if (G < 28) { dmib = WS_VB / MiB; ld = 512; g0 = 20; op = 0; }
        else if (G < 36) { dmib = WS_OG / MiB; ld = 512; g0 = 28; op = 4; }
        else if (G < 44) { dmib = WS_QM / MiB; ld = 512; g0 = 36; op = 0; }
        else { dmib = WS_LR / MiB; ld = 32; g0 = 44; op = 5; }
        bf16_t* base = (bf16_t*)(ws + (size_t)dmib * MiB); const int col = 64 * (G - g0);
        f32x4 gk[2][2];
#pragma unroll
        for (int bj = 0; bj < 2; ++bj)
#pragma unroll
            for (int n = 0; n < 2; ++n) {
                gk[bj][n] = (f32x4){1.f, 1.f, 1.f, 1.f};
                if (op == 2) { const int d = 32 * bj + 8 * fq + 4 * n; gk[bj][n] = *(const f32x4*)(gka + d); }
            }
        const int row0 = u.pm * 256 + wr * 64 + fr;
        float rsv[2][4];
#pragma unroll
        for (int ai = 0; ai < 2; ++ai)
#pragma unroll
            for (int m = 0; m < 4; ++m) rsv[ai][m] = ss[row0 + ai * 128 + m * 16];
#pragma unroll
        for (int ai = 0; ai < 2; ++ai)
#pragma unroll
            for (int m = 0; m < 4; ++m) {
                const int row = row0 + ai * 128 + m * 16;
                const float rs = __builtin_amdgcn_rsqf(rsv[ai][m] * (1.0f / DM) + EPS);
                f32x4 v[2][2];
#pragma unroll
                for (int bj = 0; bj < 2; ++bj)
#pragma unroll
                    for (int n = 0; n < 2; ++n) v[bj][n] = acc[ai][bj][m][n] * rs;
                if (op == 1 || op == 2) {
                    float s = 0.f;
#pragma unroll
                    for (int bj = 0; bj < 2; ++bj)
#pragma unroll
                        for (int n = 0; n < 2; ++n) { const f32x4 x = v[bj][n]; s += (x[0] * x[0] + x[1] * x[1]) + (x[2] * x[2] + x[3] * x[3]); }
                    s = xsum16(s); s = swapsum(s);
                    const float r2 = __builtin_amdgcn_rsqf(s * (1.0f / 64.0f) + EPS);
#pragma unroll
                    for (int bj = 0; bj < 2; ++bj)
#pragma unroll
                        for (int n = 0; n < 2; ++n) v[bj][n] = v[bj][n] * r2 * gk[bj][n];
                } else if (op == 3) {
#pragma unroll
                    for (int bj = 0; bj < 2; ++bj)
#pragma unroll
                        for (int n = 0; n < 2; ++n) v[bj][n] = v[bj][n] * 0.125f;
                } else if (op == 4) {
#pragma unroll
                    for (int bj = 0; bj < 2; ++bj)
#pragma unroll
                        for (int n = 0; n < 2; ++n)
#pragma unroll
                            for (int e = 0; e < 4; ++e) v[bj][n][e] = siluf_(v[bj][n][e]);
                }
                bf16_t* rp = base + (size_t)row * ld + col + 8 * fq;
                st8(rp, v[0][0], v[0][1]);
                if (op != 5) st8(rp + 32, v[1][0], v[1][1]);
            }
        return false;
    }
};
template <int ACT> struct EpiRowScale {
    bf16_t* O; int ldc; size_t sub_stride; const float* ss;
    __device__ __forceinline__ bool operator()(Acc& acc, const Unit& u, int wr, int wc, int fr, int fq) const {
        const int row0 = u.pm * 256 + wr * 64 + fr, col0 = u.pn * 256 + wc * 32 + 8 * fq;
        bf16_t* base = O + (size_t)u.sub * sub_stride;
#pragma unroll
        for (int ai = 0; ai < 2; ++ai)
#pragma unroll
            for (int m = 0; m < 4; ++m) {
                const int row = row0 + ai * 128 + m * 16;
                const float rs = __builtin_amdgcn_rsqf(ss[row] * (1.0f / DM) + EPS);
#pragma unroll
                for (int bj = 0; bj < 2; ++bj) {
                    f32x4 a = acc[ai][bj][m][0] * rs, b = acc[ai][bj][m][1] * rs;
                    if (ACT == 1) {
#pragma unroll
                        for (int e = 0; e < 4; ++e) { a[e] = sigmoidf_(a[e]); b[e] = sigmoidf_(b[e]); }
                    }
                    st8(base + (size_t)row * ldc + col0 + bj * 128, a, b);
                }
            }
        return false;
    }
};
__device__ __forceinline__ unsigned pack4u8(float y0, float y1, float y2, float y3) {
    const unsigned p01 = __builtin_amdgcn_perm(__builtin_bit_cast(unsigned, y1), __builtin_bit_cast(unsigned, y0), 0x0c0c0400u);
    const unsigned p23 = __builtin_amdgcn_perm(__builtin_bit_cast(unsigned, y3), __builtin_bit_cast(unsigned, y2), 0x0c0c0400u);
    return __builtin_amdgcn_perm(p23, p01, 0x05040100u);
}
__device__ __forceinline__ float gate_u8(float zneg) {
    return fmaxf(__builtin_fmaf(__builtin_amdgcn_rcpf(1.0f + ex2(zneg)), 255.0f, 8388608.0f), 8388609.0f);
}
constexpr size_t G8_STRIDE = (size_t)128 * 4 * 8 * 8 * 64;
struct EpiGate {
    u32x4* GT; const float* ss; unsigned* fin_cnt; unsigned fin_need; mutable bool fin_ok;
    __device__ __forceinline__ bool operator()(Acc& acc, const Unit& u, int wr, int wc, int fr, int fq) const {
        if (!fin_ok) { fin_ok = true; unsigned sp = 0; while (__hip_atomic_load(fin_cnt, __ATOMIC_RELAXED, __HIP_MEMORY_SCOPE_AGENT) < fin_need && ++sp < (1u << 22)) __builtin_amdgcn_s_sleep(2); }
        const int row0 = u.pm * 256 + wr * 64 + fr, lane = fq * 16 + fr, j = u.sub;
        u32x4* gp = GT + (size_t)j * G8_STRIDE + ((((size_t)u.pm * 4 + u.pn) * 8 + (wr * 4 + wc)) * 8) * 64 + lane;
        float rs[2][4];
#pragma unroll
        for (int ai = 0; ai < 2; ++ai)
#pragma unroll
            for (int m = 0; m < 4; ++m) rs[ai][m] = ss[row0 + ai * 128 + m * 16];
#pragma unroll
        for (int ai = 0; ai < 2; ++ai)
#pragma unroll
            for (int m = 0; m < 4; ++m) {
                const float r = __builtin_amdgcn_rsqf(rs[ai][m] * (1.0f / DM) + EPS) * (-LOG2E);
                unsigned wv[4];
#pragma unroll
                for (int bj = 0; bj < 2; ++bj) {
                    const f32x4 a = acc[ai][bj][m][0] * r, b = acc[ai][bj][m][1] * r;
                    wv[2 * bj] = pack4u8(gate_u8(a[0]), gate_u8(a[1]), gate_u8(a[2]), gate_u8(a[3]));
                    wv[2 * bj + 1] = pack4u8(gate_u8(b[0]), gate_u8(b[1]), gate_u8(b[2]), gate_u8(b[3]));
                }
                u32x4 w; w.x = wv[0]; w.y = wv[1]; w.z = wv[2]; w.w = wv[3];
                st16_wt(gp + (ai * 4 + m) * 64, w);
            }
        return false;
    }
};
__device__ __forceinline__ void unpack_u8x8(unsigned x0, unsigned x1, float (&f)[8]) {
    f[0] = (float)(x0 & 0xffu); f[1] = (float)((x0 >> 8) & 0xffu); f[2] = (float)((x0 >> 16) & 0xffu); f[3] = (float)(x0 >> 24);
    f[4] = (float)(x1 & 0xffu); f[5] = (float)((x1 >> 8) & 0xffu); f[6] = (float)((x1 >> 16) & 0xffu); f[7] = (float)(x1 >> 24);
}
struct EpiMerge {
    const u32x4* GT; bf16_t* O;
    __device__ __forceinline__ bool operator()(Acc& acc, const Unit& u, int wr, int wc, int fr, int fq) const {
        const int row0 = u.pm * 256 + wr * 64 + fr, col0 = u.pn * 256 + wc * 32 + 8 * fq, lane = fq * 16 + fr;
        const int sub = u.sub;
        const u32x4* gp = GT + (size_t)sub * G8_STRIDE + ((((size_t)u.pm * 4 + u.pn) * 8 + (wr * 4 + wc)) * 8) * 64 + lane;
        u32x4 ga[2][4], gb[2][4];
#pragma unroll
        for (int ai = 0; ai < 2; ++ai)
#pragma unroll
            for (int m = 0; m < 4; ++m) { ga[ai][m] = gp[(ai * 4 + m) * 64]; gb[ai][m] = gp[(sub < 2 ? G8_STRIDE : 0) + (ai * 4 + m) * 64]; }
#pragma unroll
        for (int ai = 0; ai < 2; ++ai)
#pragma unroll
            for (int m = 0; m < 4; ++m) {
                const int row = row0 + ai * 128 + m * 16;
#pragma unroll
                for (int bj = 0; bj < 2; ++bj) {
                    float f[8], d[8];
                    unpack_u8x8(bj ? ga[ai][m].z : ga[ai][m].x, bj ? ga[ai][m].w : ga[ai][m].y, f);
                    unpack_u8x8(bj ? gb[ai][m].z : gb[ai][m].x, bj ? gb[ai][m].w : gb[ai][m].y, d);
#pragma unroll
                    for (int e = 0; e < 8; ++e) f[e] = (sub < 2) ? f[e] * __builtin_amdgcn_rcpf(d[e]) : f[e] * (1.0f / 255.0f);
                    f32x4 a = acc[ai][bj][m][0], b = acc[ai][bj][m][1];
#pragma unroll
                    for (int e = 0; e < 4; ++e) { a[e] *= f[e]; b[e] *= f[4 + e]; }
                    acc[ai][bj][m][0] = a; acc[ai][bj][m][1] = b;
                    if (sub == 2) st8(O + (size_t)row * DM + col0 + bj * 128, a, b);
                }
            }
        return sub < 2;
    }
};
struct EpiRes {
    bf16_t* XB; float* xout; float* ss; bool dry;
    __device__ __forceinline__ bool operator()(Acc& acc, const Unit& u, int wr, int wc, int fr, int fq) const {
        const int row0 = u.pm * 256 + wr * 64 + fr, col0 = u.pn * 256 + wc * 32 + 8 * fq;
#pragma unroll
        for (int ai = 0; ai < 2; ++ai) {
            u32x4 xr[4][2];
#pragma unroll
            for (int m = 0; m < 4; ++m)
#pragma unroll
                for (int bj = 0; bj < 2; ++bj) xr[m][bj] = *(const u32x4*)(XB + (size_t)(row0 + ai * 128 + m * 16) * DM + col0 + bj * 128);
            asm volatile("" ::: "memory");
#pragma unroll
            for (int m = 0; m < 4; ++m) {
                const int row = row0 + ai * 128 + m * 16; float s = 0.f;
#pragma unroll
                for (int bj = 0; bj < 2; ++bj) {
                    const size_t off = (size_t)row * DM + col0 + bj * 128; const u32x4 x = xr[m][bj];
                    const f32x4 a = (f32x4){bflo(x.x), bfhi(x.x), bflo(x.y), bfhi(x.y)} + acc[ai][bj][m][0], b = (f32x4){bflo(x.z), bfhi(x.z), bflo(x.w), bfhi(x.w)} + acc[ai][bj][m][1];
                    if (xout) { if (!dry) { *(f32x4*)(xout + off) = a; *(f32x4*)(xout + off + 4) = b; } }
                    else if (!dry) { st8(XB + off, a, b); s += (a[0] * a[0] + a[1] * a[1]) + (a[2] * a[2] + a[3] * a[3]) + (b[0] * b[0] + b[1] * b[1]) + (b[2] * b[2] + b[3] * b[3]); }
                }
                if (!xout && !dry) { s = xsum16(s); s = swapsum(s); if (fq == 0) atomicAdd(ss + row, s); }
            }
            asm volatile("" ::: "memory");
        }
        return false;
    }
};
struct EpiFFN {
    bf16_t* H; const float* ss;
    __device__ __forceinline__ bool operator()(Acc& acc, const Unit& u, int wr, int wc, int fr, int fq) const {
        const int row0 = u.pm * 256 + wr * 64 + fr, col0 = u.pn * 128 + wc * 32 + 8 * fq;
        float rsv[2][4];
#pragma unroll
        for (int ai = 0; ai < 2; ++ai)
#pragma unroll
            for (int m = 0; m < 4; ++m) rsv[ai][m] = ss[row0 + ai * 128 + m * 16];
#pragma unroll
        for (int ai = 0; ai < 2; ++ai)
#pragma unroll
            for (int m = 0; m < 4; ++m) {
                const int row = row0 + ai * 128 + m * 16;
                const float rs = __builtin_amdgcn_rsqf(rsv[ai][m] * (1.0f / DM) + EPS);
                f32x4 h[2];
#pragma unroll
                for (int n = 0; n < 2; ++n)
#pragma unroll
                    for (int e = 0; e < 4; ++e) { const float gt = acc[ai][0][m][n][e] * rs, up = acc[ai][1][m][n][e] * rs; h[n][e] = siluf_(gt) * up; }
                st8(H + (size_t)row * DFF + col0, h[0], h[1]);
            }
        return false;
    }
};

typedef GAS unsigned gu32;
#define XB_TMO      128
#define XB_XCNT(j)  (256  + 64 * (j))
#define XB_XSUB(j)  (1280 + 64 * (j))
#define XB_XGEN(j)  (2304 + 64 * (j))
#define XB_TOP      3328
#define XB_TOPGEN   3392
#define XCD_BAR_WORDS 3456
#define XB_SPIN_CAP (1u << 22)
__device__ __forceinline__ unsigned xb_ld(unsigned* p)              { return __hip_atomic_load(p, __ATOMIC_RELAXED, __HIP_MEMORY_SCOPE_AGENT); }
__device__ __forceinline__ unsigned xb_add(unsigned* p, unsigned v) { return __hip_atomic_fetch_add(p, v, __ATOMIC_RELAXED, __HIP_MEMORY_SCOPE_AGENT); }
__device__ __forceinline__ unsigned xb_xcc_id() { return (unsigned)__builtin_amdgcn_s_getreg((3 << 11) | 20) & 0xFu; }
#define XB_SPIN(cond, bar) do { unsigned _sp = 0; while (cond) { __builtin_amdgcn_s_sleep(1); \
    if ((++_sp & 255u) == 0u) { if (xb_ld(&(bar)[XB_TMO])) break; if (_sp > XB_SPIN_CAP) { atomicAdd(&(bar)[XB_TMO], 1u); break; } } } } while (0)
struct XcdBarrier { unsigned* bar; unsigned x; volatile LAS unsigned* st; };
__device__ __forceinline__ XcdBarrier xcd_barrier_post(unsigned* bar, volatile LAS unsigned* st) {
    XcdBarrier b; b.bar = bar; b.x = xb_xcc_id(); b.st = st;
    if (threadIdx.x == 0) (void)xb_add(&bar[XB_XCNT(b.x)], 1u);
    return b;
}
__device__ __forceinline__ void xcd_barrier_complete(unsigned* bar, unsigned x, unsigned& nloc, unsigned& nx) {
    const unsigned G = gridDim.x * gridDim.y * gridDim.z;
    unsigned sum, cnt, mine, sp = 0u;
    for (;;) {
        sum = 0u; cnt = 0u; mine = 0u;
#pragma unroll
        for (unsigned j = 0; j < 16; ++j) { const unsigned c = xb_ld(&bar[XB_XCNT(j)]); sum += c; cnt += (c > 0u) ? 1u : 0u; mine = (j == x) ? c : mine; }
        if (sum == G) break;
        __builtin_amdgcn_s_sleep(1);
        if ((++sp & 255u) == 0u) { if (xb_ld(&bar[XB_TMO])) break; if (sp > XB_SPIN_CAP) { atomicAdd(&bar[XB_TMO], 1u); break; } }
    }
    nloc = mine > 0u ? mine : 1u; nx = cnt > 0u ? cnt : 1u;
}
__device__ __forceinline__ void xcd_barrier(const XcdBarrier& b) {
    asm volatile("s_waitcnt vmcnt(0)" ::: "memory");
    __syncthreads();
    if (threadIdx.x == 0) {
        unsigned* bar = b.bar;
        __builtin_amdgcn_s_waitcnt(0);
        unsigned nloc = b.st[0], nx = b.st[1];
        if (nloc == 0u) { xcd_barrier_complete(bar, b.x, nloc, nx); b.st[0] = nloc; b.st[1] = nx; }
        const unsigned old = xb_add(&bar[XB_XSUB(b.x)], 1u);
        const unsigned gen = old / nloc;
        if (old + 1u == (gen + 1u) * nloc) {
            __builtin_amdgcn_fence(__ATOMIC_RELEASE, "agent");
            asm volatile("s_waitcnt vmcnt(0)" ::: "memory");
            const unsigned og = xb_add(&bar[XB_TOP], 1u);
            const unsigned tg = og / nx;
            if (og + 1u == (tg + 1u) * nx) xb_add(&bar[XB_TOPGEN], 1u);
            else XB_SPIN(xb_ld(&bar[XB_TOPGEN]) == tg, bar);
            __builtin_amdgcn_fence(__ATOMIC_ACQUIRE, "agent");
            xb_add(&bar[XB_XGEN(b.x)], 1u);
            asm volatile("s_waitcnt vmcnt(0)" ::: "memory");
        } else {
            XB_SPIN(xb_ld(&bar[XB_XGEN(b.x)]) == gen, bar);
            __builtin_amdgcn_fence(__ATOMIC_ACQUIRE, "agent");
            asm volatile("s_waitcnt vmcnt(0)" ::: "memory");
        }
    }
    __syncthreads();
}

struct Args { const float* in[20]; float* out; unsigned char* ws; int ph_lo, ph_hi; };
struct Frame {
    LAS unsigned char* lds; unsigned char* ws; int tid, lane, wave, G, bid;
    float* out;
};
__device__ __forceinline__ const float* par(const Frame& F, int l, int off) { return (const float*)(F.ws + WS_PAR) + l * PAR_LAYER + off; }
enum { I_X = 0, I_MEM, I_RELB, I_NMIX, I_NFFN, I_NMEM, I_WIN, I_QNA, I_KNA, I_SINK, I_WDU, I_BDEC, I_GLAG, I_WMKV, I_QNM, I_KNM, I_WBR, I_WOUT, I_WFI, I_WFO };

__device__ __forceinline__ float wave_sum(float v) {
#pragma unroll
    for (int o = 1; o < 64; o <<= 1) v += __shfl_xor(v, o);
    return v;
}

#ifndef TBLK
#define TBLK 0
#endif
#define T_BEGIN() const unsigned long long t_begin_ = (TSEC >= 0) ? __builtin_amdgcn_s_memrealtime() : 0ull
#define T_END(id) do { if (TSEC == (id) && F.bid == TBLK && F.tid == 0) { unsigned* p_ = (unsigned*)(F.ws + WS_CTL) + 8192; *p_ += (unsigned)(__builtin_amdgcn_s_memrealtime() - t_begin_); } } while (0)
__device__ __forceinline__ int ina_src(int n0);
__device__ __forceinline__ int src32(int kind, int pn, int jb) {
    if (kind == 1) return ina_src(256 * pn + 32 * jb);
    if (kind == 2) return 2848 + 256 * pn + 32 * jb;
    if (kind == 3) return 2816 * (jb >> 2) + 128 * pn + 32 * (jb & 3);
    return 256 * pn + 32 * jb;
}
struct TrItem { const float* W; int ldw, kind, pn, k0; bf16_t* Bt; int ldb, kd0; const float* gain; };
__device__ __forceinline__ void tr_load(const Frame& F, const TrItem& I, f32x4 (&v)[8]) {
    const int lane = F.lane, w = F.wave;
    const int sc = src32(I.kind, I.pn, lane >> 3);
#pragma unroll
    for (int i = 0; i < 8; ++i) { const int k = w + 8 * i; v[i] = (f32x4){0.f, 0.f, 0.f, 0.f}; if (sc >= 0) v[i] = __builtin_nontemporal_load((const f32x4*)(I.W + (size_t)(I.k0 + k) * I.ldw + sc + 4 * (lane & 7))); }
}
__device__ __forceinline__ void tr_process(Frame& F, const TrItem& I, const f32x4 (&v)[8]) {
    LAS float* Tl = (LAS float*)F.lds;
    const int lane = F.lane, w = F.wave, tid = F.tid;
#pragma unroll
    for (int i = 0; i < 8; ++i) { const int k = w + 8 * i; f32x4 x = v[i]; if (I.gain) x = x * I.gain[I.k0 + k]; *(LAS f32x4*)(Tl + k * 260 + 4 * lane) = x; }
    asm volatile("s_waitcnt lgkmcnt(0)\n\ts_barrier" ::: "memory");
    const int n = tid & 255, kh = tid >> 8;
#pragma unroll
    for (int c = 0; c < 4; ++c) { const int k8 = 32 * kh + 8 * c; const LAS float* sp = Tl + k8 * 260 + n;
        u32x4 o; o.x = cvtpk(sp[0], sp[260]); o.y = cvtpk(sp[2 * 260], sp[3 * 260]); o.z = cvtpk(sp[4 * 260], sp[5 * 260]); o.w = cvtpk(sp[6 * 260], sp[7 * 260]);
        *(u32x4*)(I.Bt + (size_t)(256 * I.pn + n) * I.ldb + I.kd0 + I.k0 + k8) = o; }
    asm volatile("s_waitcnt lgkmcnt(0)\n\ts_barrier" ::: "memory");
}
__device__ __forceinline__ int ina_src(int n0) {
    const int pn = n0 >> 8, c = n0 & 255, bj = c >> 7, wc = (c >> 5) & 3;
    const int x = 64 * (4 * pn + wc) + 32 * bj;
    if (x < 2304) return x;
    if (x < 2816) return x + 32;
    if (x < 2848) return 2304 + (x - 2816);
    return -1;
}
__device__ __forceinline__ void p0_prologue(Frame& F, const Args& A) {
    const int gw = F.bid * 8 + F.wave, NGW = F.G * 8;
    constexpr int I_A = 12 * 16, I_G = 12 * 16, I_M = 4 * 16, I_B = 3 * 4 * 8, I_O = 4 * 16, I_FI = 22 * 16, I_FO = 4 * 44;
    constexpr int I_LAYER = I_A + I_G + I_M + I_B + I_O + I_FI + I_FO;
    T_BEGIN();
    auto decode = [&](int it, TrItem& I) {
        const int l = it / I_LAYER; int r = it - l * I_LAYER;
        unsigned char* wl = F.ws + WS_W + (size_t)l * W_LAYER;
        if (r < I_A) { I = TrItem{A.in[I_WIN] + (size_t)l * DM * DIN, DIN, 1, r % 12, 64 * (r / 12), (bf16_t*)(wl + W_INA), DM, 0, A.in[I_NMIX] + l * DM}; return; } r -= I_A;
        if (r < I_G) { I = TrItem{A.in[I_WIN] + (size_t)l * DM * DIN, DIN, 2, r % 12, 64 * (r / 12), (bf16_t*)(wl + W_ING), DM, 0, A.in[I_NMIX] + l * DM}; return; } r -= I_G;
        if (r < I_M) { I = TrItem{A.in[I_WMKV] + (size_t)l * DM * 1024, 1024, 0, r & 3, 64 * (r >> 2), (bf16_t*)(wl + W_MKV), DM, 0, A.in[I_NMEM] + l * DM}; return; } r -= I_M;
        if (r < I_B) { const int j = r / 32, q = r % 32; I = TrItem{A.in[I_WBR] + ((size_t)l * 3 + j) * 512 * DM, DM, 0, q & 3, 64 * (q >> 2), (bf16_t*)(wl + W_BR), 1536, 512 * j, nullptr}; return; } r -= I_B;
        if (r < I_O) { I = TrItem{A.in[I_WOUT] + (size_t)l * DM * DM, DM, 0, r & 3, 64 * (r >> 2), (bf16_t*)(wl + W_OUT), DM, 0, nullptr}; return; } r -= I_O;
        if (r < I_FI) { I = TrItem{A.in[I_WFI] + (size_t)l * DM * 2 * DFF, 2 * DFF, 3, r % 22, 64 * (r / 22), (bf16_t*)(wl + W_FI), DM, 0, A.in[I_NFFN] + l * DM}; return; } r -= I_FI;
        I = TrItem{A.in[I_WFO] + (size_t)l * DFF * DM, DM, 0, r & 3, 64 * (r >> 2), (bf16_t*)(wl + W_FO), DFF, 0, nullptr};
    };
    const unsigned long long t_x0_ = (TSEC >= 0) ? __builtin_amdgcn_s_memrealtime() : 0ull;
    for (int m = gw; m < T + TMEM; m += 2 * NGW) {
        const int m2 = m + NGW; const bool has2 = m2 < T + TMEM;
        const bool ism = m >= T, ism2 = m2 >= T; const int r = ism ? m - T : m, r2 = ism2 ? m2 - T : m2;
        const f32x4* xr = (const f32x4*)((ism ? A.in[I_MEM] : A.in[I_X]) + (size_t)r * DM) + F.lane;
        const f32x4* xr2 = (const f32x4*)((ism2 ? A.in[I_MEM] : A.in[I_X]) + (size_t)r2 * DM) + F.lane;
        f32x4 v[4], v2[4];
#pragma unroll
        for (int j = 0; j < 4; ++j) v[j] = __builtin_nontemporal_load(xr + 64 * j);
        if (has2) {
#pragma unroll
            for (int j = 0; j < 4; ++j) v2[j] = __builtin_nontemporal_load(xr2 + 64 * j);
        }
        {
            bf16_t* orow = (bf16_t*)(F.ws + (ism ? WS_MB : WS_XB)) + (size_t)r * DM; float s = 0.f;
#pragma unroll
            for (int j = 0; j < 4; ++j) { s += (v[j].x * v[j].x + v[j].y * v[j].y) + (v[j].z * v[j].z + v[j].w * v[j].w); u32x2 w; w.x = cvtpk(v[j].x, v[j].y); w.y = cvtpk(v[j].z, v[j].w); *(u32x2*)(orow + 256 * j + 4 * F.lane) = w; }
            s = wave_sum(s);
            if (F.lane == 0) ((float*)(F.ws + (ism ? WS_MSS : WS_SS)))[r] = s;
        }
        if (has2) {
            bf16_t* orow = (bf16_t*)(F.ws + (ism2 ? WS_MB : WS_XB)) + (size_t)r2 * DM; float s = 0.f;
#pragma unroll
            for (int j = 0; j < 4; ++j) { s += (v2[j].x * v2[j].x + v2[j].y * v2[j].y) + (v2[j].z * v2[j].z + v2[j].w * v2[j].w); u32x2 w; w.x = cvtpk(v2[j].x, v2[j].y); w.y = cvtpk(v2[j].z, v2[j].w); *(u32x2*)(orow + 256 * j + 4 * F.lane) = w; }
            s = wave_sum(s);
            if (F.lane == 0) ((float*)(F.ws + (ism2 ? WS_MSS : WS_SS)))[r2] = s;
        }
    }
    if (TSEC == 6 && F.bid == 0 && F.tid == 0) { unsigned* p_ = (unsigned*)(F.ws + WS_CTL) + 8192; *p_ += (unsigned)(__builtin_amdgcn_s_memrealtime() - t_x0_); }
    __syncthreads();
    {
        unsigned* ictr = (unsigned*)(F.ws + WS_CTL) + 8209;
        volatile LAS unsigned* slot = (volatile LAS unsigned*)(F.lds + MISC_OFF) + 24;
        constexpr int NIT = 2 * I_LAYER;
        if (F.tid == 0) { slot[0] = __hip_atomic_fetch_add(ictr, 1u, __ATOMIC_RELAXED, __HIP_MEMORY_SCOPE_AGENT); slot[1] = __hip_atomic_fetch_add(ictr, 1u, __ATOMIC_RELAXED, __HIP_MEMORY_SCOPE_AGENT); }
        __syncthreads();
        int it = (int)slot[0];
        if (it < NIT) {
            TrItem cur, nxt; f32x4 vc[8], vn[8];
            decode(it, cur); tr_load(F, cur, vc);
#pragma unroll 1
            for (int k = 0; it < NIT; ++k) {
                unsigned g2 = 0u;
                if (F.tid == 0) g2 = __hip_atomic_fetch_add(ictr, 1u, __ATOMIC_RELAXED, __HIP_MEMORY_SCOPE_AGENT);
                const int in1 = (int)slot[(k + 1) % 3];
                const int itn = in1 < NIT ? in1 : it;
                decode(itn, nxt); tr_load(F, nxt, vn);
                tr_process(F, cur, vc);
                if (F.tid == 0) slot[(k + 2) % 3] = g2;
                __syncthreads();
                cur = nxt; it = in1;
#pragma unroll
                for (int i = 0; i < 8; ++i) vc[i] = vn[i];
            }
        }
    }
    T_END(5);
    {
        for (int i = F.bid * 512 + F.tid; i < 2 * PAR_LAYER; i += F.G * 512) {
            const int l = i / PAR_LAYER, o = i % PAR_LAYER; float v = 0.f;
            if (o < 64) v = A.in[I_QNA][l * 64 + o] * A.in[I_KNA][l * 64 + o] * (0.125f * LOG2E);
            else if (o < 72) v = A.in[I_SINK][l * 8 + (o - 64)] * LOG2E;
            else if (o < 80) {
                const int h = o - 72; float mg = 0.f, mb = 0.f;
                for (int d = 0; d < 64; ++d) mg = fmaxf(mg, fabsf(A.in[I_QNA][l * 64 + d] * A.in[I_KNA][l * 64 + d]));
                for (int bk = 0; bk < 32; ++bk) mb = fmaxf(mb, A.in[I_RELB][bk * 8 + h] * LOG2E);
                const float bnd = fmaxf(64.f * mg * (0.125f * LOG2E) + mb, A.in[I_SINK][l * 8 + h] * LOG2E);
                v = fmaxf(0.f, bnd - 60.f);
            }
            else if (o == 80) {
                float mg = 0.f;
                for (int d = 0; d < 128; ++d) mg = fmaxf(mg, fabsf(A.in[I_QNM][l * 128 + d] * A.in[I_KNM][l * 128 + d]));
                v = fmaxf(0.f, 128.f * mg * (0.08838834764831845f * LOG2E) - 60.f);
            }
            else if (o < 128) v = 0.f;
            else if (o < 256) v = A.in[I_QNM][l * 128 + (o - 128)] * A.in[I_KNM][l * 128 + (o - 128)] * (0.08838834764831845f * LOG2E);
            else if (o < 384) v = A.in[I_GLAG][l * 128 + (o - 256)];
            else if (o < 896) v = A.in[I_BDEC][l * 512 + (o - 384)];
            else v = A.in[I_WDU][l * 8192 + (o - 896)];
            ((float*)(F.ws + WS_PAR))[i] = v;
        }
    }
    {
        for (int i = F.bid * 512 + F.tid; i < 8 * 257; i += F.G * 512) {
            const int h = i / 257, rel = i % 257 - 128, n = rel < 0 ? -rel : rel;
            int bk = n < 8 ? n : (2 + (31 - __builtin_clz((unsigned)(n * n)))); if (bk > 15) bk = 15;
            if (rel > 0) bk += 16;
            ((float*)(F.ws + WS_BIAS))[i] = A.in[I_RELB][bk * 8 + h] * LOG2E;
        }
    }
}

struct WinQ { bf16x8 qf[4]; float l; f32x16 o0, o1; };
__device__ __forceinline__ float max3f_(float a, float b, float c) { return fmaxf(fmaxf(a, b), c); }
__device__ __forceinline__ void win_step(WinQ& q, const bf16x8 (&kf)[4], const bf16x8 (&vf)[2][2], const LAS float* bt, LAS float* wsf, int r32, int hi) {
    f32x16 s;
#pragma unroll
    for (int r = 0; r < 16; ++r) s[r] = bt[(r & 3) + 8 * (r >> 2)];
#pragma unroll
    for (int ds = 0; ds < 4; ++ds) s = MFMA32(kf[ds], q.qf[ds], s);
    float ps = 0.f;
#pragma unroll
    for (int r = 0; r < 16; ++r) { const float p = ex2(s[r]); s[r] = p; ps += p; }
    q.l += ps;
    const bf16x8 p0 = pack8(s, 0), p1 = pack8(s, 1);
    q.o0 = MFMA32(p0, vf[0][0], q.o0); q.o0 = MFMA32(p1, vf[0][1], q.o0);
    q.o1 = MFMA32(p0, vf[1][0], q.o1); q.o1 = MFMA32(p1, vf[1][1], q.o1);
}
struct WinKV { u32x4 k[6], v[6], q[8]; float sk, mr; };
__device__ __forceinline__ void win_kv_addr(const Frame& F, int unit, int it, int tid, size_t& off) {
    const int b = unit >> 6, i = (unit >> 1) & 31, kvh = unit & 1; const int idx = tid + 512 * it, j = idx >> 3, ch = idx & 7;
    int kpos = 128 * i - 128 + j; kpos = min(max(kpos, 0), SEQ - 1); off = (size_t)(b * SEQ + kpos) * 128 + kvh * 64 + ch * 8;
}
__device__ __forceinline__ void win_k_load(const Frame& F, int unit, WinKV& P) {
#pragma unroll
    for (int it = 0; it < 6; ++it) { size_t off; win_kv_addr(F, unit, it, F.tid, off); P.k[it] = *(const u32x4*)((const bf16_t*)(F.ws + WS_KA) + off); }
}
__device__ __forceinline__ void win_v_load(const Frame& F, int unit, WinKV& P) {
#pragma unroll
    for (int it = 0; it < 6; ++it) { size_t off; win_kv_addr(F, unit, it, F.tid, off); P.v[it] = *(const u32x4*)((const bf16_t*)(F.ws + WS_VA) + off); }
}
__device__ __forceinline__ void win_q_load(const Frame& F, int l, int unit, int tid, WinKV& P) {
    const int b = unit >> 6, i = (unit >> 1) & 31, kvh = unit & 1; const int lane = tid & 63, r32 = lane & 31, hi = lane >> 5, w = tid >> 6;
    const int h = kvh * 4 + (w >> 1), qb0 = 2 * (w & 1);
    const bf16_t* qp = (const bf16_t*)(F.ws + WS_QA) + (size_t)(b * SEQ + 128 * i + 32 * qb0 + r32) * 512 + h * 64 + 8 * hi;
#pragma unroll
    for (int ds = 0; ds < 4; ++ds) { P.q[ds] = *(const u32x4*)(qp + 16 * ds); P.q[4 + ds] = *(const u32x4*)(qp + 32 * 512 + 16 * ds); }
    P.sk = par(F, l, PAR_SINK)[h]; P.mr = par(F, l, PAR_MREF)[h];
}
__device__ __forceinline__ void winattn_unit(Frame& F, int l, int unit, bool dry, const WinKV& cur, bool has_next, int next_unit, WinKV& nxt, bool stage_bias) {
    const int b = unit >> 6, i = (unit >> 1) & 31, kvh = unit & 1;
    const int tid = opaque_v(F.tid), lane = tid & 63, r32 = lane & 31, hi = lane >> 5, w = F.wave;
    const bf16_t* KA = (const bf16_t*)(F.ws + WS_KA); const bf16_t* VA = (const bf16_t*)(F.ws + WS_VA); bf16_t* QA = (bf16_t*)(F.ws + WS_QA);
    LAS unsigned char* Kt = F.lds; LAS unsigned char* Vt = F.lds + 49152; LAS float* bias = (LAS float*)(F.lds + 98304);
    LAS float* wsf = (LAS float*)(F.lds + WSF_OFF) + w * 128;
    const int start = 128 * i;
    T_BEGIN();
    const int g = w >> 1, half = w & 1, h = kvh * 4 + g, qb0 = 2 * half;
    WinQ A, B;
#pragma unroll
    for (int ds = 0; ds < 4; ++ds) { A.qf[ds] = __builtin_bit_cast(bf16x8, cur.q[ds]); B.qf[ds] = __builtin_bit_cast(bf16x8, cur.q[4 + ds]); }
    {
        if (stage_bias)
        for (int idx = tid; idx < 4 * 321; idx += 512) { const int g_ = idx / 321, rel = idx % 321 - 160;
            bias[idx] = (rel >= -128 && rel <= 128) ? ((const float*)(F.ws + WS_BIAS))[(kvh * 4 + g_) * 257 + rel + 128] - par(F, l, PAR_MREF)[kvh * 4 + g_] : -1e30f; }
#pragma unroll
        for (int it = 0; it < 6; ++it) { const int idx = tid + 512 * it, j = idx >> 3, ch = idx & 7;
            *(LAS u32x4*)(Kt + j * 128 + ((ch ^ ((j >> 1) & 7)) << 4)) = cur.k[it];
            *(LAS u32x4*)(Vt + ((ch >> 2) * 24 + (j >> 4)) * 1024 + (j & 15) * 64 + (ch & 3) * 16) = cur.v[it]; }
    }
    asm volatile("s_waitcnt lgkmcnt(0)\n\ts_barrier" ::: "memory");
    T_END(3);
    { const int nu = has_next ? next_unit : unit; win_k_load(F, nu, nxt); win_v_load(F, nu, nxt); }
    const LAS float* bh = bias + g * 321;
    const int vlane = ((lane >> 4) & 1) * 32 + (lane & 3) * 8 + (4 * hi + ((lane & 15) >> 2)) * 64;
    A.l = (hi == 0) ? ex2(cur.sk - cur.mr) : 0.0f; B.l = A.l; A.o0 = f32x16{}; A.o1 = f32x16{}; B.o0 = f32x16{}; B.o1 = f32x16{};
#pragma unroll 1
    for (int kt = qb0; kt <= qb0 + 9; ++kt) {
        const int kp0 = start - 128 + 32 * kt;
        if (kp0 + 31 < 0 || kp0 >= SEQ) continue;
        bf16x8 kf[4], vf[2][2];
#pragma unroll
        for (int ds = 0; ds < 4; ++ds) { const int kr = 32 * kt + r32, ch = 2 * ds + hi; kf[ds] = *(const LAS bf16x8*)(Kt + kr * 128 + ((ch ^ ((kr >> 1) & 7)) << 4)); }
#pragma unroll
        for (int d0 = 0; d0 < 2; ++d0) { const LAS char* vb = (const LAS char*)Vt + (d0 * 24 + 2 * kt) * 1024 + vlane;
            vf[d0][0] = mk8(vtr(vb), vtr(vb + 512)); vf[d0][1] = mk8(vtr(vb + 1024), vtr(vb + 1024 + 512)); }
        if (kt <= qb0 + 8) win_step(A, kf, vf, bh + (32 * (kt - qb0) + 32 - r32 + 4 * hi), wsf, r32, hi);
        if (kt >= qb0 + 1) win_step(B, kf, vf, bh + (32 * (kt - qb0 - 1) + 32 - r32 + 4 * hi), wsf + 32, r32, hi);
    }
    T_END(16);
    { const int nu = has_next ? next_unit : unit; win_q_load(F, l, nu, tid, nxt); }
    LAS unsigned char* stg = F.lds + 104448 + w * 4608;
#pragma unroll
    for (int qq = 0; qq < 2; ++qq) {
        WinQ& q = qq == 0 ? A : B;
        const float lt = swapsum(q.l);
        if (hi == 0) wsf[64 + r32] = __builtin_amdgcn_rcpf(lt);
        asm volatile("s_waitcnt lgkmcnt(0)" ::: "memory");
#pragma unroll
        for (int qd = 0; qd < 4; ++qd) { const f32x4 rl = *(const LAS f32x4*)(wsf + 64 + 8 * qd + 4 * hi);
            u32x2 p0 = {cvtpk(q.o0[4 * qd] * rl[0], q.o0[4 * qd + 1] * rl[1]), cvtpk(q.o0[4 * qd + 2] * rl[2], q.o0[4 * qd + 3] * rl[3])};
            u32x2 p1 = {cvtpk(q.o1[4 * qd] * rl[0], q.o1[4 * qd + 1] * rl[1]), cvtpk(q.o1[4 * qd + 2] * rl[2], q.o1[4 * qd + 3] * rl[3])};
            *(LAS u32x2*)(stg + r32 * 72 + (8 * qd + 4 * hi) * 2) = p0; *(LAS u32x2*)(stg + (32 + r32) * 72 + (8 * qd + 4 * hi) * 2) = p1; }
        asm volatile("s_waitcnt lgkmcnt(0)" ::: "memory");
        bf16_t* Ob = QA + (size_t)(b * SEQ + start + 32 * (qb0 + qq)) * 512 + h * 64;
        const LAS char* tb = (const LAS char*)stg + (8 * (lane >> 4) + ((lane & 15) >> 2)) * 72 + (4 * (lane & 3)) * 2;
#pragma unroll
        for (int pc = 0; pc < 2; ++pc)
#pragma unroll
            for (int t = 0; t < 2; ++t) { const bf16x8 v8 = mk8(vtr(tb + pc * 32 * 72 + 32 * t), vtr(tb + pc * 32 * 72 + 4 * 72 + 32 * t));
                if (!dry) *(u32x4*)(Ob + (size_t)(16 * t + (lane & 15)) * 512 + 32 * pc + 8 * (lane >> 4)) = __builtin_bit_cast(u32x4, v8); }
        asm volatile("s_waitcnt lgkmcnt(0)" ::: "memory");
    }
    T_END(18);
    asm volatile("s_waitcnt lgkmcnt(0)\n\ts_barrier" ::: "memory");
    T_END(0);
}

__device__ __forceinline__ void memattn_unit(Frame& F, int l, int unit, bool dry) {
    const int b = unit >> 5, h = (unit >> 3) & 3, rb = unit & 7;
    const int tid = opaque_v(F.tid), lane = tid & 63, r32 = lane & 31, hi = lane >> 5, w = F.wave;
    const bf16_t* KV = (const bf16_t*)(F.ws + WS_KVM) + (size_t)l * TMEM * 1024; bf16_t* QM = (bf16_t*)(F.ws + WS_QM);
    LAS unsigned char* Kt = F.lds; LAS unsigned char* Vt = F.lds + 65536;
    LAS float* wsf = (LAS float*)(F.lds + WSF_OFF) + w * 128;
    const float* gkm = par(F, l, PAR_GKM); const float nmref = -par(F, l, PAR_MREFM)[0];
    T_BEGIN();
    bf16x8 qfr[2][8];
#pragma unroll
    for (int ds = 0; ds < 8; ++ds) qfr[0][ds] = *(const bf16x8*)(QM + ((size_t)b * SEQ + rb * 512 + w * 64 + r32) * 512 + h * 128 + 16 * ds + 8 * hi);
    {
        u32x4 kvr[8], vvr[8];
#pragma unroll
        for (int it = 0; it < 8; ++it) { const int idx = tid + 512 * it, j = idx >> 4, ch = idx & 15;
            const bf16_t* rp = KV + (size_t)(b * NMEM + j) * 1024 + h * 128 + ch * 8; kvr[it] = *(const u32x4*)rp; vvr[it] = *(const u32x4*)(rp + 512); }
#pragma unroll
        for (int it = 0; it < 8; ++it) { const int idx = tid + 512 * it, j = idx >> 4, ch = idx & 15;
            const u32x4 kv = kvr[it];
            float f[8] = {bflo(kv.x), bfhi(kv.x), bflo(kv.y), bfhi(kv.y), bflo(kv.z), bfhi(kv.z), bflo(kv.w), bfhi(kv.w)};
            float s = 0.f;
#pragma unroll
            for (int e = 0; e < 8; ++e) s += f[e] * f[e];
            s = rowsum16(s);
            const float rs = __builtin_amdgcn_rsqf(s * (1.0f / 128.0f) + EPS);
#pragma unroll
            for (int e = 0; e < 8; ++e) f[e] *= rs * gkm[ch * 8 + e];
            u32x4 ko; ko.x = cvtpk(f[0], f[1]); ko.y = cvtpk(f[2], f[3]); ko.z = cvtpk(f[4], f[5]); ko.w = cvtpk(f[6], f[7]);
            *(LAS u32x4*)(Kt + j * 256 + ((ch ^ (j & 15)) << 4)) = ko;
            *(LAS u32x4*)(Vt + ((ch >> 2) * 16 + (j >> 4)) * 1024 + (j & 15) * 64 + (ch & 3) * 16) = vvr[it]; }
    }
    asm volatile("s_waitcnt lgkmcnt(0)\n\ts_barrier" ::: "memory");
    T_END(10);
#pragma unroll
    for (int ds = 0; ds < 8; ++ds) qfr[1][ds] = *(const bf16x8*)(QM + ((size_t)b * SEQ + rb * 512 + w * 64 + 32 + r32) * 512 + h * 128 + 16 * ds + 8 * hi);
    const int vlane = ((lane >> 4) & 1) * 32 + (lane & 3) * 8 + (4 * hi + ((lane & 15) >> 2)) * 64;
    unsigned opk[2][4][8];
#pragma unroll
    for (int qq = 0; qq < 2; ++qq) {
        float qs = 0.f;
#pragma unroll
        for (int ds = 0; ds < 8; ++ds) { const u32x4 qv = __builtin_bit_cast(u32x4, qfr[qq][ds]);
            const float a0 = bflo(qv.x), a1 = bfhi(qv.x), a2 = bflo(qv.y), a3 = bfhi(qv.y), a4 = bflo(qv.z), a5 = bfhi(qv.z), a6 = bflo(qv.w), a7 = bfhi(qv.w);
            qs += (a0 * a0 + a1 * a1) + (a2 * a2 + a3 * a3) + (a4 * a4 + a5 * a5) + (a6 * a6 + a7 * a7); }
        qs = swapsum(qs);
        const float rq = __builtin_amdgcn_rsqf(qs * (1.0f / 128.0f) + EPS);
        bf16x8 qn[8];
#pragma unroll
        for (int ds = 0; ds < 8; ++ds) { const u32x4 qv = __builtin_bit_cast(u32x4, qfr[qq][ds]); u32x4 o4;
            o4.x = cvtpk(bflo(qv.x) * rq, bfhi(qv.x) * rq); o4.y = cvtpk(bflo(qv.y) * rq, bfhi(qv.y) * rq); o4.z = cvtpk(bflo(qv.z) * rq, bfhi(qv.z) * rq); o4.w = cvtpk(bflo(qv.w) * rq, bfhi(qv.w) * rq);
            qn[ds] = __builtin_bit_cast(bf16x8, o4); }
        float lsum = 0.f;
        f32x16 o[4]; o[0] = f32x16{}; o[1] = f32x16{}; o[2] = f32x16{}; o[3] = f32x16{};
#pragma unroll 1
        for (int kt = 0; kt < 8; ++kt) {
            f32x16 s;
#pragma unroll
            for (int r = 0; r < 16; ++r) s[r] = nmref;
#pragma unroll
            for (int ds = 0; ds < 8; ++ds) {
                const int kr = 32 * kt + r32, ch = 2 * ds + hi;
                const bf16x8 kf = *(const LAS bf16x8*)(Kt + kr * 256 + ((ch ^ (kr & 15)) << 4));
                s = MFMA32(kf, qn[ds], s);
            }
            float ps = 0.f;
#pragma unroll
            for (int r = 0; r < 16; ++r) { const float p = ex2(s[r]); s[r] = p; ps += p; }
            lsum += ps;
            const bf16x8 p0 = pack8(s, 0), p1 = pack8(s, 1);
#pragma unroll
            for (int d0 = 0; d0 < 4; ++d0) {
                const LAS char* vb = (const LAS char*)Vt + (d0 * 16 + 2 * kt) * 1024 + vlane;
                const bf16x8 v0 = mk8(vtr(vb), vtr(vb + 512)), v1 = mk8(vtr(vb + 1024), vtr(vb + 1024 + 512));
                o[d0] = MFMA32(p0, v0, o[d0]); o[d0] = MFMA32(p1, v1, o[d0]);
            }
        }
        lsum = swapsum(lsum);
        if (hi == 0) wsf[32 + r32] = __builtin_amdgcn_rcpf(lsum);
        asm volatile("s_waitcnt lgkmcnt(0)" ::: "memory");
#pragma unroll
        for (int i = 0; i < 8; ++i) { const float r0 = wsf[32 + crow(2 * i, hi)], r1 = wsf[32 + crow(2 * i + 1, hi)];
#pragma unroll
            for (int d0 = 0; d0 < 4; ++d0) opk[qq][d0][i] = cvtpk(o[d0][2 * i] * r0, o[d0][2 * i + 1] * r1); }
    }
    asm volatile("s_waitcnt lgkmcnt(0)\n\ts_barrier" ::: "memory");
    T_END(11);
    LAS bf16_t* stg = (LAS bf16_t*)(F.lds + w * 16384);
#pragma unroll
    for (int qq = 0; qq < 2; ++qq)
#pragma unroll
        for (int i = 0; i < 8; ++i)
#pragma unroll
            for (int d0 = 0; d0 < 4; ++d0) { const unsigned v = opk[qq][d0][i];
                stg[qq * 4096 + crow(2 * i, hi) * 128 + 32 * d0 + r32] = (bf16_t)(v & 0xffffu); stg[qq * 4096 + crow(2 * i + 1, hi) * 128 + 32 * d0 + r32] = (bf16_t)(v >> 16); }
    asm volatile("s_waitcnt lgkmcnt(0)" ::: "memory");
#pragma unroll
    for (int qq = 0; qq < 2; ++qq) {
        bf16_t* Ob = QM + ((size_t)b * SEQ + rb * 512 + w * 64 + qq * 32) * 512 + h * 128;
#pragma unroll
        for (int k = 0; k < 8; ++k) { const int c = k * 64 + lane, row = c >> 4, ch = c & 15; const u32x4 v = *(const LAS u32x4*)(stg + qq * 4096 + row * 128 + ch * 8); if (!dry) *(u32x4*)(Ob + (size_t)row * 512 + ch * 8) = v; }
    }
    asm volatile("s_waitcnt lgkmcnt(0)\n\ts_barrier" ::: "memory");
}

__device__ __forceinline__ void st_tile(unsigned* p, const f32x16& x, int lane) {
    u32x4 a, b; a.x = cvtpk(x[0], x[1]); a.y = cvtpk(x[2], x[3]); a.z = cvtpk(x[4], x[5]); a.w = cvtpk(x[6], x[7]);
    b.x = cvtpk(x[8], x[9]); b.y = cvtpk(x[10], x[11]); b.z = cvtpk(x[12], x[13]); b.w = cvtpk(x[14], x[15]);
    *(u32x4*)(p + lane * 4) = a; *(u32x4*)(p + 256 + lane * 4) = b;
}
__device__ __forceinline__ void st_nat(bf16_t* p, const f32x16& x, int r32, int hi) {
#pragma unroll
    for (int r = 0; r < 16; ++r) p[(size_t)crow(r, hi) * 512 + r32] = (bf16_t)(cvtpk(x[r], 0.f) & 0xffffu);
}
__device__ __forceinline__ void ld_tile_add(const unsigned* p, f32x16& x, int lane) {
#pragma unroll
    for (int i = 0; i < 8; ++i) { const unsigned w = p[i * 64 + lane]; x[2 * i] += bflo(w); x[2 * i + 1] += bfhi(w); }
}
__device__ __forceinline__ float dpp_f(float v, const int ctrl_sel) {
    const int iv = __builtin_bit_cast(int, v); int r;
    switch (ctrl_sel) { case 1: r = __builtin_amdgcn_update_dpp(0, iv, 0x111, 0xf, 0xf, true); break; case 2: r = __builtin_amdgcn_update_dpp(0, iv, 0x112, 0xf, 0xf, true); break;
                        case 4: r = __builtin_amdgcn_update_dpp(0, iv, 0x114, 0xf, 0xf, true); break; case 8: r = __builtin_amdgcn_update_dpp(0, iv, 0x118, 0xf, 0xf, true); break;
                        case 15: r = __builtin_amdgcn_update_dpp(0, iv, 0x142, 0xa, 0xf, false); break; default: r = __builtin_amdgcn_update_dpp(0, iv, 0x143, 0xc, 0xf, false); break; }
    return __builtin_bit_cast(float, r);
}
__device__ __forceinline__ float wave_prefix(float v, int lane) {
    (void)lane;
    v += dpp_f(v, 1); v += dpp_f(v, 2); v += dpp_f(v, 4); v += dpp_f(v, 8); v += dpp_f(v, 15); v += dpp_f(v, 31);
    return v;
}
struct IntraPre { u32x4 lr[4]; u32x4 q8, k8, v0, v1; };
struct IntraConst { bf16x8 wuA[2]; f32x4 bd4[2]; };
__device__ __forceinline__ void gla_intra_load(const Frame& F, int unit, IntraPre& P) {
    const int b = unit >> 8, n = (unit >> 2) & 63, h = unit & 3, c = F.lane, w = F.wave;
    const size_t m0 = (size_t)b * SEQ + 64 * n;
#pragma unroll
    for (int q = 0; q < 4; ++q) P.lr[q] = *(const u32x4*)((const bf16_t*)(F.ws + WS_LR) + (m0 + 32 * (q >> 1) + (c & 31)) * 32 + 16 * (q & 1) + 8 * (c >> 5));
    P.q8 = *(const u32x4*)((const bf16_t*)(F.ws + WS_QB) + (m0 + c) * 256 + h * 64 + 8 * w);
    P.k8 = *(const u32x4*)((const bf16_t*)(F.ws + WS_KB) + (m0 + c) * 256 + h * 64 + 8 * w);
    const bf16_t* VB = (const bf16_t*)(F.ws + WS_VB);
    { const int idx = F.tid, j = idx >> 4, ch = idx & 15; P.v0 = *(const u32x4*)(VB + (m0 + j) * 512 + h * 128 + ch * 8); }
    { const int idx = F.tid + 512, j = idx >> 4, ch = idx & 15; P.v1 = *(const u32x4*)(VB + (m0 + j) * 512 + h * 128 + ch * 8); }
}
__device__ __forceinline__ void gla_intra_unit(Frame& F, int l, int unit, const IntraPre& P, const IntraConst& K) {
    const int b = unit >> 8, n = (unit >> 2) & 63, h = unit & 3;
    const int tid = F.tid, lane = F.lane, r32 = lane & 31, hi = lane >> 5, w = F.wave;
    const size_t m0 = (size_t)b * SEQ + 64 * n;
    bf16_t* QD = (bf16_t*)(F.ws + WS_QD);
    LAS unsigned char* L = F.lds;
    T_BEGIN();
    { const int idx = tid, j = idx >> 4, ch = idx & 15; *(LAS u32x4*)(L + 49152 + ((ch >> 2) * 4 + (j >> 4)) * 1024 + (j & 15) * 64 + (ch & 3) * 16) = P.v0; }
    { const int idx = tid + 512, j = idx >> 4, ch = idx & 15; *(LAS u32x4*)(L + 49152 + ((ch >> 2) * 4 + (j >> 4)) * 1024 + (j & 15) * 64 + (ch & 3) * 16) = P.v1; }
    {
        const int c = lane;
        const u32x4 q8 = P.q8, k8 = P.k8;
        const float qv[8] = {bflo(q8.x), bfhi(q8.x), bflo(q8.y), bfhi(q8.y), bflo(q8.z), bfhi(q8.z), bflo(q8.w), bfhi(q8.w)};
        const float kv[8] = {bflo(k8.x), bfhi(k8.x), bflo(k8.y), bfhi(k8.y), bflo(k8.z), bfhi(k8.z), bflo(k8.w), bfhi(k8.w)};
        float* DEC = (float*)(F.ws + WS_DEC) + (size_t)unit * 128;
#pragma unroll
        for (int dir = 0; dir < 2; ++dir) {
            float lg[8];
            { f32x16 ci = f32x16{}; ci[0] = K.bd4[dir][0]; ci[1] = K.bd4[dir][1]; ci[2] = K.bd4[dir][2]; ci[3] = K.bd4[dir][3];
              const f32x16 a0 = MFMA32(K.wuA[dir], __builtin_bit_cast(bf16x8, P.lr[dir]), ci), a1 = MFMA32(K.wuA[dir], __builtin_bit_cast(bf16x8, P.lr[2 + dir]), ci);
#pragma unroll
              for (int i = 0; i < 4; ++i) { auto rr = __builtin_amdgcn_permlane32_swap(__float_as_uint(a0[i]), __float_as_uint(a1[i]), false, false); lg[i] = __uint_as_float(rr[0]); lg[4 + i] = __uint_as_float(rr[1]); } }
            float qd[8], kd[8], ke[8], dc[8], la2[8], pre[8];
#pragma unroll
            for (int d = 0; d < 8; ++d) {
                const float tt = ex2(-fabsf(lg[d]) * LOG2E);
                la2[d] = (fminf(lg[d], 0.f) * LOG2E - __builtin_amdgcn_logf(1.0f + tt)) * (1.0f / 16.0f);
                pre[d] = la2[d];
            }
#pragma unroll
            for (int d = 0; d < 8; ++d) pre[d] += dpp_f(pre[d], 1);
#pragma unroll
            for (int d = 0; d < 8; ++d) pre[d] += dpp_f(pre[d], 2);
#pragma unroll
            for (int d = 0; d < 8; ++d) pre[d] += dpp_f(pre[d], 4);
#pragma unroll
            for (int d = 0; d < 8; ++d) pre[d] += dpp_f(pre[d], 8);
#pragma unroll
            for (int d = 0; d < 8; ++d) pre[d] += dpp_f(pre[d], 15);
#pragma unroll
            for (int d = 0; d < 8; ++d) pre[d] += dpp_f(pre[d], 31);
#pragma unroll
            for (int d = 0; d < 8; ++d) {
                const float tot = __builtin_bit_cast(float, __builtin_amdgcn_readlane(__builtin_bit_cast(int, pre[d]), 63));
                const float bb = dir == 0 ? pre[d] : (tot - pre[d] + la2[d]);
                const float e1 = ex2(bb), e2 = ex2(-bb), dct = ex2(tot);
                qd[d] = qv[d] * e1; kd[d] = kv[d] * e2; ke[d] = kd[d] * dct; dc[d] = dct;
            }
            if (lane == 0) { *(f32x4*)(DEC + dir * 64 + 8 * w) = (f32x4){dc[0], dc[1], dc[2], dc[3]}; *(f32x4*)(DEC + dir * 64 + 8 * w + 4) = (f32x4){dc[4], dc[5], dc[6], dc[7]}; }
            u32x4 a, bq, cq;
            a.x = cvtpk(qd[0], qd[1]); a.y = cvtpk(qd[2], qd[3]); a.z = cvtpk(qd[4], qd[5]); a.w = cvtpk(qd[6], qd[7]);
            bq.x = cvtpk(kd[0], kd[1]); bq.y = cvtpk(kd[2], kd[3]); bq.z = cvtpk(kd[4], kd[5]); bq.w = cvtpk(kd[6], kd[7]);
            cq.x = cvtpk(ke[0], ke[1]); cq.y = cvtpk(ke[2], ke[3]); cq.z = cvtpk(ke[4], ke[5]); cq.w = cvtpk(ke[6], ke[7]);
            { bf16_t* qp = QD + ((size_t)dir * T + m0 + c) * 256 + h * 64 + 16 * (w >> 1) + 4 * (w & 1);
              *(u32x2*)qp = (u32x2){a.x, a.y}; *(u32x2*)(qp + 8) = (u32x2){a.z, a.w}; }
            const int kso = c * 128 + ((w ^ ((c >> 1) & 7)) << 4);
            *(LAS u32x4*)(L + dir * 16384 + kso) = a;
            *(LAS u32x4*)(L + dir * 16384 + 8192 + kso) = bq;
            *(LAS u32x4*)(L + 32768 + dir * 8192 + ((w >> 2) * 4 + (c >> 4)) * 1024 + (c & 15) * 64 + (w & 3) * 16) = cq;
        }
    }
    asm volatile("s_waitcnt lgkmcnt(0)\n\ts_barrier" ::: "memory");
    T_END(12);
    const int vperm = ((lane >> 4) & 1) * 32 + (lane & 3) * 8 + (4 * hi + ((lane & 15) >> 2)) * 64;
    const int vnat = ((lane >> 4) & 1) * 32 + (lane & 3) * 8 + (8 * hi + ((lane & 15) >> 2)) * 64;
    {
        const int ct = w & 1, dvt = w >> 1;
        f32x16 o = f32x16{};
#pragma unroll
        for (int dir = 0; dir < 2; ++dir)
#pragma unroll
            for (int st = 0; st < 2; ++st) {
                if ((dir == 0 && st > ct) || (dir == 1 && st < ct)) continue;
                f32x16 x = f32x16{};
#pragma unroll
                for (int ds = 0; ds < 4; ++ds) {
                    const int sr = 32 * st + r32, cr = 32 * ct + r32, ch = 2 * ds + hi;
                    const bf16x8 kf = *(const LAS bf16x8*)(L + dir * 16384 + 8192 + sr * 128 + ((ch ^ ((sr >> 1) & 7)) << 4));
                    const bf16x8 qf = *(const LAS bf16x8*)(L + dir * 16384 + cr * 128 + ((ch ^ ((cr >> 1) & 7)) << 4));
                    x = MFMA32(kf, qf, x);
                }
                if (st == ct) {
#pragma unroll
                    for (int r = 0; r < 16; ++r) { const int s_ = crow(r, hi), c_ = r32; const bool keepv = dir == 0 ? (s_ <= c_) : (s_ > c_); if (!keepv) x[r] = 0.f; }
                }
                const bf16x8 p0 = pack8(x, 0), p1 = pack8(x, 1);
                const LAS char* vb = (const LAS char*)L + 49152 + (dvt * 4 + 2 * st) * 1024 + vperm;
                const bf16x8 v0 = mk8(vtr(vb), vtr(vb + 512)), v1 = mk8(vtr(vb + 1024), vtr(vb + 1024 + 512));
                o = MFMA32(p0, v0, o); o = MFMA32(p1, v1, o);
            }
        st_nat((bf16_t*)(F.ws + WS_OI) + (m0 + 32 * ct) * 512 + h * 128 + 32 * dvt, o, r32, hi);
    }
    {
        const int dkt = w & 1, dvt = w >> 1;
#pragma unroll
        for (int dir = 0; dir < 2; ++dir) {
            f32x16 u = f32x16{};
#pragma unroll
            for (int t = 0; t < 4; ++t) {
                const LAS char* ka = (const LAS char*)L + 32768 + dir * 8192 + (dkt * 4 + t) * 1024 + vnat;
                const LAS char* vb = (const LAS char*)L + 49152 + (dvt * 4 + t) * 1024 + vnat;
                const bf16x8 af = mk8(vtr(ka), vtr(ka + 256)), bfr = mk8(vtr(vb), vtr(vb + 256));
                u = MFMA32(af, bfr, u);
            }
            st_tile((unsigned*)(F.ws + WS_U) + (((size_t)unit * 2 + dir) * 8 + dkt * 4 + dvt) * 512, u, lane);
        }
    }
    asm volatile("s_waitcnt lgkmcnt(0)\n\ts_barrier" ::: "memory");
}
__device__ __forceinline__ void gla_intra_consts(const Frame& F, int l, int h, IntraConst& KC) {
    const float* wu = par(F, l, PAR_WDU); const float* bd = par(F, l, PAR_BDEC);
    const int m = F.lane & 31, kh = F.lane >> 5;
#pragma unroll
    for (int dir = 0; dir < 2; ++dir) {
        float t[8];
#pragma unroll
        for (int j = 0; j < 8; ++j) t[j] = (m < 8) ? wu[(dir * 16 + 8 * kh + j) * 256 + h * 64 + 8 * F.wave + m] : 0.f;
        u32x4 pk; pk.x = cvtpk(t[0], t[1]); pk.y = cvtpk(t[2], t[3]); pk.z = cvtpk(t[4], t[5]); pk.w = cvtpk(t[6], t[7]);
        KC.wuA[dir] = __builtin_bit_cast(bf16x8, pk);
        KC.bd4[dir] = *(const f32x4*)(bd + dir * 256 + h * 64 + 8 * F.wave + 4 * kh);
    }
}
__device__ __forceinline__ void gla_intra_phase(Frame& F, int l) {
    if (F.bid >= 2048) return;
    const bool rot = (F.G == 256); const int nun = rot ? 8 : (2048 - F.bid + F.G - 1) / F.G;
    auto unit_of = [&](int j) { const int jj = j < nun ? j : nun - 1; return rot ? ((((jj + (F.bid >> 5)) & 7) << 8) + F.bid) : (F.bid + jj * F.G); };
    IntraPre pa, pb; IntraConst KC; int hs = -1;
    int j = 0, u = unit_of(0);
    gla_intra_load(F, u, pa);
#pragma unroll 1
    for (;;) {
        gla_intra_load(F, unit_of(j + 1), pb);
        if ((u & 3) != hs) { hs = u & 3; gla_intra_consts(F, l, hs, KC); }
        { T_BEGIN(); gla_intra_unit(F, l, u, pa, KC); T_END(2); }
        if (++j >= nun) break; u = unit_of(j);
        gla_intra_load(F, unit_of(j + 1), pa);
        if ((u & 3) != hs) { hs = u & 3; gla_intra_consts(F, l, hs, KC); }
        { T_BEGIN(); gla_intra_unit(F, l, u, pb, KC); T_END(2); }
        if (++j >= nun) break; u = unit_of(j);
    }
}
constexpr int SC_NC = 2;
constexpr int SC_SLOT = 8192 + SC_NC * 4096, SC_NSLOT = 6, SC_DEPTH = 5, SC_DEC = SC_SLOT * SC_NSLOT, SC_STG = SC_DEC + 16384, SC_SPIN = 1 << 22, SC_NWG = 256 / SC_NC;
static_assert(SC_STG + SC_NC * 4608 <= MISC_OFF && 8 * (SC_DEPTH - 1) <= 63 && 4 * SC_NC * (SC_DEPTH - 1) <= 63, "scan LDS map / vmcnt range");
__device__ __forceinline__ unsigned lds_addr(const volatile LAS void* p) { return (unsigned)(size_t)p; }
__device__ __forceinline__ void lds_st_u32(unsigned addr, unsigned v) { asm volatile("ds_write_b32 %0, %1" : : "v"(addr), "v"(v) : "memory"); }
__device__ __forceinline__ unsigned lds_ld_u32(unsigned addr) { unsigned v; asm volatile("ds_read_b32 %0, %1\n\ts_waitcnt lgkmcnt(0)" : "=&v"(v) : "v"(addr) : "memory"); return v; }
__device__ __forceinline__ void glds16_asm(const void* gsrc, unsigned lds_dst) {
    unsigned keep;
    asm volatile("s_mov_b32 %0, m0\n\ts_mov_b32 m0, %2\n\ts_nop 0\n\tglobal_load_lds_dwordx4 %1, off\n\ts_mov_b32 m0, %0" : "=&s"(keep) : "v"(gsrc), "s"(lds_dst) : "memory");
}
__device__ __forceinline__ void wait_vm_dyn(int n) {
    switch (n) { case 32: asm volatile("s_waitcnt vmcnt(32)" ::: "memory"); break; case 24: asm volatile("s_waitcnt vmcnt(24)" ::: "memory"); break; case 16: asm volatile("s_waitcnt vmcnt(16)" ::: "memory"); break;
                 case 8: asm volatile("s_waitcnt vmcnt(8)" ::: "memory"); break; default: asm volatile("s_waitcnt vmcnt(0)" ::: "memory"); break; }
}
__device__ __forceinline__ void gla_scan_chain(Frame& F, int item) {
    const int chain = item / (4 / SC_NC), dv0 = (item % (4 / SC_NC)) * SC_NC;
    const int b = chain >> 3, h = (chain >> 1) & 3, dir = chain & 1;
    const int tid = F.tid, lane = F.lane, r32 = lane & 31, hi = lane >> 5, w = F.wave;
    volatile LAS unsigned* MISC = (volatile LAS unsigned*)(F.lds + MISC_OFF);
    const unsigned ldsb = lds_addr(F.lds);
    for (int i = tid; i < 4096; i += 512) { const int st = i >> 6, n = dir == 0 ? st : 63 - st;
        ((LAS float*)(F.lds + SC_DEC))[i] = ((const float*)(F.ws + WS_DEC))[(size_t)((b * 64 + n) * 4 + h) * 128 + dir * 64 + (i & 63)]; }
    if (tid < 8) MISC[16 + tid] = 0u;
    __syncthreads();
    if (w == 4 || w == 5) {
        const bool isq = (w == 4);
        const unsigned rdy = lds_addr(MISC + (isq ? 16 : 17)), dn = lds_addr(MISC + 18);
#pragma unroll 1
        for (int s = 0; s < 64 + SC_DEPTH - 1; ++s) {
            if (s < 64) {
                if (s >= SC_NSLOT) { int sp = 0;
                    for (;;) { int dmin = 1 << 30;
#pragma unroll
                        for (int k = 0; k < SC_NC; ++k) dmin = min(dmin, (int)__builtin_amdgcn_readfirstlane(lds_ld_u32(dn + 4 * k)));
                        if (dmin >= s - SC_NSLOT + 1 || ++sp >= SC_SPIN) break; __builtin_amdgcn_s_sleep(2); } }
                const int n = dir == 0 ? s : 63 - s;
                const size_t m0 = (size_t)b * SEQ + 64 * n;
                const unsigned slot = (unsigned)__builtin_amdgcn_readfirstlane(ldsb + (s % SC_NSLOT) * SC_SLOT);
                if (isq) {
                    const bf16_t* QD = (const bf16_t*)(F.ws + WS_QD) + ((size_t)dir * T + m0) * 256 + h * 64;
#pragma unroll
                    for (int p = 0; p < 8; ++p) { const int row = 8 * p + (lane >> 3), g = (lane & 7) ^ ((row >> 1) & 7);
                        glds16_asm(QD + (size_t)row * 256 + 8 * g, slot + p * 1024); }
                } else {
                    const unsigned* up = (const unsigned*)(F.ws + WS_U) + (((size_t)((b * 64 + n) * 4 + h) * 2 + dir) * 8 + dv0) * 512;
#pragma unroll
                    for (int p = 0; p < 4 * SC_NC; ++p) { const int k = p >> 2, q = p & 3; glds16_asm(up + (size_t)k * 512 + (q >> 1) * 2048 + (q & 1) * 256 + lane * 4, slot + 8192 + p * 1024); }
                }
            }
            const int pgrp = s - (SC_DEPTH - 1);
            if (pgrp >= 0) {
                const int younger = (s < 64 ? s : 63) - pgrp;
                wait_vm_dyn(younger * (isq ? 8 : 4 * SC_NC));
                if (lane == 0) lds_st_u32(rdy, (unsigned)(pgrp + 1));
            }
        }
    } else if (w < SC_NC) {
        const int dvt = dv0 + w;
        f32x16 S0 = f32x16{}, S1 = f32x16{};
        LAS bf16_t* stg = (LAS bf16_t*)(F.lds + SC_STG + w * 4608);
#pragma unroll 1
        for (int s = 0; s < 64; ++s) {
            { const unsigned long long tp0_ = (TSEC == 14) ? __builtin_amdgcn_s_memrealtime() : 0ull;
              int sp = 0; while (((int)MISC[16] <= s || (int)MISC[17] <= s) && ++sp < SC_SPIN) __builtin_amdgcn_s_sleep(1);
              if (TSEC == 14 && F.bid == 0 && tid == 0) { unsigned* p_ = (unsigned*)(F.ws + WS_CTL) + 8192; *p_ += (unsigned)(__builtin_amdgcn_s_memrealtime() - tp0_); } }
            asm volatile("" ::: "memory");
            const LAS unsigned char* slot = F.lds + (s % SC_NSLOT) * SC_SLOT;
            bf16x8 qa[2][4];
#pragma unroll
            for (int ct = 0; ct < 2; ++ct)
#pragma unroll
                for (int t = 0; t < 4; ++t) {
                    const int c = 32 * ct + r32, sw = (c >> 1) & 7;
                    qa[ct][t] = *(const LAS bf16x8*)(slot + c * 128 + (((2 * t + hi) ^ sw) << 4));
                }
            unsigned u0[8], u1[8];
            const LAS unsigned char* us = slot + 8192 + w * 4096;
            { const u32x4 a0 = *(const LAS u32x4*)(us + lane * 16), a1 = *(const LAS u32x4*)(us + 1024 + lane * 16), b0 = *(const LAS u32x4*)(us + 2048 + lane * 16), b1 = *(const LAS u32x4*)(us + 3072 + lane * 16);
              u0[0] = a0.x; u0[1] = a0.y; u0[2] = a0.z; u0[3] = a0.w; u0[4] = a1.x; u0[5] = a1.y; u0[6] = a1.z; u0[7] = a1.w;
              u1[0] = b0.x; u1[1] = b0.y; u1[2] = b0.z; u1[3] = b0.w; u1[4] = b1.x; u1[5] = b1.y; u1[6] = b1.z; u1[7] = b1.w; }
            const LAS float* dp = (const LAS float*)(F.lds + SC_DEC) + s * 64;
            f32x4 d0[4], d1[4];
#pragma unroll
            for (int q = 0; q < 4; ++q) { d0[q] = *(const LAS f32x4*)(dp + 8 * q + 4 * hi); d1[q] = *(const LAS f32x4*)(dp + 32 + 8 * q + 4 * hi); }
            const bf16x8 sb0 = pack8(S0, 0), sb1 = pack8(S0, 1), sb2 = pack8(S1, 0), sb3 = pack8(S1, 1);
            f32x16 oi[2];
#pragma unroll
            for (int ct = 0; ct < 2; ++ct) { f32x16 a = f32x16{}; a = MFMA32(qa[ct][0], sb0, a); a = MFMA32(qa[ct][1], sb1, a); a = MFMA32(qa[ct][2], sb2, a); a = MFMA32(qa[ct][3], sb3, a); oi[ct] = a; }
#pragma unroll
            for (int i = 0; i < 8; ++i) {
                S0[2 * i] = S0[2 * i] * d0[(2 * i) >> 2][(2 * i) & 3] + bflo(u0[i]); S0[2 * i + 1] = S0[2 * i + 1] * d0[(2 * i + 1) >> 2][(2 * i + 1) & 3] + bfhi(u0[i]);
                S1[2 * i] = S1[2 * i] * d1[(2 * i) >> 2][(2 * i) & 3] + bflo(u1[i]); S1[2 * i + 1] = S1[2 * i + 1] * d1[(2 * i + 1) >> 2][(2 * i + 1) & 3] + bfhi(u1[i]);
            }
            asm volatile("s_waitcnt lgkmcnt(0)" ::: "memory");
            if (lane == 0) MISC[18 + w] = (unsigned)(s + 1);
            const int n = dir == 0 ? s : 63 - s;
            bf16_t* op = (bf16_t*)(F.ws + WS_OT) + ((size_t)dir * T + (size_t)b * SEQ + 64 * n) * 512 + h * 128 + 32 * dvt;
#pragma unroll
            for (int ct = 0; ct < 2; ++ct)
#pragma unroll
                for (int q = 0; q < 4; ++q) { u32x2 pkd; pkd.x = cvtpk(oi[ct][4 * q], oi[ct][4 * q + 1]); pkd.y = cvtpk(oi[ct][4 * q + 2], oi[ct][4 * q + 3]);
                    *(LAS u32x2*)((LAS unsigned char*)stg + r32 * 136 + (32 * ct + 8 * q + 4 * hi) * 2) = pkd; }
            asm volatile("s_waitcnt lgkmcnt(0)" ::: "memory");
            {
              const LAS char* tb = (const LAS char*)stg + (8 * (lane >> 4) + ((lane & 15) >> 2)) * 136 + (4 * (lane & 3)) * 2;
#pragma unroll
              for (int t = 0; t < 4; ++t) { const bf16x8 v8 = mk8(vtr(tb + 32 * t), vtr(tb + 4 * 136 + 32 * t));
                  *(u32x4*)(op + (size_t)(16 * t + (lane & 15)) * 512 + 8 * (lane >> 4)) = __builtin_bit_cast(u32x4, v8); } }
            asm volatile("s_waitcnt lgkmcnt(0)" ::: "memory");
        }
    }
    __syncthreads();
}
__device__ __forceinline__ void gla_final_stream(Frame& F, int l) {
    const u32x4* OI = (const u32x4*)(F.ws + WS_OI); const u32x4* OF = (const u32x4*)(F.ws + WS_OT); const u32x4* OBk = OF + (size_t)T * 512 / 8;
    const u32x4* OG = (const u32x4*)(F.ws + WS_OG); u32x4* OUT = (u32x4*)(F.ws + WS_OB);
    const float* gn = par(F, l, PAR_GLAG) + (F.tid & 15) * 8;
    const f32x4 g0 = *(const f32x4*)gn, g1 = *(const f32x4*)(gn + 4);
    const float gg[8] = {g0.x, g0.y, g0.z, g0.w, g1.x, g1.y, g1.z, g1.w};
    const int n16 = T * 512 / 8, stride = F.G * 512;
#pragma unroll 2
    for (int idx = F.bid * 512 + F.tid; idx < n16; idx += stride) {
        const u32x4 a = OI[idx], b = OF[idx], c = OBk[idx], g = OG[idx];
        float v[8] = {bflo(a.x) + bflo(b.x) + bflo(c.x), bfhi(a.x) + bfhi(b.x) + bfhi(c.x), bflo(a.y) + bflo(b.y) + bflo(c.y), bfhi(a.y) + bfhi(b.y) + bfhi(c.y),
                      bflo(a.z) + bflo(b.z) + bflo(c.z), bfhi(a.z) + bfhi(b.z) + bfhi(c.z), bflo(a.w) + bflo(b.w) + bflo(c.w), bfhi(a.w) + bfhi(b.w) + bfhi(c.w)};
        const float og[8] = {bflo(g.x), bfhi(g.x), bflo(g.y), bfhi(g.y), bflo(g.z), bfhi(g.z), bflo(g.w), bfhi(g.w)};
        float s = 0.f;
#pragma unroll
        for (int e = 0; e < 8; ++e) s += v[e] * v[e];
        s = rowsum16(s);
        const float rs = __builtin_amdgcn_rsqf(s * (1.0f / 128.0f) + EPS);
#pragma unroll
        for (int e = 0; e < 8; ++e) v[e] = v[e] * rs * gg[e] * og[e];
        u32x4 o; o.x = cvtpk(v[0], v[1]); o.y = cvtpk(v[2], v[3]); o.z = cvtpk(v[4], v[5]); o.w = cvtpk(v[6], v[7]);
        if (FUSE_GATE_MERGE) asm volatile("global_store_dwordx4 %0, %1, off sc1" :: "v"(OUT + idx), "v"(o) : "memory");
        else st16_wt(OUT + idx, o);
    }
}

__global__ void __launch_bounds__(512, 2) fwd_kernel(Args args) {
    extern __shared__ __attribute__((aligned(16))) unsigned char lds_raw[];
    Frame F;
    F.lds = (LAS unsigned char*)lds_raw; F.ws = args.ws; F.tid = threadIdx.x; F.lane = F.tid & 63; F.wave = __builtin_amdgcn_readfirstlane(F.tid >> 6);
    F.G = gridDim.x; F.bid = blockIdx.x; F.out = args.out;
    volatile LAS unsigned* MISC = (volatile LAS unsigned*)(F.lds + MISC_OFF);
    if (F.tid < 32) MISC[F.tid] = 0u;
    __syncthreads();
    const int lo = args.ph_lo, hi_ = args.ph_hi;
    XcdBarrier bar; bar.bar = (unsigned*)(F.ws + WS_CTL) + CW_BAR; bar.x = 0; bar.st = nullptr;
    if (hi_ - lo > 1) bar = xcd_barrier_post((unsigned*)(F.ws + WS_CTL) + CW_BAR, MISC + 8);
#ifndef PH_MASK
#define PH_MASK 0x1ff
#endif
#define IN(k) (lo <= (k) && (k) < hi_)
#define PM(j) ((PH_MASK >> (j)) & 1)
#define FRESH() do { F.tid = opaque_v(threadIdx.x); F.lane = F.tid & 63; F.wave = __builtin_amdgcn_readfirstlane(F.tid >> 6); } while (0)
#define SEAM(k) do { if (TSEC == 41 && ((k) == 0 ? 0 : (((k) - 1) & 7) + 1) == TPH && threadIdx.x == 0) { asm volatile("s_waitcnt vmcnt(0)" ::: "memory"); __hip_atomic_fetch_max((unsigned*)(F.ws + WS_CTL) + 8200 + ((k) > 8), (unsigned)(__builtin_amdgcn_s_memrealtime() - tph0_), __ATOMIC_RELAXED, __HIP_MEMORY_SCOPE_AGENT); } if (TSEC == 40 && F.bid == TBLK && ((k) == 0 ? 0 : (((k) - 1) & 7) + 1) == TPH && threadIdx.x == 0) { asm volatile("s_waitcnt vmcnt(0)" ::: "memory"); unsigned* p_ = (unsigned*)(F.ws + WS_CTL) + 8192; __hip_atomic_fetch_add(p_, (unsigned)(__builtin_amdgcn_s_memrealtime() - tph0_), __ATOMIC_RELAXED, __HIP_MEMORY_SCOPE_AGENT); } if (IN(k) && IN((k) + 1)) { const unsigned long long tb0_ = (TSEC >= 30 && TSEC <= 34) ? __builtin_amdgcn_s_memrealtime() : 0ull; xcd_barrier(bar); if ((TSEC == 30 && F.bid == 0 || TSEC == 31 && F.bid == 128 || (TSEC == 32 && F.bid == 0 || TSEC == 33 && F.bid == (TBLK ? TBLK : 128) || TSEC == 34 && F.bid == 255) && ((k) == 0 ? 0 : (((k) - 1) & 7) + 1) == TPH) && threadIdx.x == 0) { unsigned* p_ = (unsigned*)(F.ws + WS_CTL) + 8192; __hip_atomic_fetch_add(p_, (unsigned)(__builtin_amdgcn_s_memrealtime() - tb0_), __ATOMIC_RELAXED, __HIP_MEMORY_SCOPE_AGENT); } } if ((TSEC >= 20 && TSEC == 20 + ((k) == 0 ? 0 : (((k) - 1) & 7) + 1) || TSEC == 45 && ((k) == 0 ? 0 : (((k) - 1) & 7) + 1) == 5) && F.bid == 0 && threadIdx.x == 0) { unsigned* p_ = (unsigned*)(F.ws + WS_CTL) + 8192; *p_ += (unsigned)(__builtin_amdgcn_s_memrealtime() - tph0_); } } while (0)
    float* SSb = (float*)(F.ws + WS_SS);
    unsigned long long tph0_ = 0ull; (void)tph0_;
    unsigned* const TP = (unsigned*)(F.ws + WS_CTL) + 8192; (void)TP;

#define REPS(j) (((j) == PROBE_PHASE && hi_ - lo > 1) ? 1 + PROBE_REPS : 1)
#define PHASE_BEGIN(j) tph0_ = (TSEC == 20 + (j) || (TSEC == 45 && (j) == 4) || ((TSEC == 40 || TSEC == 41) && TPH == (j))) ? __builtin_amdgcn_s_memrealtime() : tph0_; for (int rep = 0; rep < REPS(j); ++rep) { const bool dry = rep + 1 < REPS(j); (void)dry; FRESH();
#define PHASE_END() if (dry) xcd_barrier(bar); }
    if (PM(0) && IN(0)) { PHASE_BEGIN(0) p0_prologue(F, args); PHASE_END() }
    SEAM(0);
#pragma unroll 1
    for (int l = 0; l < 2; ++l) {
        const int pb = 1 + 8 * l;
        unsigned char* wl = F.ws + WS_W + (size_t)l * W_LAYER;
        if (PM(1) && IN(pb + 0)) { PHASE_BEGIN(1)
            {
                pg8::Gemm g{(const bf16_t*)(F.ws + WS_XB), (const bf16_t*)(wl + W_INA), DM, DM, DM, TPH == 1 ? TP : nullptr};
                pg8::Sched S; S.init(T, 3072, 1, F.G, F.bid, 256 * DM * 2, 0, 256 * DM * 2, 0);
                EpiQKV E{F.ws, SSb + (size_t)(2 * l) * T, par(F, l, PAR_GKA)};
                pg8::gemm_phase<EpiQKV, true, true>(F.lds, g, S, E);
            }
            if (l == 0) {
                pg8::Gemm g{(const bf16_t*)(F.ws + WS_MB), (const bf16_t*)(F.ws + WS_W + W_MKV), DM, DM, DM, nullptr};
                pg8::Sched S; S.init(TMEM, 1024, 2, F.G, F.bid, 256 * DM * 2, 0, 256 * DM * 2, (unsigned)W_LAYER); S.subFast = false;
                EpiRowScale<0> E{(bf16_t*)(F.ws + WS_KVM), 1024, (size_t)TMEM * 1024, (const float*)(F.ws + WS_MSS)};
                pg8::gemm_phase<EpiRowScale<0>, true, true>(F.lds, g, S, E);
            }
        PHASE_END() }
        SEAM(pb + 0);
        if (PM(2) && IN(pb + 1)) { PHASE_BEGIN(2)
            const bool mem_first = P2_STAGGER && (((F.bid >> 3) & 1) != 0);
            if (mem_first) for (int u = F.bid; u < 256; u += F.G) { T_BEGIN(); memattn_unit(F, l, u, dry); T_END(1); }
            { T_BEGIN(); gla_intra_phase(F, l); T_END(15); }
            if (!mem_first) for (int u = F.bid; u < 256; u += F.G) { T_BEGIN(); memattn_unit(F, l, u, dry); T_END(1); }
        PHASE_END() }
        if (WIN_WARM && PM(3) && IN(pb + 2) && F.G > SC_NWG + 8 && F.bid >= SC_NWG && F.bid - SC_NWG < 512) {
            const int u0 = F.bid - SC_NWG, b_ = u0 >> 6, i_ = (u0 >> 1) & 31, kvh_ = u0 & 1;
            const unsigned dump = lds_addr(F.lds) + 131072u + (unsigned)F.wave * 1024u;
            for (int idx = F.tid; idx < 768 + 512; idx += 512) {
                const bf16_t* p;
                if (idx < 768) { const int t_ = idx / 384, j_ = idx % 384; const int kpos = min(max(128 * i_ - 128 + j_, 0), SEQ - 1);
                    p = (const bf16_t*)(F.ws + (t_ ? WS_VA : WS_KA)) + (size_t)(b_ * SEQ + kpos) * 128 + kvh_ * 64; }
                else { const int q_ = idx - 768; p = (const bf16_t*)(F.ws + WS_QA) + (size_t)(b_ * SEQ + 128 * i_ + (q_ >> 2)) * 512 + (kvh_ * 4 + (q_ & 3)) * 64; }
                glds16_asm(p, dump);
            }
        }
        SEAM(pb + 1);
        if (PM(3) && IN(pb + 2)) { PHASE_BEGIN(3)
            if (F.G > SC_NWG + 8) {
                if (F.bid < SC_NWG) { T_BEGIN(); gla_scan_chain(F, F.bid); T_END(4); }
                else { const int nb = F.G - SC_NWG; int u = F.bid - SC_NWG;
                    if (u < 512) { WinKV cur, nxt; win_k_load(F, u, cur); win_v_load(F, u, cur); win_q_load(F, l, u, F.tid, cur); bool first = true;
#pragma unroll 1
                        for (; u < 512; u += nb) { const bool hn = u + nb < 512; winattn_unit(F, l, u, dry, cur, hn, u + nb, nxt, first || (nb & 1)); cur = nxt; first = false; } } }
            } else {
                for (int c = F.bid; c < SC_NWG; c += F.G) gla_scan_chain(F, c);
                for (int u = F.bid; u < 512; u += F.G) { WinKV cur, nxt; win_k_load(F, u, cur); win_v_load(F, u, cur); win_q_load(F, l, u, F.tid, cur); winattn_unit(F, l, u, dry, cur, false, u, nxt, true); }
            }
        PHASE_END() }
        SEAM(pb + 2);
        if (PM(4) && IN(pb + 3)) { PHASE_BEGIN(4)
            { T_BEGIN(); gla_final_stream(F, l); T_END(7); }
            asm volatile("s_waitcnt vmcnt(0)" ::: "memory"); __syncthreads();
            if (F.tid == 0) __hip_atomic_fetch_add((unsigned*)(F.ws + WS_CTL) + 8256 + 64 * l, 1u, __ATOMIC_RELAXED, __HIP_MEMORY_SCOPE_AGENT);
            pg8::Gemm g{(const bf16_t*)(F.ws + WS_XB), (const bf16_t*)(wl + W_ING), DM, DM, DM, TPH == 4 ? TP : nullptr};
            pg8::Sched S; S.init(T, 1024, 3, F.G, F.bid, 256 * DM * 2, 0, 256 * DM * 2, 1024 * DM * 2);
            EpiGate E{(u32x4*)(F.ws + WS_G), SSb + (size_t)(2 * l) * T, (unsigned*)(F.ws + WS_CTL) + 8256 + 64 * l, (hi_ - lo > 1) ? (unsigned)F.G : 0u, false};
            pg8::gemm_phase<EpiGate, true, true>(F.lds, g, S, E);
        PHASE_END() }
        if (!(FUSE_GATE_MERGE && (hi_ - lo > 1))) SEAM(pb + 3);
        if (PM(5) && IN(pb + 4)) { PHASE_BEGIN(5)
            pg8::Gemm g{(const bf16_t*)(F.ws + WS_QA), (const bf16_t*)(wl + W_BR), 512, 1536, 512, TPH == 5 ? TP : nullptr};
            pg8::Sched S; S.init(T, 1024, 3, F.G, F.bid, 256 * 512 * 2, 32 * MiB, 256 * 1536 * 2, 512 * 2);
            EpiMerge E{(const u32x4*)(F.ws + WS_G), (bf16_t*)(F.ws + WS_MG)};
            pg8::gemm_phase<EpiMerge, true, true>(F.lds, g, S, E);
        PHASE_END() }
        SEAM(pb + 4);
        if (PM(6) && IN(pb + 5)) { PHASE_BEGIN(6)
            pg8::Gemm g{(const bf16_t*)(F.ws + WS_MG), (const bf16_t*)(wl + W_OUT), DM, DM, DM, TPH == 6 ? TP : nullptr};
            pg8::Sched S; S.init(T, 1024, 1, F.G, F.bid, 256 * DM * 2, 0, 256 * DM * 2, 0);
            EpiRes E{(bf16_t*)(F.ws + WS_XB), nullptr, SSb + (size_t)(2 * l + 1) * T, dry};
            pg8::gemm_phase<EpiRes, true, true>(F.lds, g, S, E);
        PHASE_END() }
        SEAM(pb + 5);
        if (PM(7) && IN(pb + 6)) { PHASE_BEGIN(7)
            pg8::Gemm g{(const bf16_t*)(F.ws + WS_XB), (const bf16_t*)(wl + W_FI), DM, DM, DM, TPH == 7 ? TP : nullptr};
            pg8::Sched S; S.init(T, 2 * DFF, 1, F.G, F.bid, 256 * DM * 2, 0, 256 * DM * 2, 0);
            EpiFFN E{(bf16_t*)(F.ws + WS_H), SSb + (size_t)(2 * l + 1) * T};
            pg8::gemm_phase<EpiFFN, true, true>(F.lds, g, S, E);
        PHASE_END() }
        SEAM(pb + 6);
        if (PM(8) && IN(pb + 7)) { PHASE_BEGIN(8)
            pg8::Gemm g{(const bf16_t*)(F.ws + WS_H), (const bf16_t*)(wl + W_FO), DFF, DFF, DFF, TPH == 8 ? TP : nullptr};
            pg8::Sched S; S.init(T, 1024, 1, F.G, F.bid, 256 * DFF * 2, 0, 256 * DFF * 2, 0);
            EpiRes E{(bf16_t*)(F.ws + WS_XB), l == 0 ? nullptr : F.out, SSb + (size_t)(2 * l + 2) * T, dry};
            pg8::gemm_phase<EpiRes, true, true>(F.lds, g, S, E);
        PHASE_END() }
        SEAM(pb + 7);
    }
    if (TSEC >= 0 && hi_ == NPH && F.bid == 0 && threadIdx.x == 0) {
        asm volatile("s_waitcnt vmcnt(0)" ::: "memory");
        const unsigned long long ticks = (unsigned long long)(TSEC == 41 ? __hip_atomic_load((unsigned*)(F.ws + WS_CTL) + 8200, __ATOMIC_RELAXED, __HIP_MEMORY_SCOPE_AGENT) + __hip_atomic_load((unsigned*)(F.ws + WS_CTL) + 8201, __ATOMIC_RELAXED, __HIP_MEMORY_SCOPE_AGENT)
                                                                    : __hip_atomic_load((unsigned*)(F.ws + WS_CTL) + 8192, __ATOMIC_RELAXED, __HIP_MEMORY_SCOPE_AGENT)) * TGAIN;
        const unsigned long long t0 = __builtin_amdgcn_s_memrealtime();
        while (__builtin_amdgcn_s_memrealtime() - t0 < ticks) __builtin_amdgcn_s_sleep(8);
    }
#undef IN
#undef SEAM
}

extern "C" void kernel_launch(void* const* d_in, const int* in_sizes, int n_in, void* d_out, int out_size, void* d_ws, size_t ws_size, hipStream_t stream) {
    static int grid = 0;
    if (grid == 0) {
        if (n_in != 20 || ws_size < WS_END) { fprintf(stderr, "kernel_launch: unexpected n_in %d / ws %zu\n", n_in, ws_size); grid = -1; return; }
        int dev = 0, cus = 0, per_cu = 0;
        if (hipGetDevice(&dev) != hipSuccess || hipDeviceGetAttribute(&cus, hipDeviceAttributeMultiprocessorCount, dev) != hipSuccess) { grid = -1; return; }
        if (hipFuncSetAttribute((const void*)fwd_kernel, hipFuncAttributeMaxDynamicSharedMemorySize, LDS_BYTES) != hipSuccess) { fprintf(stderr, "kernel_launch: hipFuncSetAttribute failed\n"); grid = -1; return; }
        if (hipOccupancyMaxActiveBlocksPerMultiprocessor(&per_cu, (const void*)fwd_kernel, 512, LDS_BYTES) != hipSuccess || per_cu < 1) { fprintf(stderr, "kernel_launch: occupancy query says %d blocks/CU\n", per_cu); per_cu = 1; }
        (void)hipGetLastError();
        grid = cus;
    }
    if (grid < 0) return;
    (void)hipMemsetAsync((char*)d_ws + WS_CTL, 0, 1 * MiB, stream);
    Args a{};
    for (int i = 0; i < 20; ++i) a.in[i] = (const float*)d_in[i];
    a.out = (float*)d_out; a.ws = (unsigned char*)d_ws;
#if MK_N_LAUNCHES == 1
    a.ph_lo = 0; a.ph_hi = NPH;
    hipLaunchKernelGGL(fwd_kernel, dim3(grid), dim3(512), LDS_BYTES, stream, a);
#else
    for (int p = 0; p < NPH; ++p) { a.ph_lo = p; a.ph_hi = p + 1; hipLaunchKernelGGL(fwd_kernel, dim3(grid), dim3(512), LDS_BYTES, stream, a); }
#endif
}
```
